# Optimizing an MI355X kernel written in HIP

```python
import math
import jax, jax.numpy as jnp
from jax import lax
import numpy as np

D_MODEL = 2048
BATCH = 2
SEQ = 8192
DEPTH = 2

N_MIXERS = 2
N_FOX_LAYERS = (DEPTH + 1) // 2
N_GDN_LAYERS = DEPTH // 2
EPS = 1e-6

FOX_HEAD_DIM = 128
FOX_HEADS = D_MODEL // FOX_HEAD_DIM
FOX_Q = FOX_HEADS * FOX_HEAD_DIM
FOX_IN = 3 * FOX_Q + FOX_HEADS + FOX_Q
FOX_F_BIAS_INIT = 3.0
Q_BLOCK = 128

GDN_HEAD_DIM_K = 128
GDN_HEAD_DIM_V = 128
GDN_QK_HEADS = D_MODEL // 128
GDN_V_HEADS = 2 * GDN_QK_HEADS
GDN_KD = GDN_QK_HEADS * GDN_HEAD_DIM_K
GDN_VD = GDN_V_HEADS * GDN_HEAD_DIM_V
GDN_CONV_DIM = 2 * GDN_KD + GDN_VD
GDN_IN = 2 * GDN_KD + 2 * GDN_VD + 2 * GDN_V_HEADS
GDN_CONV = 4
GDN_CHUNK = 64

D_FF = 11 * D_MODEL // 4
FFN_CONV = 3

kernel_name = "fox_gdn_interleaved_convglu_adaln_sandwich"


def rmsnorm(x, g):
    xf = x.astype(jnp.float32)
    y = xf * lax.rsqrt(jnp.mean(xf * xf, axis=-1, keepdims=True) + EPS)
    return (y * g.astype(jnp.float32)).astype(x.dtype)


def l2norm(x):
    return x * lax.rsqrt(jnp.sum(x * x, axis=-1, keepdims=True) + EPS)


def causal_dwconv(x, w):
    K = w.shape[0]
    S = x.shape[1]
    xp = jnp.pad(x, ((0, 0), (K - 1, 0), (0, 0)))
    return sum(xp[:, k:k + S] * w[k] for k in range(K))


def fox_attention(h, w_in, f_bias, q_norm_g, k_norm_g, w_o):
    B, S, _ = h.shape
    H, Dh = FOX_HEADS, FOX_HEAD_DIM
    proj = h @ w_in
    q, k, v, f_logit, o_gate = jnp.split(proj, [FOX_Q, 2 * FOX_Q, 3 * FOX_Q, 3 * FOX_Q + H], axis=-1)
    qh = rmsnorm(q.reshape(B, S, H, Dh), q_norm_g).transpose(0, 2, 1, 3)
    kh = rmsnorm(k.reshape(B, S, H, Dh), k_norm_g).transpose(0, 2, 1, 3)
    vh = v.reshape(B, S, H, Dh).transpose(0, 2, 1, 3)
    log_f = jax.nn.log_sigmoid(f_logit.astype(jnp.float32) + f_bias.astype(jnp.float32))
    f_cum = jnp.cumsum(log_f, axis=1).transpose(0, 2, 1)
    scale = Dh ** -0.5
    key_pos = jnp.arange(S)

    def block(i):
        start = i * Q_BLOCK
        qb = lax.dynamic_slice_in_dim(qh, start, Q_BLOCK, axis=2)
        fq = lax.dynamic_slice_in_dim(f_cum, start, Q_BLOCK, axis=2)
        s = jnp.einsum('bhqd,bhkd->bhqk', qb, kh, preferred_element_type=jnp.float32) * scale
        s = s + fq[..., :, None] - f_cum[..., None, :]
        q_pos = start + jnp.arange(Q_BLOCK)
        s = jnp.where(key_pos[None, :] <= q_pos[:, None], s, -jnp.inf)
        p = jax.nn.softmax(s, axis=-1)
        return jnp.einsum('bhqk,bhkd->bhqd', p.astype(vh.dtype), vh)

    out = lax.map(block, jnp.arange(S // Q_BLOCK))
    out = out.transpose(1, 0, 3, 2, 4).reshape(B, S, H * Dh)
    out = out * jax.nn.sigmoid(o_gate)
    return out @ w_o


def chunk_gated_delta_rule(q, k, v, g, beta):
    B, S, H, Dk = q.shape
    Dv = v.shape[-1]
    C = GDN_CHUNK
    N = S // C

    def to_chunks(t):
        return t.reshape(B, N, C, H, -1).transpose(0, 3, 1, 2, 4)

    q, k, v = to_chunks(q), to_chunks(k), to_chunks(v)
    beta = beta.reshape(B, N, C, H).transpose(0, 3, 1, 2)
    g = jnp.cumsum(g.reshape(B, N, C, H).transpose(0, 3, 1, 2), axis=-1)
    idx = jnp.arange(C)
    lower_incl = idx[:, None] >= idx[None, :]
    strict = idx[:, None] > idx[None, :]
    decay_mat = jnp.exp(jnp.where(lower_incl, g[..., :, None] - g[..., None, :], -jnp.inf))
    kk = jnp.einsum('bhncd,bhnjd->bhncj', k, k)
    A = jnp.where(strict, kk * decay_mat * beta[..., :, None], 0.0)
    eye = jnp.eye(C, dtype=jnp.float32)
    rhs = jnp.concatenate([v * beta[..., None], k * (beta * jnp.exp(g))[..., None]], axis=-1)
    sol = lax.linalg.triangular_solve(eye + A, rhs, left_side=True, lower=True)
    u, w = jnp.split(sol, [Dv], axis=-1)
    qk = jnp.where(lower_incl, jnp.einsum('bhncd,bhnjd->bhncj', q, k) * decay_mat, 0.0)
    q_dec = q * jnp.exp(g)[..., None]
    g_last = g[..., -1]
    k_dec = k * jnp.exp(g_last[..., None] - g)[..., None]

    def step(state, inp):
        q_d, k_d, w_c, u_c, qk_c, gl = inp
        v_new = u_c - jnp.einsum('bhcd,bhde->bhce', w_c, state)
        o = jnp.einsum('bhcd,bhde->bhce', q_d, state) + jnp.einsum('bhcj,bhje->bhce', qk_c, v_new)
        state = state * jnp.exp(gl)[..., None, None] + jnp.einsum('bhcd,bhce->bhde', k_d, v_new)
        return state, o

    xs = (jnp.moveaxis(q_dec, 2, 0), jnp.moveaxis(k_dec, 2, 0), jnp.moveaxis(w, 2, 0),
          jnp.moveaxis(u, 2, 0), jnp.moveaxis(qk, 2, 0), jnp.moveaxis(g_last, 2, 0))
    state0 = jnp.zeros((B, H, Dk, Dv), jnp.float32)
    _, o = lax.scan(step, state0, xs)
    return o.transpose(1, 0, 3, 2, 4).reshape(B, S, H, Dv)


def gated_deltanet(h, w_in, conv_w, a_log, dt_bias, out_norm_g, w_o):
    B, S, _ = h.shape
    Hk, Hv, Dk, Dv = GDN_QK_HEADS, GDN_V_HEADS, GDN_HEAD_DIM_K, GDN_HEAD_DIM_V
    proj = h @ w_in
    qkv, z, a, b = jnp.split(proj, [GDN_CONV_DIM, GDN_CONV_DIM + GDN_VD, GDN_CONV_DIM + GDN_VD + Hv], axis=-1)
    qkv = jax.nn.silu(causal_dwconv(qkv, conv_w))
    q, k, v = jnp.split(qkv, [GDN_KD, 2 * GDN_KD], axis=-1)
    q = l2norm(q.reshape(B, S, Hk, Dk).astype(jnp.float32)) * (Dk ** -0.5)
    k = l2norm(k.reshape(B, S, Hk, Dk).astype(jnp.float32))
    q = jnp.repeat(q, Hv // Hk, axis=2)
    k = jnp.repeat(k, Hv // Hk, axis=2)
    v = v.reshape(B, S, Hv, Dv).astype(jnp.float32)
    beta = jax.nn.sigmoid(b.astype(jnp.float32))
    g = -jnp.exp(a_log.astype(jnp.float32)) * jax.nn.softplus(a.astype(jnp.float32) + dt_bias.astype(jnp.float32))
    o = chunk_gated_delta_rule(q, k, v, g, beta)
    o = rmsnorm(o, out_norm_g) * jax.nn.silu(z.reshape(B, S, Hv, Dv).astype(jnp.float32))
    return o.reshape(B, S, GDN_VD).astype(h.dtype) @ w_o


def conv_glu(h, w_up, conv_w, conv_b, w_down):
    gate, val = jnp.split(h @ w_up, 2, axis=-1)
    gate = causal_dwconv(gate, conv_w) + conv_b
    return (jax.nn.gelu(gate, approximate=False) * val) @ w_down


def modulate(x, g_pre, mod):
    shift, scale, gate = jnp.split(mod[:, None, :], 3, axis=-1)
    return rmsnorm(x, g_pre) * (1 + scale) + shift, gate


def setup_inputs(seed: int = 0) -> dict:
    key = jax.random.key(seed)
    ks = iter(jax.random.split(key, 32))
    NF, NG = N_FOX_LAYERS, N_GDN_LAYERS

    def nrm(shape, scale):
        return jax.random.normal(next(ks), shape, jnp.float32) * scale

    def gain(shape):
        return 1.0 + 0.02 * jax.random.normal(next(ks), shape, jnp.float32)

    x = nrm((BATCH, SEQ, D_MODEL), 1.0)
    c = nrm((BATCH, D_MODEL), 1.0)
    ada_w = nrm((DEPTH, 2, D_MODEL, 3 * D_MODEL), 0.5 * D_MODEL ** -0.5)
    ada_b = nrm((DEPTH, 2, 3 * D_MODEL), 0.02)
    norm_g = gain((DEPTH, 4, D_MODEL))
    fox_w_in = nrm((NF, D_MODEL, FOX_IN), D_MODEL ** -0.5)
    fox_f_bias = FOX_F_BIAS_INIT + nrm((NF, FOX_HEADS), 0.1)
    fox_q_norm = gain((NF, FOX_HEAD_DIM))
    fox_k_norm = gain((NF, FOX_HEAD_DIM))
    fox_w_o = nrm((NF, FOX_Q, D_MODEL), FOX_Q ** -0.5)
    gdn_w_in = nrm((NG, D_MODEL, GDN_IN), D_MODEL ** -0.5)
    gdn_conv_w = nrm((NG, GDN_CONV, GDN_CONV_DIM), GDN_CONV ** -0.5)
    gdn_a_log = jnp.log(jax.random.uniform(next(ks), (NG, GDN_V_HEADS), jnp.float32, 1.0, 16.0))
    dt = jnp.exp(jax.random.uniform(next(ks), (NG, GDN_V_HEADS), jnp.float32, math.log(1e-3), math.log(1e-1)))
    gdn_dt_bias = dt + jnp.log(-jnp.expm1(-dt))
    gdn_out_norm = gain((NG, GDN_HEAD_DIM_V))
    gdn_w_o = nrm((NG, GDN_VD, D_MODEL), GDN_VD ** -0.5)
    ffn_w_up = nrm((DEPTH, D_MODEL, 2 * D_FF), D_MODEL ** -0.5)
    ffn_conv_w = nrm((DEPTH, FFN_CONV, D_FF), FFN_CONV ** -0.5)
    ffn_conv_b = nrm((DEPTH, D_FF), 0.02)
    ffn_w_down = nrm((DEPTH, D_FF, D_MODEL), D_FF ** -0.5)
    return {"x": x, "c": c, "ada_w": ada_w, "ada_b": ada_b, "norm_g": norm_g,
            "fox_w_in": fox_w_in, "fox_f_bias": fox_f_bias, "fox_q_norm": fox_q_norm,
            "fox_k_norm": fox_k_norm, "fox_w_o": fox_w_o,
            "gdn_w_in": gdn_w_in, "gdn_conv_w": gdn_conv_w, "gdn_a_log": gdn_a_log,
            "gdn_dt_bias": gdn_dt_bias, "gdn_out_norm": gdn_out_norm, "gdn_w_o": gdn_w_o,
            "ffn_w_up": ffn_w_up, "ffn_conv_w": ffn_conv_w, "ffn_conv_b": ffn_conv_b,
            "ffn_w_down": ffn_w_down}


def reference(x, c, ada_w, ada_b, norm_g, fox_w_in, fox_f_bias, fox_q_norm, fox_k_norm, fox_w_o,
              gdn_w_in, gdn_conv_w, gdn_a_log, gdn_dt_bias, gdn_out_norm, gdn_w_o,
              ffn_w_up, ffn_conv_w, ffn_conv_b, ffn_w_down):
    c_act = jax.nn.silu(c)
    for i in range(DEPTH):
        mods = jnp.einsum('bd,sde->sbe', c_act, ada_w[i]) + ada_b[i][:, None, :]
        h, gate = modulate(x, norm_g[i, 0], mods[0])
        j = i // N_MIXERS
        if i % N_MIXERS == 0:
            y = fox_attention(h, fox_w_in[j], fox_f_bias[j], fox_q_norm[j], fox_k_norm[j], fox_w_o[j])
        else:
            y = gated_deltanet(h, gdn_w_in[j], gdn_conv_w[j], gdn_a_log[j], gdn_dt_bias[j],
                               gdn_out_norm[j], gdn_w_o[j])
        x = x + gate * rmsnorm(y, norm_g[i, 1])
        h, gate = modulate(x, norm_g[i, 2], mods[1])
        y = conv_glu(h, ffn_w_up[i], ffn_conv_w[i], ffn_conv_b[i], ffn_w_down[i])
        x = x + gate * rmsnorm(y, norm_g[i, 3])
    return x
```

```cpp
#include <hip/hip_runtime.h>
#include <hip/hip_cooperative_groups.h>
#include <hip/hip_bf16.h>
#include <cstdio>
#include <cstdint>
#include <cmath>
namespace cg = cooperative_groups;
__device__ __forceinline__ int tidx() { int t = (int)__builtin_amdgcn_workitem_id_x(); asm volatile("" : "+v"(t)); return t; }
namespace pg8 {
#define PG8_LAS __attribute__((address_space(3)))
typedef unsigned short bf16_t;
typedef short bf16x8 __attribute__((ext_vector_type(8)));
typedef float f32x4 __attribute__((ext_vector_type(4)));
typedef unsigned u32x4 __attribute__((ext_vector_type(4)));
constexpr int BM = 256, BK = 64, HALF = 128, HTB = HALF * BK * 2  , STAGE_BYTES = 8 * HTB, NXCD = 8, WGM = 8;

__host__ __device__ __forceinline__ int lds_byte(int r, int c) { const int st = (r >> 4) * 2 + (c >> 5), rr = r & 15, cc = c & 31, ob = rr * 64 + cc * 2; return st * 1024 + (ob ^ (((ob >> 9) & 1) << 5)); }
__host__ __device__ __forceinline__ void stage_rc(int b, int& R, int& C) { const int st = b / 1024, sb = b % 1024, swz = sb ^ (((sb >> 9) & 1) << 5); R = (st >> 1) * 16 + swz / 64; C = (st & 1) * 32 + (swz % 64) / 2; }
__host__ __device__ __forceinline__ int perm32(int rho) { const int n = rho >> 4, i = rho & 15; return 8 * (i >> 2) + 4 * n + (i & 3); }

struct Unit { int pm, pn; };
struct Gemm { const bf16_t* A; const bf16_t* Bt; int M, N, K, lda; };

struct StaticOrder {
    int nM, nN, nwg, G, c;
    __host__ __device__ void init(int M, int N, int G_, int c_) { nM = M / BM; nN = N / BM; nwg = nM * nN; G = G_; c = c_; }
    __host__ __device__ bool next(int i, Unit& u) const {
        const long L = (long)i * G + c; if (L >= nwg) return false;
        int wgid = (int)L; { const int q = nwg / NXCD, r = nwg % NXCD, xcd = wgid % NXCD, off = wgid / NXCD; wgid = (xcd < r ? xcd * (q + 1) : r * (q + 1) + (xcd - r) * q) + off; }
        const int nig = WGM * nN, gid = wgid / nig, fm = gid * WGM, gsz = (nM - fm) < WGM ? (nM - fm) : WGM;
        u.pm = fm + ((wgid % nig) % gsz); u.pn = (wgid % nig) / gsz; return true;
    }
    __device__ __forceinline__ void a_ready(const Unit&) const {}
    __device__ __forceinline__ void done(const Unit&) const {}
};

__device__ __forceinline__ unsigned cvt_pk_bf16(float lo, float hi) { unsigned r; asm volatile("v_cvt_pk_bf16_f32 %0, %1, %2" : "=v"(r) : "v"(lo), "v"(hi)); return r; }
template <class Epi, class Sched, bool ALIGN_EPI = false, bool SP2 = false>
__device__ __forceinline__ void gemm_phase(PG8_LAS unsigned char* lds, const Gemm g, const Sched& S, const Epi& E) {
    const int tid = tidx(), wid = __builtin_amdgcn_readfirstlane(tid >> 6), lane = tid & 63, wr = wid >> 2, wc = wid & 3, fr = lane & 15, fq = lane >> 4;
    const int K = g.K, nt = K / BK;
    unsigned voffA[2], voffB[2];
#pragma unroll
    for (int i = 0; i < 2; ++i) { int R, C; stage_rc(tid * 16 + i * 8192, R, C); const int Rb = Epi::PERM ? ((R & ~31) + perm32(R & 31)) : R;
        voffA[i] = (unsigned)(R * g.lda + C) * 2u; voffB[i] = (unsigned)(Rb * K + C) * 2u; }
    const size_t kstep = (size_t)(BK * 2);
    const size_t hstep = (size_t)HALF * K * 2;
    const size_t tstep = 2 * hstep; const size_t hstepA = (size_t)HALF * g.lda * 2, tstepA = 2 * hstepA;
    const unsigned ldsw = (unsigned)wid * 1024u;
    const int aoff = lds_byte(wr * 64 + fr, fq * 8), boff = lds_byte(wc * 32 + fr, fq * 8);
#define PG8_SA(b, h) (((b) * 2 + (h)) * HTB)
#define PG8_SB(b, h) ((4 + (b) * 2 + (h)) * HTB)
#define PG8_STAGE(bufoff, gbase, voff) do { _Pragma("unroll") for (int _i = 0; _i < 2; ++_i) \
        __builtin_amdgcn_global_load_lds((const unsigned*)((const char*)(gbase) + (voff)[_i]), (PG8_LAS unsigned*)(lds + (bufoff) + ldsw + _i * 8192), 16, 0, 0); } while (0)
#define PG8_LDA(dst, b, h) do { _Pragma("unroll") for (int m = 0; m < 4; ++m) _Pragma("unroll") for (int k = 0; k < 2; ++k) dst[m][k] = *(const PG8_LAS bf16x8*)(lds + PG8_SA(b, h) + aoff + m * 2048 + k * 1024); } while (0)
#define PG8_LDB(dst, b, h) do { _Pragma("unroll") for (int n = 0; n < 2; ++n) _Pragma("unroll") for (int k = 0; k < 2; ++k) dst[n][k] = *(const PG8_LAS bf16x8*)(lds + PG8_SB(b, h) + boff + n * 2048 + k * 1024); } while (0)
#define PG8_MMA(ai, bj, At, Bt) do { __builtin_amdgcn_s_setprio(1); _Pragma("unroll") for (int m = 0; m < 4; ++m) _Pragma("unroll") for (int n = 0; n < 2; ++n) _Pragma("unroll") for (int k = 0; k < 2; ++k) \
        acc[ai][bj][m][n] = __builtin_amdgcn_mfma_f32_16x16x32_bf16(Bt[n][k], At[m][k], acc[ai][bj][m][n], 0, 0, 0); __builtin_amdgcn_s_setprio(0); } while (0)
#define PG8_WAIT_V(n) asm volatile("s_waitcnt vmcnt(" #n ")" ::: "memory")
#define PG8_WAIT_L(n) asm volatile("s_waitcnt lgkmcnt(" #n ")" ::: "memory")
#define PG8_BAR __builtin_amdgcn_s_barrier()
#define PG8_SCHED __builtin_amdgcn_sched_barrier(0)
    Unit cur, nxt; int ui = 0;
    if (!S.next(0, cur)) return;
    f32x4 acc[2][2][4][2];
#pragma unroll
    for (int a = 0; a < 2; ++a)
#pragma unroll
        for (int b = 0; b < 2; ++b)
#pragma unroll
            for (int m = 0; m < 4; ++m)
#pragma unroll
                for (int n = 0; n < 2; ++n) acc[a][b][m][n] = (f32x4){0.f, 0.f, 0.f, 0.f};
    bf16x8 At[4][2], B0[2][2], B1[2][2];
    const char* cA = (const char*)g.A + (size_t)cur.pm * tstepA; const char* cB = (const char*)g.Bt + (size_t)cur.pn * tstep;
    S.a_ready(cur);
    if constexpr (SP2) {
        PG8_STAGE(PG8_SB(0, 0), cB, voffB); PG8_STAGE(PG8_SB(0, 1), cB + hstep, voffB); PG8_STAGE(PG8_SA(0, 0), cA, voffA); PG8_STAGE(PG8_SA(0, 1), cA + hstepA, voffA);
        if (wr == 1) PG8_BAR;
        PG8_WAIT_V(2); PG8_BAR;
        PG8_STAGE(PG8_SB(1, 0), cB + kstep, voffB); PG8_STAGE(PG8_SA(1, 0), cA + kstep, voffA); PG8_STAGE(PG8_SB(1, 1), cB + hstep + kstep, voffB);
        PG8_WAIT_V(6); PG8_BAR;
    } else {
        PG8_STAGE(PG8_SB(0, 0), cB, voffB); PG8_STAGE(PG8_SA(0, 0), cA, voffA); PG8_STAGE(PG8_SB(0, 1), cB + hstep, voffB); PG8_STAGE(PG8_SA(0, 1), cA + hstepA, voffA);
        if (wr == 1) PG8_BAR;
        PG8_WAIT_V(4); PG8_BAR;
        PG8_STAGE(PG8_SB(1, 0), cB + kstep, voffB); PG8_STAGE(PG8_SA(1, 0), cA + kstep, voffA); PG8_STAGE(PG8_SB(1, 1), cB + hstep + kstep, voffB);
        PG8_WAIT_V(6); PG8_BAR;
    }
    for (;;) {
        const bool has_next = S.next(ui + 1, nxt);
        const char* nA = has_next ? (const char*)g.A + (size_t)nxt.pm * tstepA : cA; const char* nB = has_next ? (const char*)g.Bt + (size_t)nxt.pn * tstep : cB;
        for (int t = 0; t < nt; t += 2) {
            const bool last = (t == nt - 2);
            const char* a1 = cA + (size_t)(t + 1) * kstep;
            const char* a2 = last ? nA : cA + (size_t)(t + 2) * kstep; const char* b2 = last ? nB : cB + (size_t)(t + 2) * kstep;
            const char* a3 = a2 + kstep; const char* b3 = b2 + kstep;
            if (last && has_next) S.a_ready(nxt);
            if constexpr (SP2) {
            PG8_LDB(B0, 0, 0); PG8_LDB(B1, 0, 1); PG8_SCHED; PG8_LDA(At, 0, 0); PG8_STAGE(PG8_SA(1, 1), a1 + hstepA, voffA);
            PG8_WAIT_V(8); PG8_WAIT_L(0); PG8_BAR; PG8_MMA(0, 0, At, B0); PG8_MMA(0, 1, At, B1); PG8_BAR; PG8_SCHED;
            PG8_LDA(At, 0, 1); PG8_STAGE(PG8_SB(0, 0), b2, voffB); PG8_STAGE(PG8_SB(0, 1), b2 + hstep, voffB); PG8_STAGE(PG8_SA(0, 0), a2, voffA);
            PG8_WAIT_V(8); PG8_WAIT_L(0); PG8_BAR; PG8_MMA(1, 0, At, B0); PG8_MMA(1, 1, At, B1); PG8_BAR; PG8_SCHED;
            PG8_LDB(B0, 1, 0); PG8_LDB(B1, 1, 1); PG8_SCHED; PG8_LDA(At, 1, 0); PG8_STAGE(PG8_SA(0, 1), a2 + hstepA, voffA);
            PG8_WAIT_V(8); PG8_WAIT_L(0); PG8_BAR; PG8_MMA(0, 0, At, B0); PG8_MMA(0, 1, At, B1); PG8_BAR; PG8_SCHED;
            PG8_LDA(At, 1, 1); PG8_STAGE(PG8_SB(1, 0), b3, voffB); PG8_STAGE(PG8_SB(1, 1), b3 + hstep, voffB); PG8_STAGE(PG8_SA(1, 0), a3, voffA);
            PG8_WAIT_V(8); PG8_WAIT_L(0); PG8_BAR; PG8_MMA(1, 0, At, B0); PG8_MMA(1, 1, At, B1); PG8_BAR; PG8_SCHED;
            } else {
            PG8_LDB(B0, 0, 0); PG8_SCHED; PG8_LDA(At, 0, 0); PG8_STAGE(PG8_SA(1, 1), a1 + hstepA, voffA);
            PG8_WAIT_L(8); PG8_BAR; PG8_WAIT_L(0); PG8_MMA(0, 0, At, B0); PG8_BAR; PG8_SCHED;
            PG8_LDB(B1, 0, 1); PG8_STAGE(PG8_SB(0, 0), b2, voffB);
            PG8_BAR; PG8_WAIT_L(0); PG8_MMA(0, 1, At, B1); PG8_BAR;
            PG8_LDA(At, 0, 1); PG8_STAGE(PG8_SA(0, 0), a2, voffA);
            PG8_BAR; PG8_WAIT_L(0); PG8_MMA(1, 0, At, B0); PG8_BAR; PG8_SCHED;
            PG8_STAGE(PG8_SB(0, 1), b2 + hstep, voffB);
            PG8_WAIT_V(6); PG8_BAR; PG8_MMA(1, 1, At, B1); PG8_BAR;
            PG8_LDB(B0, 1, 0); PG8_SCHED; PG8_LDA(At, 1, 0); PG8_STAGE(PG8_SA(0, 1), a2 + hstepA, voffA);
            PG8_WAIT_L(8); PG8_BAR; PG8_WAIT_L(0); PG8_MMA(0, 0, At, B0); PG8_BAR; PG8_SCHED;
            PG8_LDB(B1, 1, 1); PG8_STAGE(PG8_SB(1, 0), b3, voffB);
            PG8_BAR; PG8_WAIT_L(0); PG8_MMA(0, 1, At, B1); PG8_BAR;
            PG8_LDA(At, 1, 1); PG8_STAGE(PG8_SA(1, 0), a3, voffA);
            PG8_BAR; PG8_WAIT_L(0); PG8_MMA(1, 0, At, B0); PG8_BAR; PG8_SCHED;
            PG8_STAGE(PG8_SB(1, 1), b3 + hstep, voffB);
            PG8_WAIT_V(6); PG8_BAR; PG8_MMA(1, 1, At, B1); PG8_BAR;
            }
        }
        if constexpr (ALIGN_EPI) { if (wr == 0) PG8_BAR; }
        if constexpr (!Epi::AFTER_DRAIN) { E(acc, cur, wr, wc, fr, fq); S.done(cur); }
        if (!has_next) break;
#pragma unroll
        for (int a = 0; a < 2; ++a)
#pragma unroll
            for (int b = 0; b < 2; ++b)
#pragma unroll
                for (int m = 0; m < 4; ++m)
#pragma unroll
                    for (int n = 0; n < 2; ++n) acc[a][b][m][n] = (f32x4){0.f, 0.f, 0.f, 0.f};
        cur = nxt; cA = nA; cB = nB; ++ui;
        if constexpr (ALIGN_EPI) { if (wr == 1) PG8_BAR; }
    }
    PG8_WAIT_V(0);
    if constexpr (!ALIGN_EPI) { if (wr == 0) PG8_BAR; }
    PG8_BAR;
    if constexpr (Epi::AFTER_DRAIN) { E.fused(acc, cur, wr, wc, fr, fq, lds, wid, lane); S.done(cur); }
#undef PG8_SA
#undef PG8_SB
#undef PG8_STAGE
#undef PG8_LDA
#undef PG8_LDB
#undef PG8_MMA
#undef PG8_WAIT_V
#undef PG8_WAIT_L
#undef PG8_BAR
#undef PG8_SCHED
}
}
namespace att {
enum { ORDER_NATURAL = 0, ORDER_REVERSED = 1, ORDER_PAIRED = 2, ORDER_XCD = 4 };
constexpr int B = 2, H = 16, HKV = 16, SQ = 8192, SKV = 8192, D = 128;
constexpr int QOFF = 0;
constexpr int WINDOW = SKV;
constexpr float THR = 8.f;
constexpr bool WSKIP = false;

constexpr float SCALE = 0.08838834764831845f;
constexpr int NW = 8, QBLK = 32, KVBLK = 64, QB = NW * QBLK;
constexpr int SHM_V = KVBLK * D * 2, SHM_K = KVBLK * D * 2;
constexpr int LDS_BYTES = 2 * SHM_V + 2 * SHM_K + NW * 64 * 4;
constexpr int FB_OFF = LDS_BYTES, OSTR = 2048, GSTR = 8448;

using bf16 = __hip_bfloat16;
#define ALAS __attribute__((address_space(3)))
typedef short bf16x8 __attribute__((ext_vector_type(8)));
typedef short s16x4 __attribute__((ext_vector_type(4)));
typedef float f32x16 __attribute__((ext_vector_type(16)));
typedef float f32x4 __attribute__((ext_vector_type(4)));
typedef unsigned u32x4 __attribute__((ext_vector_type(4)));
template <class A, class Bt> struct same_t { static constexpr bool v = false; };
template <class A> struct same_t<A, A> { static constexpr bool v = true; };

#define KSWZ(row, colB) ((row) * 256 + ((colB) ^ (((row) & 7) << 4)))
#define SBAR() __builtin_amdgcn_sched_barrier(0)
__device__ __forceinline__ int v_st(int k, int c) { const int kk = (k & ~0xC) | ((k & 4) << 1) | ((k & 8) >> 1); return ((kk >> 3) * 4 + (c >> 5)) * 512 + ((kk & 7) * 32 + (c & 31)) * 2; }
__device__ __forceinline__ int v_rd_base(int lane) { return ((lane & 3) << 3) | (((lane >> 2) & 3) << 6) | (((lane >> 4) & 1) << 5) | (((lane >> 5) & 1) << 8); }
constexpr int v_rd_off(int d0, int ks, int half) { return d0 * 512 + ks * 4096 + half * 2048; }
__device__ __forceinline__ int crow(int r, int hi) { return (r & 3) + 8 * (r >> 2) + 4 * hi; }
__device__ __forceinline__ unsigned cvtpk(float lo, float hi) {
    unsigned r; asm volatile("v_cvt_pk_bf16_f32 %0, %1, %2" : "=v"(r) : "v"(lo), "v"(hi)); return r;
}
__device__ __forceinline__ bf16x8 pack8(f32x4 a, f32x4 b) {
    u32x4 w = {cvtpk(a[0], a[1]), cvtpk(a[2], a[3]), cvtpk(b[0], b[1]), cvtpk(b[2], b[3])};
    return *reinterpret_cast<bf16x8*>(&w);
}
template <class T> __device__ __forceinline__ bf16x8 load8(const T* p) {
    if constexpr (same_t<T, float>::v) { return pack8(*(const f32x4*)p, *(const f32x4*)(p + 4)); }
    else { return *reinterpret_cast<const bf16x8*>(p); }
}
__device__ __forceinline__ void mask_tile(f32x16& p0, f32x16& p1, int dq, unsigned W) {
    const float NEG = -__builtin_inff();
#pragma unroll
    for (int r = 0; r < 16; ++r) {
        const int c = (r & 3) + 8 * (r >> 2);
        if ((unsigned)(dq - c) >= W) p0[r] = NEG;
        if ((unsigned)(dq - c - 32) >= W) p1[r] = NEG;
    }
}
__device__ __forceinline__ void partialSM(f32x16& p0, f32x16& p1, float& m_reg, float& mn, float& alpha) {
    float pmax = p0[0]; for (int r = 1; r < 16; ++r) pmax = fmaxf(pmax, p0[r]); for (int r = 0; r < 16; ++r) pmax = fmaxf(pmax, p1[r]);
    { auto rr = __builtin_amdgcn_permlane32_swap(__float_as_uint(pmax), __float_as_uint(pmax), false, false);
      pmax = fmaxf(__uint_as_float(rr[0]), __uint_as_float(rr[1])); }
    constexpr float C2 = 1.4426950408889634f * SCALE;
    if (__builtin_expect(__all((pmax - m_reg) * SCALE <= THR), 1)) { mn = m_reg; alpha = 1.f; }
    else { mn = fmaxf(m_reg, pmax); alpha = __builtin_amdgcn_exp2f((m_reg - mn) * C2); m_reg = mn; }
    const float mnL = -mn * C2;
    for (int r = 0; r < 16; ++r) p0[r] = fmaf(p0[r], C2, mnL); for (int r = 0; r < 16; ++r) p1[r] = fmaf(p1[r], C2, mnL);
    for (int r = 0; r < 16; ++r) p0[r] = __builtin_amdgcn_exp2f(p0[r]);
}
__device__ __forceinline__ void finishSM(f32x16& p0, f32x16& p1, float alpha, float& l_reg, bf16x8& pa0, bf16x8& pa1, bf16x8& pa2, bf16x8& pa3) {
    for (int r = 0; r < 16; ++r) p1[r] = __builtin_amdgcn_exp2f(p1[r]);
    float ps = 0; for (int r = 0; r < 16; ++r) ps += p0[r]; for (int r = 0; r < 16; ++r) ps += p1[r];
    { auto rr = __builtin_amdgcn_permlane32_swap(__float_as_uint(ps), __float_as_uint(ps), false, false);
      ps = __uint_as_float(rr[0]) + __uint_as_float(rr[1]); }
    l_reg = l_reg * alpha + ps;
#define PK4(P, B_, OUT) do { unsigned a0 = cvtpk(P[B_+0], P[B_+1]), a1 = cvtpk(P[B_+2], P[B_+3]);                          \
        unsigned b0 = cvtpk(P[B_+4], P[B_+5]), b1 = cvtpk(P[B_+6], P[B_+7]);                                             \
        auto r0 = __builtin_amdgcn_permlane32_swap(a0, b0, false, false); auto r1 = __builtin_amdgcn_permlane32_swap(a1, b1, false, false); \
        u32x4 w = {r0[0], r1[0], r0[1], r1[1]}; OUT = *reinterpret_cast<bf16x8*>(&w); } while (0)
    PK4(p0, 0, pa0); PK4(p0, 8, pa1); PK4(p1, 0, pa2); PK4(p1, 8, pa3);
#undef PK4
}
template <int KB, bool SK>
__device__ __forceinline__ void qkt(f32x16& p0, f32x16& p1, const char* K_lds, int r32, int hi, const bf16x8* qr, bool act, const ALAS float* fbp) {
    if (SK && !act) { const float NEG = -__builtin_inff();
#pragma unroll
        for (int r = 0; r < 16; ++r) { p0[r] = NEG; p1[r] = NEG; } return; }
#pragma unroll
    for (int a = 0; a < 4; ++a) { const f32x4 t0 = *(const ALAS f32x4*)(fbp + 8 * a), t1 = *(const ALAS f32x4*)(fbp + 32 + 8 * a);
        p0[4 * a] = t0[0]; p0[4 * a + 1] = t0[1]; p0[4 * a + 2] = t0[2]; p0[4 * a + 3] = t0[3];
        p1[4 * a] = t1[0]; p1[4 * a + 1] = t1[1]; p1[4 * a + 2] = t1[2]; p1[4 * a + 3] = t1[3]; }
    const char* kb[4];
#pragma unroll
    for (int dd = 0; dd < 4; ++dd) kb[dd] = K_lds + KB * SHM_K + KSWZ(r32, (dd * 16 + hi * 8) * 2);
#pragma unroll
    for (int d0 = 0; d0 < 8; ++d0) { const char* a = kb[d0 & 3] + (d0 >> 2) * 128;
        bf16x8 b0 = *reinterpret_cast<const bf16x8*>(a);
        bf16x8 b1 = *reinterpret_cast<const bf16x8*>(a + 32 * 256);
        p0 = __builtin_amdgcn_mfma_f32_32x32x16_bf16(b0, qr[d0], p0, 0, 0, 0);
        p1 = __builtin_amdgcn_mfma_f32_32x32x16_bf16(b1, qr[d0], p1, 0, 0, 0); }
}
template <int VB, bool SK>
__device__ __forceinline__ void pv_tile(f32x16* o, int vb0, bf16x8 pa0, bf16x8 pa1, bf16x8 pa2, bf16x8 pa3, bool act) {
    if (SK && !act) return;
#define TRRD(dst, off) asm volatile("ds_read_b64_tr_b16 %0, %1 offset:%2" : "=&v"(dst) : "v"(vb0), "i"(off) : "memory")
#define PV_D0(d0) do { s16x4 l0, l1, l2, l3, h0, h1, h2, h3; constexpr int b_ = VB * SHM_V + v_rd_off(d0, 0, 0);     \
        TRRD(l0, b_); TRRD(h0, b_ + 2048); TRRD(l1, b_ + 4096); TRRD(h1, b_ + 6144); TRRD(l2, b_ + 8192); TRRD(h2, b_ + 10240); TRRD(l3, b_ + 12288); TRRD(h3, b_ + 14336); \
        asm volatile("s_waitcnt lgkmcnt(0)" ::: "memory"); SBAR();                 \
        o[d0] = __builtin_amdgcn_mfma_f32_32x32x16_bf16(pa0, (bf16x8){l0[0], l0[1], l0[2], l0[3], h0[0], h0[1], h0[2], h0[3]}, o[d0], 0, 0, 0);   \
        o[d0] = __builtin_amdgcn_mfma_f32_32x32x16_bf16(pa1, (bf16x8){l1[0], l1[1], l1[2], l1[3], h1[0], h1[1], h1[2], h1[3]}, o[d0], 0, 0, 0);   \
        o[d0] = __builtin_amdgcn_mfma_f32_32x32x16_bf16(pa2, (bf16x8){l2[0], l2[1], l2[2], l2[3], h2[0], h2[1], h2[2], h2[3]}, o[d0], 0, 0, 0);   \
        o[d0] = __builtin_amdgcn_mfma_f32_32x32x16_bf16(pa3, (bf16x8){l3[0], l3[1], l3[2], l3[3], h3[0], h3[1], h3[2], h3[3]}, o[d0], 0, 0, 0); } while (0)
    PV_D0(0); PV_D0(1); PV_D0(2); PV_D0(3);
#undef PV_D0
#undef TRRD
}

template <class TIn, class TOut> struct BlockRef { const TIn* Q; const TIn* K; const TIn* V; TOut* O; const TIn* G; int P0; int JLO; };
template <class TIn> struct Seam {
    bf16x8 qr[8];
    bf16x8 st_v0, st_v1, st_k0, st_k1; f32x4 sf0, sf1, sf2, sf3;
    f32x4 tq[16];
};
__device__ __forceinline__ int swa_jlo(int P0, int W) { const int lowk = P0 - W + 1; return lowk > 0 ? lowk / KVBLK : 0; }
#define ROW(p, k0, rr) ((p) + (size_t)((k0) + (rr)) * D + sc)
#define VMW() asm volatile("s_waitcnt vmcnt(0)" ::: "memory")
#define VMWN(n) asm volatile("s_waitcnt vmcnt(%0)" :: "i"(n) : "memory")
#define SLOAD_H(Kp, Vp, k0) do { S.st_v0 = load8<TIn>(ROW(Vp, k0, sr)); S.st_v1 = load8<TIn>(ROW(Vp, k0, 32 + sr));              \
                         S.st_k0 = load8<TIn>(ROW(Kp, k0, sr)); S.st_k1 = load8<TIn>(ROW(Kp, k0, 32 + sr)); } while (0)
#define SWRITE_HK(bf) do { *(bf16x8*)(K_lds + (bf) * SHM_K + kws) = S.st_k0; *(bf16x8*)(K_lds + (bf) * SHM_K + kws + 32 * 256) = S.st_k1; } while (0)
#define SWRITE_HV(bf) do { *(bf16x8*)(V_lds + (bf) * SHM_V + vst0) = S.st_v0; *(bf16x8*)(V_lds + (bf) * SHM_V + vst1) = S.st_v1; } while (0)
#define SWRITE_H(bf) do { SWRITE_HV(bf); SWRITE_HK(bf); } while (0)
#define SLOAD_F(p, k0) do { S.sf0 = *(const f32x4*)ROW(p, k0, sr); S.sf1 = *(const f32x4*)(ROW(p, k0, sr) + 4);                \
                            S.sf2 = *(const f32x4*)ROW(p, k0, 32 + sr); S.sf3 = *(const f32x4*)(ROW(p, k0, 32 + sr) + 4); } while (0)
#define SWRITE_KF(bf) do { *(bf16x8*)(K_lds + (bf) * SHM_K + kws) = pack8(S.sf0, S.sf1); *(bf16x8*)(K_lds + (bf) * SHM_K + kws + 32 * 256) = pack8(S.sf2, S.sf3); } while (0)
#define SWRITE_VF(bf) do { *(bf16x8*)(V_lds + (bf) * SHM_V + vst0) = pack8(S.sf0, S.sf1); *(bf16x8*)(V_lds + (bf) * SHM_V + vst1) = pack8(S.sf2, S.sf3); } while (0)
template <class TIn, class TOut>
__device__ __forceinline__ void causal_swa_prime(const BlockRef<TIn, TOut>& cur, int W, char* lds, Seam<TIn>& S) {
    constexpr bool F32 = same_t<TIn, float>::v;
    const int tid = tidx(), wid = __builtin_amdgcn_readfirstlane(tid >> 6), lane = tid & 63, r32 = lane & 31, hi = lane >> 5;
    const int sr = tid >> 4, sc = (tid & 15) * 8, kws = KSWZ(sr, sc * 2); char* K_lds = lds + 2 * SHM_V;
    const int kb0 = cur.JLO * KVBLK;
    for (int d0 = 0; d0 < 8; ++d0) S.qr[d0] = load8<TIn>(cur.Q + (size_t)(wid * QBLK + r32) * D + d0 * 16 + hi * 8);
    if constexpr (F32) { SLOAD_F((const float*)cur.K, kb0); VMW(); SWRITE_KF(0); SBAR(); SLOAD_F((const float*)cur.V, kb0); }
    else { SLOAD_H(cur.K, cur.V, kb0); VMW(); SWRITE_HK(0); }
    __syncthreads();
}
template <class TIn, class TOut>
__device__ __forceinline__ void causal_swa_block(const BlockRef<TIn, TOut>& cur, const BlockRef<TIn, TOut>& nxt, int skv, int W, char* lds, Seam<TIn>& S) {
    constexpr bool F32 = same_t<TIn, float>::v;
    const int tid = tidx(), wid = __builtin_amdgcn_readfirstlane(tid >> 6), lane = tid & 63, r32 = lane & 31, hi = lane >> 5;
    const int j_lo = cur.JLO;
    int j_hi = (cur.P0 + QB - 1) / KVBLK + 1; if (j_hi > skv / KVBLK) j_hi = skv / KVBLK;
    const int NT = j_hi - j_lo;
    const int kbn = nxt.JLO * KVBLK;
    const int qlo = cur.P0 + wid * QBLK, qm = qlo + r32 - 4 * hi;
    char* V_lds = lds; char* K_lds = lds + 2 * SHM_V;
    float* ws = (float*)(lds + 2 * SHM_V + 2 * SHM_K) + wid * 64; float* li_l = ws, * al_l = ws + 32;
    float m_reg = -1e30f, l_reg = 0; f32x16 o[4] = {};
    const int sr = tid >> 4, sc = (tid & 15) * 8, vst0 = v_st(sr, sc), vst1 = v_st(32 + sr, sc), kws = KSWZ(sr, sc * 2);
    const int vb0 = (int)(uintptr_t)V_lds + v_rd_base(lane);
    const TIn* Kh = cur.K; const TIn* Vh = cur.V;
#define RESC(a) do { if (__any((a) < 1.f)) { if (hi == 0) al_l[r32] = (a); asm volatile("s_waitcnt lgkmcnt(0)" ::: "memory");              \
                     for (int d_ = 0; d_ < 4; ++d_) for (int r = 0; r < 16; ++r) o[d_][r] *= al_l[crow(r, hi)]; } } while (0)
#define KBASE(t) ((j_lo + (t)) * KVBLK)
    const ALAS float* fb3 = (const ALAS float*)((ALAS char*)lds + FB_OFF) + 4 * hi;
#define FBP(t) (fb3 + KBASE(t))
#define ACT(t) (KBASE(t) <= qlo + QBLK - 1 && KBASE(t) + KVBLK - 1 >= qlo - W + 1)
#define MASKT(P0_, P1_, t) do { const int kb_ = KBASE(t); if ((!SK || ACT(t)) && (kb_ + KVBLK - 1 > qlo || kb_ <= qlo + QBLK - 1 - W)) mask_tile(P0_, P1_, qm - kb_, (unsigned)W); } while (0)
    constexpr int NQL = F32 ? 16 : 8;
    constexpr bool SK = WSKIP && !F32;
#define SEAM_K0() do { VMWN(NQL); if constexpr (F32) { SWRITE_KF(0); SBAR(); SLOAD_F((const float*)nxt.V, kbn); } else { SWRITE_HK(0); } SBAR(); } while (0)
    f32x16 pA0, pA1, pB0, pB1; float mnA, mnB, alA, alB; bf16x8 pa0, pa1, pa2, pa3;
    if constexpr (F32) { VMW(); SWRITE_VF(0); SBAR(); } else { SWRITE_HV(0); SBAR(); }
    if (NT > 1) { if constexpr (F32) SLOAD_F((const float*)Kh, KBASE(1)); else SLOAD_H(Kh, Vh, KBASE(1)); }
    SBAR(); qkt<0, SK>(pA0, pA1, K_lds, r32, hi, S.qr, ACT(0), FBP(0));
    if constexpr (F32) { if (NT > 1) { VMW(); SWRITE_KF(1); SBAR(); SLOAD_F((const float*)Vh, KBASE(1)); } }
    MASKT(pA0, pA1, 0); partialSM(pA0, pA1, m_reg, mnA, alA);
    if (NT > 1) { VMW(); if constexpr (F32) { SWRITE_VF(1); SBAR(); if (NT > 2) SLOAD_F((const float*)Kh, KBASE(2)); } else SWRITE_H(1); }
    __syncthreads();
#define HALF_STEP(PX0, PX1, mnX, alX, PY0, PY1, alY, t, KB, VB, SB) do {                                                      \
        SBAR(); qkt<KB, SK>(PX0, PX1, K_lds, r32, hi, S.qr, ACT(t), FBP(t));                                             \
        finishSM(PY0, PY1, alY, l_reg, pa0, pa1, pa2, pa3); SBAR();                                                           \
        if ((t) + 1 < NT) { if constexpr (F32) { VMW(); SWRITE_KF(SB); SBAR(); SLOAD_F((const float*)Vh, KBASE((t) + 1)); }  \
                            else { SLOAD_H(Kh, Vh, KBASE((t) + 1)); } SBAR(); }                                               \
        pv_tile<VB, SK>(o, vb0, pa0, pa1, pa2, pa3, ACT((t) - 1)); MASKT(PX0, PX1, (t)); partialSM(PX0, PX1, m_reg, mnX, alX);                                        \
        __syncthreads();                                                                                                      \
        if ((t) + 1 < NT) { VMW(); if constexpr (F32) { SWRITE_VF(SB); SBAR(); if ((t) + 2 < NT) SLOAD_F((const float*)Kh, KBASE((t) + 2)); } \
                            else { SWRITE_H(SB); } }                                                                          \
        RESC(alX); __syncthreads(); } while (0)
    for (int t = 1; t + 1 < NT; t += 2) {
        HALF_STEP(pB0, pB1, mnB, alB, pA0, pA1, alA, t, 1, 0, 0);
        HALF_STEP(pA0, pA1, mnA, alA, pB0, pB1, alB, t + 1, 0, 1, 1);
    }
    const bool even = (NT & 1) == 0;
    if (even) { SBAR(); qkt<1, SK>(pB0, pB1, K_lds, r32, hi, S.qr, ACT(NT - 1), FBP(NT - 1)); SBAR(); }
#define QROW(e) (nxt.Q + (size_t)(wid * QBLK + r32) * D + ((e) >> 1) * 16 + hi * 8 + ((e) & 1) * 4)
    if constexpr (F32) { SLOAD_F((const float*)nxt.K, kbn); SBAR();
#pragma unroll
        for (int e = 0; e < 8; ++e) S.tq[e] = *(const f32x4*)QROW(e); }
    else { SLOAD_H(nxt.K, nxt.V, kbn); SBAR();
#pragma unroll
        for (int d0 = 0; d0 < 8; ++d0) S.qr[d0] = load8<TIn>(nxt.Q + (size_t)(wid * QBLK + r32) * D + d0 * 16 + hi * 8); }
    SBAR();
    finishSM(pA0, pA1, alA, l_reg, pa0, pa1, pa2, pa3); SBAR();
    if constexpr (F32) {
#pragma unroll
        for (int e = 8; e < 16; ++e) S.tq[e] = *(const f32x4*)QROW(e); SBAR(); }
#undef QROW
    pv_tile<0, SK>(o, vb0, pa0, pa1, pa2, pa3, ACT(even ? NT - 2 : NT - 1));
    if (even) { MASKT(pB0, pB1, NT - 1); partialSM(pB0, pB1, m_reg, mnB, alB); __syncthreads(); RESC(alB);
        finishSM(pB0, pB1, alB, l_reg, pa0, pa1, pa2, pa3); SBAR(); pv_tile<1, SK>(o, vb0, pa0, pa1, pa2, pa3, ACT(NT - 1)); }
    SBAR(); SEAM_K0();
    if (hi == 0) li_l[r32] = l_reg; asm volatile("s_waitcnt lgkmcnt(0)" ::: "memory");
    float rli[16];
#pragma unroll
    for (int r = 0; r < 16; ++r) rli[r] = __builtin_amdgcn_rcpf(li_l[crow(r, hi)]);
    TOut* Ow = cur.O + (size_t)(wid * QBLK) * OSTR;
#pragma unroll
    for (int r = 0; r < 16; ++r) { const int orow = crow(r, hi);
#pragma unroll
        for (int d0 = 0; d0 < 4; ++d0) {
            const float v = o[d0][r] * rli[r];
            const float vn = __shfl_xor(v, 1);
            if ((r32 & 1) == 0) *(unsigned*)(Ow + (size_t)orow * OSTR + d0 * 32 + r32) = cvtpk(v, vn); } }
    if constexpr (F32) {
#pragma unroll
        for (int d0 = 0; d0 < 8; ++d0) S.qr[d0] = pack8(S.tq[2 * d0], S.tq[2 * d0 + 1]); }
    __syncthreads();
#undef RESC
#undef KBASE
#undef FBP
#undef ACT
#undef MASKT
#undef SEAM_K0
#undef HALF_STEP
}
#undef ROW
#undef VMW
#undef VMWN
#undef SLOAD_H
#undef SWRITE_HK
#undef SWRITE_HV
#undef SWRITE_H
#undef SLOAD_F
#undef SWRITE_KF
#undef SWRITE_VF

}

#define LAS __attribute__((address_space(3)))
typedef unsigned short bf16_t;
typedef short bf16x8 __attribute__((ext_vector_type(8)));
typedef short s16x4 __attribute__((ext_vector_type(4)));
typedef float f32x4 __attribute__((ext_vector_type(4)));
typedef unsigned u32x4 __attribute__((ext_vector_type(4)));
typedef unsigned u32x2 __attribute__((ext_vector_type(2)));

constexpr int NB = 2, SEQ = 8192, T = NB * SEQ, DM = 2048, DFF = 5632;
constexpr int NTHR = 512, NWV = 8;
constexpr float EPS = 1e-6f;
constexpr int FOX_N = 8208, FOX_LD = 8448;
constexpr int GDN_ROWS = 12544;

constexpr size_t MiB = 1u << 20;
constexpr size_t WS_MODS = 0, WS_FL = 1 * MiB, WS_FB = 2 * MiB, WS_AB = 3 * MiB, WS_GB = 7 * MiB, WS_TB = 11 * MiB;
constexpr size_t WS_WA = 17 * MiB, WS_WB = 66 * MiB, WS_H = 88 * MiB, WS_Y = 152 * MiB, WS_BIG = 216 * MiB;
constexpr size_t WS_P = WS_BIG, WS_QH = WS_BIG + 264 * MiB, WS_KH = WS_QH + 64 * MiB, WS_VH = WS_KH + 64 * MiB;
constexpr size_t WS_GV = WS_BIG;
constexpr size_t WS_QKV = WS_BIG, WS_QN = WS_BIG + 256 * MiB, WS_KN = WS_QN + 64 * MiB, WS_KT = WS_KN + 64 * MiB, WS_VT = WS_KT + 64 * MiB;
constexpr size_t WS_TM = WS_BIG, WS_QKM = WS_BIG + 64 * MiB, WS_O = WS_BIG + 128 * MiB, WS_Z = WS_QN;
constexpr size_t WS_END = WS_VT + 128 * MiB;
static_assert((size_t)GDN_ROWS * DM * 2 <= WS_WB - WS_WA && (size_t)DM * DFF * 2 <= WS_H - WS_WB, "weight regions");

constexpr int LDS_TOTAL = 147456;

__device__ __forceinline__ float bf2f(unsigned h) { return __uint_as_float(h << 16); }
typedef float f32x2_t __attribute__((ext_vector_type(2))); typedef __bf16 bf16x2_t __attribute__((ext_vector_type(2)));
__device__ __forceinline__ unsigned pk2(float lo, float hi) { const f32x2_t v = {lo, hi}; const bf16x2_t b = __builtin_convertvector(v, bf16x2_t); return __builtin_bit_cast(unsigned, b); }
__device__ __forceinline__ void unpack8(u32x4 w, float* f) {
    f[0] = __uint_as_float(w.x << 16); f[1] = __uint_as_float(w.x & 0xffff0000u); f[2] = __uint_as_float(w.y << 16); f[3] = __uint_as_float(w.y & 0xffff0000u);
    f[4] = __uint_as_float(w.z << 16); f[5] = __uint_as_float(w.z & 0xffff0000u); f[6] = __uint_as_float(w.w << 16); f[7] = __uint_as_float(w.w & 0xffff0000u);
}
__device__ __forceinline__ u32x4 pack8f(const float* f) { u32x4 w; w.x = pk2(f[0], f[1]); w.y = pk2(f[2], f[3]); w.z = pk2(f[4], f[5]); w.w = pk2(f[6], f[7]); return w; }
__device__ __forceinline__ float wave_sum(float v) {
#pragma unroll
    for (int o = 1; o < 64; o <<= 1) v += __shfl_xor(v, o);
    return v;
}
__device__ __forceinline__ float sum16(float v) { v += __shfl_xor(v, 1); v += __shfl_xor(v, 2); v += __shfl_xor(v, 4); v += __shfl_xor(v, 8); return v; }
__device__ __forceinline__ float sigmoidf_(float x) { return 1.f / (1.f + __expf(-x)); }
__device__ __forceinline__ float siluf_(float x) { return x / (1.f + __expf(-x)); }

struct EpiStore {
    static constexpr bool PERM = true, AFTER_DRAIN = false;
    bf16_t* O; int ldc; int ncols; float* aux; int aux_tile, aux_n;
    __device__ __forceinline__ void operator()(const pg8::f32x4 (&acc)[2][2][4][2], const pg8::Unit& u, int wr, int wc, int fr, int fq) const {
        const int row0 = u.pm * 256 + wr * 64 + fr, col0 = u.pn * 256 + wc * 32 + 8 * fq;
#pragma unroll
        for (int ai = 0; ai < 2; ++ai)
#pragma unroll
            for (int m = 0; m < 4; ++m) { const int row = row0 + ai * 128 + m * 16; bf16_t* rowp = O + (size_t)row * ldc + col0;
#pragma unroll
                for (int bj = 0; bj < 2; ++bj) { const pg8::f32x4 v0 = acc[ai][bj][m][0], v1 = acc[ai][bj][m][1];
                    if (col0 + bj * 128 < ncols) { u32x4 w; w.x = pk2(v0[0], v0[1]); w.y = pk2(v0[2], v0[3]); w.z = pk2(v1[0], v1[1]); w.w = pk2(v1[2], v1[3]);
                        *(u32x4*)(rowp + bj * 128) = w; }
                    if (u.pn == aux_tile) { const int ct = wc * 32 + 8 * fq + bj * 128;
                        if (ct < aux_n) { float* ap = aux + (size_t)row * aux_n + ct; *(pg8::f32x4*)ap = v0; *(pg8::f32x4*)(ap + 4) = v1; } } } }
    }
};
__device__ __forceinline__ void run_gemm(LAS unsigned char* lds, const bf16_t* A, int lda, const bf16_t* Bt, int N, int K, bf16_t* O, int ldc, int ncols, float* aux, int aux_tile, int aux_n) {
    pg8::Gemm g{A, Bt, T, N, K, lda}; pg8::StaticOrder S; S.init(T, N, (int)gridDim.x, (int)blockIdx.x);
    EpiStore E{O, ldc, ncols, aux, aux_tile, aux_n};
    pg8::gemm_phase<EpiStore, pg8::StaticOrder, true, true>(lds, g, S, E);
}

__device__ __forceinline__ void convert_weight(LAS unsigned char* lds, const float* W, int K, int N, bf16_t* WT, int seg1, int add1, int seg2, int add2) {
    const int lane = tidx() & 63, wave = tidx() >> 6;
    LAS float* scr = (LAS float*)(lds + wave * 16384);
    const int gw = blockIdx.x * NWV + wave, NGW = gridDim.x * NWV;
    const int nblk = (N + 31) / 32, nitems = (K / 64) * nblk;
    const int c4 = (lane & 7) * 4, c = lane & 7;
    f32x4 vld[8];
#define CW_LOAD(item_, dst_) do { const int kb_ = (item_) / nblk, nb_ = (item_) % nblk, nn_ = 32 * nb_ + c4; const bool ok_ = nn_ < N; \
        _Pragma("unroll") for (int i_ = 0; i_ < 8; ++i_) { const int kk_ = 8 * i_ + (lane >> 3); dst_[i_] = ok_ ? *(const f32x4*)(W + (size_t)(64 * kb_ + kk_) * N + nn_) : (f32x4){0.f, 0.f, 0.f, 0.f}; } } while (0)
    if (gw < nitems) CW_LOAD(gw, vld);
    for (int item = gw; item < nitems; item += NGW) {
        const int kb = item / nblk, nb = item % nblk, k0 = 64 * kb, n0 = 32 * nb;
#pragma unroll
        for (int i = 0; i < 8; ++i) { const int kk = 8 * i + (lane >> 3); LAS float* sp = scr + kk * 33 + c4; sp[0] = vld[i][0]; sp[1] = vld[i][1]; sp[2] = vld[i][2]; sp[3] = vld[i][3]; }
        if (item + NGW < nitems) CW_LOAD(item + NGW, vld);
        asm volatile("s_waitcnt lgkmcnt(0)" ::: "memory");
#pragma unroll
        for (int j = 0; j < 4; ++j) { const int nl = (lane >> 3) + 8 * j, n = n0 + nl; const LAS float* s = scr + (8 * c) * 33 + nl;
            u32x4 o; o.x = pk2(s[0 * 33], s[1 * 33]); o.y = pk2(s[2 * 33], s[3 * 33]); o.z = pk2(s[4 * 33], s[5 * 33]); o.w = pk2(s[6 * 33], s[7 * 33]);
            if (n < N) { const int row = n + (n >= seg2 ? add2 : (n >= seg1 ? add1 : 0)); *(u32x4*)(WT + (size_t)row * K + k0 + 8 * c) = o; } }
        asm volatile("s_waitcnt lgkmcnt(0)" ::: "memory");
    }
#undef CW_LOAD
    __syncthreads();
}
constexpr int NOSEG = 0x7fffffff;

__device__ __forceinline__ void mods_phase(LAS unsigned char* lds, const float* c, const float* ada_w, const float* ada_b, float* Mods) {
    const int tid = tidx(), lane = tid & 63, wave = tid >> 6, e4 = lane & 15, ds = lane >> 4;
    LAS float* red = (LAS float*)lds;
    for (int u = blockIdx.x; u < 4 * 96; u += gridDim.x) {
        const int is = u / 96, e0 = (u % 96) * 64;
        f32x4 a0 = {0.f, 0.f, 0.f, 0.f}, a1 = {0.f, 0.f, 0.f, 0.f};
#pragma unroll 8
        for (int it = 0; it < 64; ++it) { const int d = 256 * wave + 4 * it + ds;
            const f32x4 wv = *(const f32x4*)(ada_w + ((size_t)is * DM + d) * (3 * DM) + e0 + 4 * e4);
            const float c0 = siluf_(c[d]), c1 = siluf_(c[DM + d]);
            a0 += wv * c0; a1 += wv * c1; }
#pragma unroll
        for (int k = 0; k < 4; ++k) { a0[k] += __shfl_xor(a0[k], 16); a0[k] += __shfl_xor(a0[k], 32); a1[k] += __shfl_xor(a1[k], 16); a1[k] += __shfl_xor(a1[k], 32); }
        if (lane < 16) {
#pragma unroll
            for (int k = 0; k < 4; ++k) { red[(wave * 2 + 0) * 64 + 4 * e4 + k] = a0[k]; red[(wave * 2 + 1) * 64 + 4 * e4 + k] = a1[k]; } }
        __syncthreads();
        if (tid < 128) { const int b = tid >> 6, e = tid & 63; float s = 0.f;
#pragma unroll
            for (int w = 0; w < 8; ++w) s += red[(w * 2 + b) * 64 + e];
            Mods[((size_t)is * 2 + b) * (3 * DM) + e0 + e] = s + ada_b[(size_t)is * (3 * DM) + e0 + e]; }
        __syncthreads();
    }
}

__device__ __forceinline__ void row_phase(const float* xin, float* xout, const bf16_t* Yb, const float* gate, const float* gpost, bf16_t* Hout, const float* gpre, const float* shift, const float* scale) {
    const int lane = tidx() & 63, wave = __builtin_amdgcn_readfirstlane(tidx() >> 6);
    const int gw = blockIdx.x * NWV + wave, NGW = gridDim.x * NWV;
    for (int row = gw; row < T; row += 2 * NGW) {
        const int row1 = row + NGW; const int b = row >> 13; const size_t mo = (size_t)b * 3 * DM;
        f32x4 x0[8], x1[8];
#pragma unroll
        for (int j = 0; j < 8; ++j) { x0[j] = *(const f32x4*)(xin + (size_t)row * DM + 4 * lane + 256 * j); x1[j] = *(const f32x4*)(xin + (size_t)row1 * DM + 4 * lane + 256 * j); }
        if (Yb) {
            u32x2 w0[8], w1[8]; float s0 = 0.f, s1 = 0.f;
#define UNPK4(w) ((f32x4){__uint_as_float((w).x << 16), __uint_as_float((w).x & 0xffff0000u), __uint_as_float((w).y << 16), __uint_as_float((w).y & 0xffff0000u)})
#pragma unroll
            for (int j = 0; j < 8; ++j) { w0[j] = *(const u32x2*)(Yb + (size_t)row * DM + 4 * lane + 256 * j); w1[j] = *(const u32x2*)(Yb + (size_t)row1 * DM + 4 * lane + 256 * j);
                const f32x4 a = UNPK4(w0[j]), c = UNPK4(w1[j]);
                s0 += (a[0] * a[0] + a[1] * a[1]) + (a[2] * a[2] + a[3] * a[3]); s1 += (c[0] * c[0] + c[1] * c[1]) + (c[2] * c[2] + c[3] * c[3]); }
            const float r0 = rsqrtf(wave_sum(s0) * (1.f / DM) + EPS), r1 = rsqrtf(wave_sum(s1) * (1.f / DM) + EPS);
#pragma unroll
            for (int j = 0; j < 8; ++j) { const int c = 4 * lane + 256 * j; const f32x4 m = *(const f32x4*)(gate + mo + c) * *(const f32x4*)(gpost + c);
                x0[j] += m * (UNPK4(w0[j]) * r0); x1[j] += m * (UNPK4(w1[j]) * r1); }
#undef UNPK4
        }
        if (xout) {
#pragma unroll
            for (int j = 0; j < 8; ++j) { *(f32x4*)(xout + (size_t)row * DM + 4 * lane + 256 * j) = x0[j]; *(f32x4*)(xout + (size_t)row1 * DM + 4 * lane + 256 * j) = x1[j]; }
        }
        if (Hout) {
            float s0 = 0.f, s1 = 0.f;
#pragma unroll
            for (int j = 0; j < 8; ++j) { s0 += (x0[j][0] * x0[j][0] + x0[j][1] * x0[j][1]) + (x0[j][2] * x0[j][2] + x0[j][3] * x0[j][3]);
                s1 += (x1[j][0] * x1[j][0] + x1[j][1] * x1[j][1]) + (x1[j][2] * x1[j][2] + x1[j][3] * x1[j][3]); }
            const float r0 = rsqrtf(wave_sum(s0) * (1.f / DM) + EPS), r1 = rsqrtf(wave_sum(s1) * (1.f / DM) + EPS);
#pragma unroll
            for (int j = 0; j < 8; ++j) { const int c = 4 * lane + 256 * j; const f32x4 a = *(const f32x4*)(gpre + c) * (*(const f32x4*)(scale + mo + c) + 1.f), sh = *(const f32x4*)(shift + mo + c);
                const f32x4 h0 = x0[j] * r0 * a + sh, h1 = x1[j] * r1 * a + sh; u32x2 w0, w1; w0.x = pk2(h0[0], h0[1]); w0.y = pk2(h0[2], h0[3]); w1.x = pk2(h1[0], h1[1]); w1.y = pk2(h1[2], h1[3]);
                *(u32x2*)(Hout + (size_t)row * DM + c) = w0; *(u32x2*)(Hout + (size_t)row1 * DM + c) = w1; }
        }
    }
}

__device__ __forceinline__ void fox_prep(const bf16_t* P, const float* FL, const float* fbias, const float* qg, const float* kg, bf16_t* Qh, bf16_t* Kh, bf16_t* Vh, float* FB) {
    const int lane = tidx() & 63, wave = tidx() >> 6;
    const int gw = blockIdx.x * NWV + wave, NGW = gridDim.x * NWV;
    const int dl = (lane & 15) * 8;
    float gq[8], gk[8];
#pragma unroll
    for (int j = 0; j < 8; ++j) { gq[j] = qg[dl + j]; gk[j] = kg[dl + j]; }
    for (int row = gw; row < T; row += NGW) {
        const int b = row >> 13, s = row & (SEQ - 1);
#pragma unroll
        for (int part = 0; part < 3; ++part) {
#pragma unroll
            for (int p = 0; p < 4; ++p) {
                const int col = p * 512 + lane * 8, h = col >> 7;
                const u32x4 w = *(const u32x4*)(P + (size_t)row * FOX_LD + part * 2048 + col);
                bf16_t* dst = (part == 0 ? Qh : (part == 1 ? Kh : Vh)) + (((size_t)(b * 16 + h) * SEQ + s) * 128 + dl);
                if (part == 2) { *(u32x4*)dst = w; }
                else { float f[8]; unpack8(w, f); float ss = 0.f;
#pragma unroll
                    for (int j = 0; j < 8; ++j) ss += f[j] * f[j];
                    const float r = rsqrtf(sum16(ss) * (1.f / 128.f) + EPS);
#pragma unroll
                    for (int j = 0; j < 8; ++j) f[j] = f[j] * r * (part == 0 ? gq[j] : gk[j]);
                    *(u32x4*)dst = pack8f(f); }
            }
        }
    }
    if (wave == 0 && blockIdx.x < 32) {
        const int bh = blockIdx.x, b = bh >> 4, h = bh & 15; const float fb = fbias[h];
        const float* src = FL + ((size_t)b * SEQ + lane * 128) * 16 + h;
        float tot = 0.f;
#pragma unroll 16
        for (int i = 0; i < 128; ++i) { const float x = src[(size_t)i * 16] + fb; tot += (x >= 0.f) ? -log1pf(expf(-x)) : (x - log1pf(expf(x))); }
        float incl = tot;
#pragma unroll
        for (int o = 1; o < 64; o <<= 1) { const float t = __shfl_up(incl, o); if (lane >= o) incl += t; }
        float run = incl - tot;
        float* dst = FB + (size_t)bh * SEQ + lane * 128;
#pragma unroll 16
        for (int i = 0; i < 128; ++i) { const float x = src[(size_t)i * 16] + fb; run += (x >= 0.f) ? -log1pf(expf(-x)) : (x - log1pf(expf(x))); dst[i] = -run * 11.313708498984761f; }
    }
}

__device__ __forceinline__ void fox_attention(char* lds, const bf16_t* Qh, const bf16_t* Kh, const bf16_t* Vh, const bf16_t* P, const float* FB, bf16_t* AO, const float* qg, const float* kg) {
    using abf = att::bf16; typedef att::BlockRef<abf, abf> Ref;
    float thr_t;
    { const int ll = tidx() & 63; float mq = fmaxf(fabsf(qg[ll]), fabsf(qg[64 + ll])), mk = fmaxf(fabsf(kg[ll]), fabsf(kg[64 + ll]));
#pragma unroll
      for (int o = 1; o < 64; o <<= 1) { mq = fmaxf(mq, __shfl_xor(mq, o)); mk = fmaxf(mk, __shfl_xor(mk, o)); }
      thr_t = 2.04f * 128.f * mq * mk + 32.f * 11.313708498984761f; }
    for (int L = blockIdx.x; L < 512; L += gridDim.x) {
        const int bh = L >> 4, x = L & 15, b = bh >> 4, h = bh & 15;
        __syncthreads();
        {
            const f32x4* src = (const f32x4*)(FB + (size_t)bh * SEQ); LAS f32x4* dst = (LAS f32x4*)((LAS char*)lds + att::FB_OFF);
            const int tl = tidx();
#pragma unroll
            for (int i = 0; i < 4; ++i) dst[tl + i * NTHR] = src[tl + i * NTHR];
        }
        Ref r0, r1;
        const int qb0 = x, qb1 = 31 - x;
        __syncthreads();
        int jl[2];
#pragma unroll
        for (int pass = 0; pass < 2; ++pass) { const int P0 = (pass ? qb1 : qb0) * 256; const LAS float* tbl = (const LAS float*)((LAS char*)lds + att::FB_OFF);
            const float ref = tbl[P0]; int lo = 0, hi = P0 >> 6;
            while (lo < hi) { const int mid = (lo + hi + 1) >> 1; if (ref - tbl[64 * mid - 1] > thr_t) lo = mid; else hi = mid - 1; }
            jl[pass] = __builtin_amdgcn_readfirstlane(lo); }
        r0.Q = (const abf*)Qh + ((size_t)bh * SEQ + (size_t)qb0 * 256) * 128; r0.K = (const abf*)Kh + (size_t)bh * SEQ * 128; r0.V = (const abf*)Vh + (size_t)bh * SEQ * 128;
        r0.O = (abf*)AO + ((size_t)b * SEQ + (size_t)qb0 * 256) * DM + h * 128; r0.G = nullptr; r0.P0 = qb0 * 256; r0.JLO = jl[0];
        r1 = r0;
        r1.Q = (const abf*)Qh + ((size_t)bh * SEQ + (size_t)qb1 * 256) * 128;
        r1.O = (abf*)AO + ((size_t)b * SEQ + (size_t)qb1 * 256) * DM + h * 128; r1.P0 = qb1 * 256; r1.JLO = jl[1];
        att::Seam<abf> S;
        att::causal_swa_prime<abf, abf>(r0, SEQ, lds, S);
        att::causal_swa_block<abf, abf>(r0, r1, SEQ, SEQ, lds, S);
        att::causal_swa_block<abf, abf>(r1, r1, SEQ, SEQ, lds, S);
        asm volatile("s_waitcnt vmcnt(0)" ::: "memory");
        __syncthreads();
#pragma unroll 1
        for (int pass = 0; pass < 2; ++pass) { const int qb = pass ? qb1 : qb0;
#pragma unroll 2
            for (int i = 0; i < 8; ++i) { const int idx = tidx() + NTHR * i, row = idx >> 4, c8 = idx & 15; const size_t trow = (size_t)b * SEQ + (size_t)qb * 256 + row;
                bf16_t* op = AO + trow * DM + h * 128 + c8 * 8; const bf16_t* gp = P + trow * FOX_LD + 6160 + h * 128 + c8 * 8;
                float o[8], g[8]; unpack8(*(const u32x4*)op, o); unpack8(*(const u32x4*)gp, g);
#pragma unroll
                for (int j = 0; j < 8; ++j) o[j] *= sigmoidf_(g[j]);
                *(u32x4*)op = pack8f(o); } }
    }
    asm volatile("s_waitcnt vmcnt(0)" ::: "memory");
    __syncthreads();
}

__device__ __forceinline__ void glu_phase(bf16_t* GV, const float* cw, const float* cb) {
    constexpr int LD = 2 * DFF, NCG = DFF / 8, RUN = 32, NTASK = (T / RUN) * NCG;
    const int gt = blockIdx.x * NTHR + tidx(), NGT = gridDim.x * NTHR;
    for (int task = gt; task < NTASK; task += NGT) {
        const int run = task / NCG, cgp = task % NCG, col = cgp * 8, t0 = run * RUN;
        float w0[8], w1[8], w2[8], bb[8];
#pragma unroll
        for (int j = 0; j < 8; ++j) { w0[j] = cw[col + j]; w1[j] = cw[DFF + col + j]; w2[j] = cw[2 * DFF + col + j]; bb[j] = cb[col + j]; }
        float h0[8], h1[8];
        if ((t0 & (SEQ - 1)) == 0) {
#pragma unroll
            for (int j = 0; j < 8; ++j) { h0[j] = 0.f; h1[j] = 0.f; }
        } else { unpack8(*(const u32x4*)(GV + (size_t)(t0 - 2) * LD + col), h0); unpack8(*(const u32x4*)(GV + (size_t)(t0 - 1) * LD + col), h1); }
#pragma unroll 4
        for (int i = 0; i < RUN; ++i) {
            bf16_t* rp = GV + (size_t)(t0 + i) * LD + col;
            float g[8], v[8], o[8]; unpack8(*(const u32x4*)rp, g); unpack8(*(const u32x4*)(rp + DFF), v);
#pragma unroll
            for (int j = 0; j < 8; ++j) { const float a = w0[j] * h0[j] + w1[j] * h1[j] + w2[j] * g[j] + bb[j];
                o[j] = 0.5f * a * (1.f + erff(a * 0.70710678118654752f)) * v[j]; h0[j] = h1[j]; h1[j] = g[j]; }
            *(u32x4*)(rp + DFF) = pack8f(o);
        }
    }
}

__device__ __forceinline__ void gdn_prep(const bf16_t* QKV, const float* AB, const float* cw, const float* a_log, const float* dt_bias,
                                         bf16_t* qn, bf16_t* kn, bf16_t* kT, bf16_t* vT, float* Gt, float* Bt) {
    const int gt = blockIdx.x * NTHR + tidx(), NGT = gridDim.x * NTHR;
    for (int i = gt; i < T * 32; i += NGT) { const int t = i >> 5, hv = i & 31;
        const float a = AB[(size_t)t * 64 + hv] + dt_bias[hv], bq = AB[(size_t)t * 64 + 32 + hv];
        const float sp = a > 20.f ? a : log1pf(expf(a));
        Gt[i] = -expf(a_log[hv]) * sp; Bt[i] = 1.f / (1.f + expf(-bq)); }
    for (int task = gt; task < 256 * 1024; task += NGT) {
        const int chunk = task >> 10, cgp = task & 1023, col = cgp * 8, n = chunk & 127, row0 = chunk * 64;
        const int type = col < 2048 ? 0 : (col < 4096 ? 1 : 2);
        float w0[8], w1[8], w2[8], w3[8], h0[8], h1[8], h2[8];
#pragma unroll
        for (int j = 0; j < 8; ++j) { w0[j] = cw[col + j]; w1[j] = cw[8192 + col + j]; w2[j] = cw[2 * 8192 + col + j]; w3[j] = cw[3 * 8192 + col + j]; }
        if (n == 0) {
#pragma unroll
            for (int j = 0; j < 8; ++j) { h0[j] = 0.f; h1[j] = 0.f; h2[j] = 0.f; }
        } else { unpack8(*(const u32x4*)(QKV + (size_t)(row0 - 3) * 8192 + col), h0); unpack8(*(const u32x4*)(QKV + (size_t)(row0 - 2) * 8192 + col), h1); unpack8(*(const u32x4*)(QKV + (size_t)(row0 - 1) * 8192 + col), h2); }
        const float qs = type == 0 ? 0.08838834764831845f : 1.f;
        for (int rb = 0; rb < 8; ++rb) {
            float yv[8][8];
#pragma unroll
            for (int rr = 0; rr < 8; ++rr) {
                const int t = row0 + rb * 8 + rr; float xv[8]; unpack8(*(const u32x4*)(QKV + (size_t)t * 8192 + col), xv);
                float ss = 0.f;
#pragma unroll
                for (int j = 0; j < 8; ++j) { float y = w0[j] * h0[j] + w1[j] * h1[j] + w2[j] * h2[j] + w3[j] * xv[j]; h0[j] = h1[j]; h1[j] = h2[j]; h2[j] = xv[j];
                    y = siluf_(y); yv[rr][j] = y; ss += y * y; }
                if (type < 2) { const float r = rsqrtf(sum16(ss) + EPS) * qs;
#pragma unroll
                    for (int j = 0; j < 8; ++j) yv[rr][j] *= r;
                    *(u32x4*)((type == 0 ? qn : kn) + (size_t)t * 2048 + (col & 2047)) = pack8f(yv[rr]); }
            }
            if (type > 0) {
                const int cc = type == 1 ? col - 2048 : col - 4096, hh = cc >> 7, d0 = cc & 127;
                bf16_t* base = type == 1 ? kT + (((size_t)chunk * 16 + hh) * 128 + d0) * 64 + rb * 8 : vT + (((size_t)chunk * 32 + hh) * 128 + d0) * 64 + rb * 8;
#pragma unroll
                for (int j = 0; j < 8; ++j) { u32x4 w; w.x = pk2(yv[0][j], yv[1][j]); w.y = pk2(yv[2][j], yv[3][j]); w.z = pk2(yv[4][j], yv[5][j]); w.w = pk2(yv[6][j], yv[7][j]);
                    *(u32x4*)(base + (size_t)j * 64) = w; }
            }
        }
    }
}

__device__ __forceinline__ void gdn_g1(LAS unsigned char* lds, const bf16_t* qn, const bf16_t* kn, const float* Gt, const float* Bt, bf16_t* Tm, bf16_t* QKm, float* TB) {
    const int tid = tidx(), lane = tid & 63, wid = __builtin_amdgcn_readfirstlane(tid >> 6), r = lane & 15, g = lane >> 4;
    const int grp = wid >> 1, lw = wid & 1;
    LAS float* Am = (LAS float*)(lds + grp * 35840);
    LAS float* gcs = (LAS float*)(lds + grp * 35840 + 34816);
    LAS float* bts = (LAS float*)(lds + grp * 35840 + 35328);
    for (int u0 = blockIdx.x; u0 < 1024; u0 += gridDim.x) {
        const int unit = u0 + grp * 1024;
        const int chunk = unit >> 4, hk = unit & 15, row0 = chunk * 64;
        { const int hv = 2 * hk + lw;
            const float gv = Gt[(size_t)(row0 + lane) * 32 + hv], bv = Bt[(size_t)(row0 + lane) * 32 + hv];
            float sc = gv;
#pragma unroll
            for (int o = 1; o < 64; o <<= 1) { const float t = __shfl_up(sc, o); if (lane >= o) sc += t; }
            const float gl = __shfl(sc, 63);
            gcs[lw * 64 + lane] = sc; bts[lw * 64 + lane] = bv;
            float* tb = TB + ((size_t)chunk * 32 + hv) * 192;
            tb[lane] = bv; tb[64 + lane] = expf(sc); tb[128 + lane] = expf(gl - sc); }
        __syncthreads();
#pragma unroll 1
        for (int nt2 = 0; nt2 < 2; ++nt2) {
            const int nt = 2 * lw + nt2, c = 16 * nt + r;
            bf16x8 kY[4], qY[4];
            const bf16_t* yb = kn + (size_t)(row0 + 16 * nt + r) * 2048 + hk * 128 + 8 * g; const bf16_t* qb = qn + (size_t)(row0 + 16 * nt + r) * 2048 + hk * 128 + 8 * g;
#pragma unroll
            for (int ks = 0; ks < 4; ++ks) { kY[ks] = *(const bf16x8*)(yb + 32 * ks); qY[ks] = *(const bf16x8*)(qb + 32 * ks); }
#pragma unroll
            for (int mt = 0; mt < 4; ++mt) {
                const bf16_t* xb = kn + (size_t)(row0 + 16 * mt + r) * 2048 + hk * 128 + 8 * g;
                f32x4 kk = {0.f, 0.f, 0.f, 0.f}, qk = {0.f, 0.f, 0.f, 0.f};
#pragma unroll
                for (int ks = 0; ks < 4; ++ks) { const bf16x8 X = *(const bf16x8*)(xb + 32 * ks);
                    kk = __builtin_amdgcn_mfma_f32_16x16x32_bf16(X, kY[ks], kk, 0, 0, 0); qk = __builtin_amdgcn_mfma_f32_16x16x32_bf16(X, qY[ks], qk, 0, 0, 0); }
#pragma unroll
                for (int j = 0; j < 2; ++j) { const float gcc = gcs[j * 64 + c], bc = bts[j * 64 + c]; const f32x4 gcp = *(const LAS f32x4*)(gcs + j * 64 + 16 * mt + 4 * g);
                    f32x4 av; float qv[4];
#pragma unroll
                    for (int i = 0; i < 4; ++i) { const int cp = 16 * mt + 4 * g + i; const float e = __expf(fminf(gcc - gcp[i], 0.f));
                        av[i] = (c > cp) ? kk[i] * bc * e : 0.f; qv[i] = (c >= cp) ? qk[i] * e : 0.f; }
                    *(LAS f32x4*)(Am + (j * 64 + c) * 68 + 16 * mt + 4 * g) = av;
                    u32x2 w; w.x = pk2(qv[0], qv[1]); w.y = pk2(qv[2], qv[3]);
                    *(u32x2*)(QKm + (((size_t)chunk * 32 + 2 * hk + j) * 64 + c) * 64 + 16 * mt + 4 * g) = w; }
            }
        }
        __syncthreads();
        {
            const LAS float* A = Am + lw * 64 * 68; float t[64];
#pragma unroll
            for (int i = 0; i < 64; ++i) t[i] = 0.f;
#pragma unroll
            for (int i = 0; i < 64; ++i) { float acc = (lane == i) ? 1.f : 0.f, acc1 = 0.f, acc2 = 0.f, acc3 = 0.f;
#pragma unroll
                for (int jb = 0; jb < (i + 3) / 4; ++jb) { const f32x4 a = *(const LAS f32x4*)(A + i * 68 + 4 * jb);
                    acc -= a[0] * t[4 * jb]; acc1 -= a[1] * t[4 * jb + 1]; acc2 -= a[2] * t[4 * jb + 2]; acc3 -= a[3] * t[4 * jb + 3]; }
                t[i] = (acc + acc1) + (acc2 + acc3); }
            bf16_t* tp = Tm + ((size_t)chunk * 32 + 2 * hk + lw) * 4096 + lane;
#pragma unroll
            for (int i = 0; i < 64; ++i) tp[i * 64] = (bf16_t)(pk2(t[i], 0.f) & 0xffffu);
        }
        __syncthreads();
    }
}

__device__ __forceinline__ s16x4 ldsrd8(const LAS unsigned char* p) { return *(const LAS s16x4*)p; }
__device__ __forceinline__ bf16x8 join8(s16x4 a, s16x4 b) { return (bf16x8){a[0], a[1], a[2], a[3], b[0], b[1], b[2], b[3]}; }
__device__ __forceinline__ bf16x8 packf8(f32x4 a, f32x4 b) { u32x4 w; w.x = pk2(a[0], a[1]); w.y = pk2(a[2], a[3]); w.z = pk2(b[0], b[1]); w.w = pk2(b[2], b[3]); return __builtin_bit_cast(bf16x8, w); }
__device__ __forceinline__ void gdn_g2(LAS unsigned char* lds, const bf16_t* qn, const bf16_t* kn, const bf16_t* kT, const bf16_t* vT, const bf16_t* Tm, const bf16_t* QKm, const float* TB, bf16_t* O) {
    if (blockIdx.x >= 128) return;
    const int tid = tidx(), lane = tid & 63, wid = __builtin_amdgcn_readfirstlane(tid >> 6), r = lane & 15, g = lane >> 4;
    const int b = blockIdx.x >> 6, hv = (blockIdx.x >> 1) & 31, hk = hv >> 1, e0 = (blockIdx.x & 1) * 64 + (wid & 3) * 16;
    constexpr int O_KN = 0, O_QN = 16384, O_KT = 32768, O_TT = 49152, O_QK = 57344, BUFB = 65536, O_TB = 131072;
    int off128[8], off64[4];
#pragma unroll
    for (int q = 0; q < 8; ++q) { const int p = 2 * q + (g >> 1); off128[q] = r * 256 + ((p ^ r) << 4) + 8 * (g & 1); }
#pragma unroll
    for (int q = 0; q < 4; ++q) { const int p = 2 * q + (g >> 1); off64[q] = r * 128 + ((p ^ ((r >> 1) & 7)) << 4) + 8 * (g & 1); }
    f32x4 S[8];
#pragma unroll
    for (int i = 0; i < 8; ++i) S[i] = (f32x4){0.f, 0.f, 0.f, 0.f};
    f32x4 tbreg = {0.f, 0.f, 0.f, 0.f};
#define G2_ISSUE(n_, bf_) do { const int chunk_ = b * 128 + (n_); \
        _Pragma("unroll") for (int i_ = 0; i_ < 8; ++i_) { const int q_ = wid * 64 + lane + 512 * i_; const bf16_t* src_; \
            if (i_ < 4) { const int ql = q_ & 1023, row = ql >> 4, p = (ql & 15) ^ (row & 15); src_ = (i_ < 2 ? kn : qn) + (size_t)(chunk_ * 64 + row) * 2048 + hk * 128 + p * 8; } \
            else if (i_ < 6) { const int ql = q_ - 2048, row = ql >> 3, p = (ql & 7) ^ ((row >> 1) & 7); src_ = kT + (((size_t)chunk_ * 16 + hk) * 128 + row) * 64 + p * 8; } \
            else { const int ql = q_ - (i_ == 6 ? 3072 : 3584), row = ql >> 3, p = (ql & 7) ^ ((row >> 1) & 7); src_ = (i_ == 6 ? Tm : QKm) + (((size_t)chunk_ * 32 + hv) * 64 + row) * 64 + p * 8; } \
            __builtin_amdgcn_global_load_lds((const unsigned*)src_, (LAS unsigned*)(lds + (bf_) * BUFB + (512 * i_ + wid * 64) * 16), 16, 0, 0); } \
        if (tid < 48) tbreg = *(const f32x4*)(TB + ((size_t)chunk_ * 32 + hv) * 192 + tid * 4); } while (0)
    G2_ISSUE(0, 0);
    if (tid < 48) *(LAS f32x4*)(lds + O_TB + tid * 16) = tbreg;
    for (int n = 0; n < 128; ++n) {
        const int bf = n & 1; const int chunk = b * 128 + n;
        asm volatile("s_waitcnt vmcnt(0)" ::: "memory");
        __syncthreads();
        if (n + 1 < 128) G2_ISSUE(n + 1, bf ^ 1);
        if (wid < 4) {
        f32x4 vv[4];
        { const bf16_t* vp = vT + (((size_t)chunk * 32 + hv) * 128 + e0 + r) * 64 + 4 * g;
#pragma unroll
          for (int mt = 0; mt < 4; ++mt) { const u32x2 w = *(const u32x2*)(vp + 16 * mt);
              vv[mt] = (f32x4){__uint_as_float(w.x << 16), __uint_as_float(w.x & 0xffff0000u), __uint_as_float(w.y << 16), __uint_as_float(w.y & 0xffff0000u)}; } }
        const LAS unsigned char* B0 = lds + bf * BUFB;
        const LAS float* tb = (const LAS float*)(lds + O_TB + bf * 768);
        bf16x8 Sb[4];
#pragma unroll
        for (int ks = 0; ks < 4; ++ks) Sb[ks] = packf8(S[2 * ks], S[2 * ks + 1]);
        f32x4 kS[4], qS[4];
#pragma unroll
        for (int mt = 0; mt < 4; ++mt) { kS[mt] = (f32x4){0.f, 0.f, 0.f, 0.f}; qS[mt] = (f32x4){0.f, 0.f, 0.f, 0.f};
#pragma unroll
            for (int ks = 0; ks < 4; ++ks) {
                const bf16x8 xk = join8(ldsrd8(B0 + O_KN + mt * 4096 + off128[2 * ks]), ldsrd8(B0 + O_KN + mt * 4096 + off128[2 * ks + 1]));
                const bf16x8 xq = join8(ldsrd8(B0 + O_QN + mt * 4096 + off128[2 * ks]), ldsrd8(B0 + O_QN + mt * 4096 + off128[2 * ks + 1]));
                kS[mt] = __builtin_amdgcn_mfma_f32_16x16x32_bf16(xk, Sb[ks], kS[mt], 0, 0, 0);
                qS[mt] = __builtin_amdgcn_mfma_f32_16x16x32_bf16(xq, Sb[ks], qS[mt], 0, 0, 0); } }
        f32x4 beta[4], eg[4], ed[4];
#pragma unroll
        for (int mt = 0; mt < 4; ++mt) { beta[mt] = *(const LAS f32x4*)(tb + 16 * mt + 4 * g); eg[mt] = *(const LAS f32x4*)(tb + 64 + 16 * mt + 4 * g); ed[mt] = *(const LAS f32x4*)(tb + 128 + 16 * mt + 4 * g); }
        const float egl = tb[64 + 63];
        f32x4 rr[4];
#pragma unroll
        for (int mt = 0; mt < 4; ++mt) rr[mt] = beta[mt] * (vv[mt] - eg[mt] * kS[mt]);
        bf16x8 rb[2] = {packf8(rr[0], rr[1]), packf8(rr[2], rr[3])};
        f32x4 vn[4];
#pragma unroll
        for (int mt = 0; mt < 4; ++mt) { vn[mt] = (f32x4){0.f, 0.f, 0.f, 0.f};
#pragma unroll
            for (int ks = 0; ks < 2; ++ks) { const bf16x8 xt = join8(ldsrd8(B0 + O_TT + mt * 2048 + off64[2 * ks]), ldsrd8(B0 + O_TT + mt * 2048 + off64[2 * ks + 1]));
                vn[mt] = __builtin_amdgcn_mfma_f32_16x16x32_bf16(xt, rb[ks], vn[mt], 0, 0, 0); } }
        bf16x8 vnb[2] = {packf8(vn[0], vn[1]), packf8(vn[2], vn[3])};
        f32x4 o[4];
#pragma unroll
        for (int mt = 0; mt < 4; ++mt) { o[mt] = eg[mt] * qS[mt];
#pragma unroll
            for (int ks = 0; ks < 2; ++ks) { const bf16x8 xq = join8(ldsrd8(B0 + O_QK + mt * 2048 + off64[2 * ks]), ldsrd8(B0 + O_QK + mt * 2048 + off64[2 * ks + 1]));
                o[mt] = __builtin_amdgcn_mfma_f32_16x16x32_bf16(xq, vnb[ks], o[mt], 0, 0, 0); } }
        bf16x8 vdb[2] = {packf8(vn[0] * ed[0], vn[1] * ed[1]), packf8(vn[2] * ed[2], vn[3] * ed[3])};
#pragma unroll
        for (int dt = 0; dt < 8; ++dt) { S[dt] = S[dt] * egl;
#pragma unroll
            for (int ks = 0; ks < 2; ++ks) { const bf16x8 xk = join8(ldsrd8(B0 + O_KT + dt * 2048 + off64[2 * ks]), ldsrd8(B0 + O_KT + dt * 2048 + off64[2 * ks + 1]));
                S[dt] = __builtin_amdgcn_mfma_f32_16x16x32_bf16(xk, vdb[ks], S[dt], 0, 0, 0); } }
        { bf16_t* op = O + (size_t)(chunk * 64 + 4 * g) * 4096 + hv * 128 + e0 + r;
#pragma unroll
          for (int mt = 0; mt < 4; ++mt)
#pragma unroll
              for (int i = 0; i < 4; ++i) op[(size_t)(16 * mt + i) * 4096] = (bf16_t)(pk2(o[mt][i], 0.f) & 0xffffu); }
        }
        if (n + 1 < 128 && tid < 48) *(LAS f32x4*)(lds + O_TB + (bf ^ 1) * 768 + tid * 16) = tbreg;
    }
#undef G2_ISSUE
    asm volatile("s_waitcnt vmcnt(0)" ::: "memory");
    __syncthreads();
}

__device__ __forceinline__ void gdn_g3(bf16_t* O, const bf16_t* Z, const float* gn) {
    const int gt = blockIdx.x * NTHR + tidx(), NGT = gridDim.x * NTHR;
    const int dl = (tidx() & 15) * 8; float gv[8];
#pragma unroll
    for (int j = 0; j < 8; ++j) gv[j] = gn[dl + j];
#pragma unroll 4
    for (int idx = gt; idx < T * 512; idx += NGT) {
        float o[8], z[8]; unpack8(*(const u32x4*)(O + (size_t)idx * 8), o); unpack8(*(const u32x4*)(Z + (size_t)idx * 8), z);
        float ss = 0.f;
#pragma unroll
        for (int j = 0; j < 8; ++j) ss += o[j] * o[j];
        const float rn = rsqrtf(sum16(ss) * (1.f / 128.f) + EPS);
#pragma unroll
        for (int j = 0; j < 8; ++j) o[j] = o[j] * rn * gv[j] * siluf_(z[j]);
        *(u32x4*)(O + (size_t)idx * 8) = pack8f(o);
    }
}

#define XB_TMO      128
#define XB_XCNT(j)  (256  + 64 * (j))
#define XB_XSUB(j)  (1280 + 64 * (j))
#define XB_XGEN(j)  (2304 + 64 * (j))
#define XB_TOP      3328
#define XB_TOPGEN   3392
#define XCD_BAR_WORDS 3456
#define XB_SPIN_CAP (1u << 18)

__device__ __forceinline__ unsigned xb_ld(unsigned* p)              { return __hip_atomic_load(p, __ATOMIC_RELAXED, __HIP_MEMORY_SCOPE_AGENT); }
__device__ __forceinline__ unsigned xb_add(unsigned* p, unsigned v) { return __hip_atomic_fetch_add(p, v, __ATOMIC_RELAXED, __HIP_MEMORY_SCOPE_AGENT); }
__device__ __forceinline__ unsigned xb_xcc_id() { return (unsigned)__builtin_amdgcn_s_getreg((3 << 11) | 20) & 0xFu; }
#define XB_SPIN(cond, bar) do { unsigned _sp = 0; while (cond) { __builtin_amdgcn_s_sleep(1); \
    if ((++_sp & 255u) == 0u) { if (xb_ld(&(bar)[XB_TMO])) break; if (_sp > XB_SPIN_CAP) { atomicAdd(&(bar)[XB_TMO], 1u); break; } } } } while (0)

struct XcdBarrier {
    unsigned* bar; unsigned x;
    volatile LAS unsigned* st;
};

__device__ __forceinline__ XcdBarrier xcd_barrier_post(unsigned* bar, volatile LAS unsigned* st) {
    XcdBarrier b; b.bar = bar; b.x = xb_xcc_id(); b.st = st;
    if (threadIdx.x == 0) (void)xb_add(&bar[XB_XCNT(b.x)], 1u);
    return b;
}
__device__ __forceinline__ void xcd_barrier_complete(unsigned* bar, unsigned x, unsigned& nloc, unsigned& nx) {
    const unsigned G = gridDim.x * gridDim.y * gridDim.z;
    unsigned sum, cnt, mine, sp = 0u;
    for (;;) {
        sum = 0u; cnt = 0u; mine = 0u;
#pragma unroll
        for (unsigned j = 0; j < 16; ++j) { const unsigned c = xb_ld(&bar[XB_XCNT(j)]); sum += c; cnt += (c > 0u) ? 1u : 0u; mine = (j == x) ? c : mine; }
        if (sum == G) break;
        __builtin_amdgcn_s_sleep(1);
        if ((++sp & 255u) == 0u) { if (xb_ld(&bar[XB_TMO])) break; if (sp > XB_SPIN_CAP) { atomicAdd(&bar[XB_TMO], 1u); break; } }
    }
    nloc = mine > 0u ? mine : 1u; nx = cnt > 0u ? cnt : 1u;
}

__device__ __forceinline__ void xcd_barrier(const XcdBarrier& b) {
    asm volatile("s_waitcnt vmcnt(0)" ::: "memory");
    __syncthreads();
    if (threadIdx.x == 0) {
        unsigned* bar = b.bar;
        __builtin_amdgcn_s_waitcnt(0);
        unsigned nloc = b.st[0], nx = b.st[1];
        if (nloc == 0u) { xcd_barrier_complete(bar, b.x, nloc, nx); b.st[0] = nloc; b.st[1] = nx; }
        const unsigned old = xb_add(&bar[XB_XSUB(b.x)], 1u);
        const unsigned gen = old / nloc;
        if (old + 1u == (gen + 1u) * nloc) {
            __builtin_amdgcn_fence(__ATOMIC_RELEASE, "agent");
            asm volatile("s_waitcnt vmcnt(0)" ::: "memory");
            const unsigned og = xb_add(&bar[XB_TOP], 1u);
            const unsigned tg = og / nx;
            if (og + 1u == (tg + 1u) * nx) xb_add(&bar[XB_TOPGEN], 1u);
            else XB_SPIN(xb_ld(&bar[XB_TOPGEN]) == tg, bar);
            __builtin_amdgcn_fence(__ATOMIC_ACQUIRE, "agent");
            xb_add(&bar[XB_XGEN(b.x)], 1u);
            asm volatile("s_waitcnt vmcnt(0)" ::: "memory");
        } else {
            XB_SPIN(xb_ld(&bar[XB_XGEN(b.x)]) == gen, bar);
            __builtin_amdgcn_fence(__ATOMIC_ACQUIRE, "agent");
            asm volatile("s_waitcnt vmcnt(0)" ::: "memory");
        }
    }
    __syncthreads();
}

constexpr size_t WS_BAR = 256 * 1024;
struct Args { const float* in[20]; float* out; unsigned char* ws; int ph_lo, ph_hi; };
constexpr int NPHASE = 23;
#ifndef ONLY_PH
#define ONLY_PH -1
#endif
#define EN(k) (ONLY_PH < 0 || ONLY_PH == (k))
#ifndef MK_COOP
#define MK_COOP 1
#endif

__global__ void __launch_bounds__(NTHR) fwd_megakernel(Args a) {
    extern __shared__ __attribute__((aligned(16))) unsigned char lds_raw[];
    LAS unsigned char* lds = (LAS unsigned char*)lds_raw;
    unsigned char* ws = a.ws;
    const float* x = a.in[0]; const float* cvec = a.in[1]; const float* ada_w = a.in[2]; const float* ada_b = a.in[3]; const float* norm_g = a.in[4];
    float* Mods = (float*)(ws + WS_MODS); float* FL = (float*)(ws + WS_FL); float* FB = (float*)(ws + WS_FB); float* AB = (float*)(ws + WS_AB);
    float* Gt = (float*)(ws + WS_GB); float* Btb = Gt + (size_t)T * 32; float* TB = (float*)(ws + WS_TB);
    bf16_t* WA = (bf16_t*)(ws + WS_WA); bf16_t* WB = (bf16_t*)(ws + WS_WB); bf16_t* Hb = (bf16_t*)(ws + WS_H); bf16_t* Yb = (bf16_t*)(ws + WS_Y);
    bf16_t* Pb = (bf16_t*)(ws + WS_P); bf16_t* Qh = (bf16_t*)(ws + WS_QH); bf16_t* Kh = (bf16_t*)(ws + WS_KH); bf16_t* Vh = (bf16_t*)(ws + WS_VH);
    bf16_t* GV = (bf16_t*)(ws + WS_GV); bf16_t* QKV = (bf16_t*)(ws + WS_QKV); bf16_t* qn = (bf16_t*)(ws + WS_QN); bf16_t* kn = (bf16_t*)(ws + WS_KN);
    bf16_t* kT = (bf16_t*)(ws + WS_KT); bf16_t* vT = (bf16_t*)(ws + WS_VT); bf16_t* Tm = (bf16_t*)(ws + WS_TM); bf16_t* QKm = (bf16_t*)(ws + WS_QKM);
    bf16_t* Ob = (bf16_t*)(ws + WS_O); bf16_t* Zb = (bf16_t*)(ws + WS_Z);
#define mods(layer, sub) (Mods + (size_t)((layer) * 2 + (sub)) * 2 * 3 * DM)
#define ng(layer, k) (norm_g + (size_t)((layer) * 4 + (k)) * DM)
    const int lo = a.ph_lo, hi = a.ph_hi;
    volatile LAS unsigned* xst = (volatile LAS unsigned*)(lds + LDS_TOTAL - 64);
    if (tidx() < 2) xst[tidx()] = 0u;
    __syncthreads();
    XcdBarrier xbar = xcd_barrier_post((unsigned*)(ws + WS_BAR), xst);
    if (__builtin_amdgcn_readfirstlane(tidx() >> 6) == 0) { __threadfence(); asm volatile("s_waitcnt vmcnt(0)" ::: "memory"); } __syncthreads();
#define IN(k) (lo <= (k) && (k) < hi && EN(k))
#define SEAM(k) do { if (lo <= (k) && (k) + 1 < hi) { if ((k) == 0) { asm volatile("s_waitcnt vmcnt(0) lgkmcnt(0)" ::: "memory"); __syncthreads(); cg::this_grid().sync(); if (__builtin_amdgcn_readfirstlane(tidx() >> 6) == 0) { __builtin_amdgcn_fence(__ATOMIC_ACQUIRE, "agent"); asm volatile("s_waitcnt vmcnt(0)" ::: "memory"); } __syncthreads(); } else { xcd_barrier(xbar); } } } while (0)
#define CONV(W_, K_, N_, T_, s1, a1, s2, a2) do { __syncthreads(); convert_weight(lds, W_, K_, N_, T_, s1, a1, s2, a2); } while (0)
#define ROWP(xin_, first_, last_, gl, gs, gk, hl, hs, hk) row_phase(xin_, (first_) ? nullptr : a.out, (first_) ? nullptr : Yb, mods(gl, gs) + 2 * DM, ng(gl, gk), (last_) ? nullptr : Hb, ng(hl, hk), mods(hl, hs), mods(hl, hs) + DM)
    if (IN(0)) { mods_phase(lds, cvec, ada_w, ada_b, Mods); CONV(a.in[5], DM, FOX_N, WA, NOSEG, 0, NOSEG, 0); } SEAM(0);
    if (IN(1)) { ROWP(x, true, false, 0, 0, 0, 0, 0, 0); CONV(a.in[9], DM, DM, WB, NOSEG, 0, NOSEG, 0); } SEAM(1);
    if (IN(2)) { run_gemm(lds, Hb, DM, WA, FOX_LD, DM, Pb, FOX_LD, FOX_N, FL, 24, 16); } SEAM(2);
    if (IN(3)) { fox_prep(Pb, FL, a.in[6], a.in[7], a.in[8], Qh, Kh, Vh, FB); CONV(a.in[16], DM, 2 * DFF, WA, NOSEG, 0, NOSEG, 0); } SEAM(3);
    if (IN(4)) { fox_attention((char*)lds_raw, Qh, Kh, Vh, Pb, FB, Hb, a.in[7], a.in[8]); } SEAM(4);
    if (IN(5)) { run_gemm(lds, Hb, DM, WB, DM, DM, Yb, DM, DM, nullptr, -1, 0); } SEAM(5);
    if (IN(6)) { ROWP(x, false, false, 0, 0, 1, 0, 1, 2); CONV(a.in[19], DFF, DM, WB, NOSEG, 0, NOSEG, 0); } SEAM(6);
    if (IN(7)) { run_gemm(lds, Hb, DM, WA, 2 * DFF, DM, GV, 2 * DFF, 2 * DFF, nullptr, -1, 0); } SEAM(7);
    if (IN(8)) { glu_phase(GV, a.in[17], a.in[18]); CONV(a.in[10], DM, 12352, WA, 8192, 256, 12288, -4096); } SEAM(8);
    if (IN(9)) { run_gemm(lds, GV + DFF, 2 * DFF, WB, DM, DFF, Yb, DM, DM, nullptr, -1, 0); } SEAM(9);
    if (IN(10)) { ROWP(a.out, false, false, 0, 1, 3, 1, 0, 0); CONV(a.in[15], 2 * DM, DM, WB, NOSEG, 0, NOSEG, 0); } SEAM(10);
    if (IN(11)) { run_gemm(lds, Hb, DM, WA, 8448, DM, QKV, 8192, 8192, AB, 32, 64); } SEAM(11);
    if (IN(12)) { gdn_prep(QKV, AB, a.in[11], a.in[12], a.in[13], qn, kn, kT, vT, Gt, Btb); } SEAM(12);
    if (IN(13)) { gdn_g1(lds, qn, kn, Gt, Btb, Tm, QKm, TB); } SEAM(13);
    if (IN(14)) { gdn_g2(lds, qn, kn, kT, vT, Tm, QKm, TB, Ob); } SEAM(14);
    if (IN(15)) { run_gemm(lds, Hb, DM, WA + (size_t)8448 * DM, 2 * DM, DM, Zb, 2 * DM, 2 * DM, nullptr, -1, 0); } SEAM(15);
    if (IN(16)) { gdn_g3(Ob, Zb, a.in[14]); CONV(a.in[16] + (size_t)DM * 2 * DFF, DM, 2 * DFF, WA, NOSEG, 0, NOSEG, 0); } SEAM(16);
    if (IN(17)) { run_gemm(lds, Ob, 2 * DM, WB, DM, 2 * DM, Yb, DM, DM, nullptr, -1, 0); } SEAM(17);
    if (IN(18)) { ROWP(a.out, false, false, 1, 0, 1, 1, 1, 2); CONV(a.in[19] + (size_t)DFF * DM, DFF, DM, WB, NOSEG, 0, NOSEG, 0); } SEAM(18);
    if (IN(19)) { run_gemm(lds, Hb, DM, WA, 2 * DFF, DM, GV, 2 * DFF, 2 * DFF, nullptr, -1, 0); } SEAM(19);
    if (IN(20)) { glu_phase(GV, a.in[17] + 3 * DFF, a.in[18] + DFF); } SEAM(20);
    if (IN(21)) { run_gemm(lds, GV + DFF, 2 * DFF, WB, DM, DFF, Yb, DM, DM, nullptr, -1, 0); } SEAM(21);
    if (IN(22)) { ROWP(a.out, false, true, 1, 1, 3, 0, 0, 0); }
    asm volatile("s_waitcnt vmcnt(0) lgkmcnt(0)" ::: "memory"); __syncthreads(); if (__builtin_amdgcn_readfirstlane(tidx() >> 6) == 0) { __threadfence(); asm volatile("s_waitcnt vmcnt(0)" ::: "memory"); }
#ifdef EXP_ROWS
    __syncthreads(); if (blockIdx.x == 0) { for (int i = tidx(); i < DM; i += NTHR) { a.out[i] = x[i]; a.out[(size_t)SEQ * DM + i] = x[(size_t)SEQ * DM + i]; } }
#endif
}

extern "C" void kernel_launch(void* const* d_in, const int* in_sizes, int n_in, void* d_out, int out_size, void* d_ws, size_t ws_size, hipStream_t stream) {
    static int grid = 0;
    if (grid == 0) {
        if (n_in != 20 || ws_size < WS_END) { fprintf(stderr, "kernel_launch: need 20 inputs and >= %zu B workspace (got %d, %zu)\n", (size_t)WS_END, n_in, ws_size); grid = -1; return; }
        int dev = 0, cus = 0, per_cu = 0;
        (void)hipGetDevice(&dev); (void)hipDeviceGetAttribute(&cus, hipDeviceAttributeMultiprocessorCount, dev);
        if (hipFuncSetAttribute((const void*)fwd_megakernel, hipFuncAttributeMaxDynamicSharedMemorySize, LDS_TOTAL) != hipSuccess) fprintf(stderr, "kernel_launch: hipFuncSetAttribute failed\n");
        if (hipOccupancyMaxActiveBlocksPerMultiprocessor(&per_cu, (const void*)fwd_megakernel, NTHR, LDS_TOTAL) != hipSuccess || per_cu < 1) { fprintf(stderr, "kernel_launch: occupancy query gave %d\n", per_cu); per_cu = 1; }
        (void)hipGetLastError();
        grid = cus > 0 ? cus : 256;
    }
    if (grid < 0) return;
    Args a{};
    for (int i = 0; i < 20; ++i) a.in[i] = (const float*)d_in[i];
    a.out = (float*)d_out; a.ws = (unsigned char*)d_ws;
    (void)hipMemsetAsync((char*)d_ws + WS_BAR, 0, 16384, stream);
#if MK_COOP
    a.ph_lo = 0; a.ph_hi = NPHASE;
    void* args[] = {&a};
    hipError_t e = hipLaunchCooperativeKernel((const void*)fwd_megakernel, dim3(grid), dim3(NTHR), args, LDS_TOTAL, stream);
    if (e != hipSuccess) fprintf(stderr, "cooperative launch failed: %s (grid %d)\n", hipGetErrorString(e), grid);
#else
    for (int ph = 0; ph < NPHASE; ++ph) { a.ph_lo = ph; a.ph_hi = ph + 1; hipLaunchKernelGGL(fwd_megakernel, dim3(grid), dim3(NTHR), LDS_TOTAL, stream, a); }
#endif
}
```

```cpp
#include <hip/hip_runtime.h>
#include <hip/hip_cooperative_groups.h>
#include <hip/hip_bf16.h>
#include <cstdio>
#include <cstdint>
#include <cmath>
namespace cg = cooperative_groups;
__device__ __forceinline__ int tidx() { int t = (int)__builtin_amdgcn_workitem_id_x(); asm volatile("" : "+v"(t)); return t; }
namespace pg8 {
#define PG8_LAS __attribute__((address_space(3)))
typedef unsigned short bf16_t;
typedef short bf16x8 __attribute__((ext_vector_type(8)));
typedef float f32x4 __attribute__((ext_vector_type(4)));
typedef unsigned u32x4 __attribute__((ext_vector_type(4)));
constexpr int BM = 256, BK = 64, HALF = 128, HTB = HALF * BK * 2  , STAGE_BYTES = 8 * HTB, NXCD = 8, WGM = 8;

__host__ __device__ __forceinline__ int lds_byte(int r, int c) { const int st = (r >> 4) * 2 + (c >> 5), rr = r & 15, cc = c & 31, ob = rr * 64 + cc * 2; return st * 1024 + (ob ^ (((ob >> 9) & 1) << 5)); }
__host__ __device__ __forceinline__ void stage_rc(int b, int& R, int& C) { const int st = b / 1024, sb = b % 1024, swz = sb ^ (((sb >> 9) & 1) << 5); R = (st >> 1) * 16 + swz / 64; C = (st & 1) * 32 + (swz % 64) / 2; }
__host__ __device__ __forceinline__ int perm32(int rho) { const int n = rho >> 4, i = rho & 15; return 8 * (i >> 2) + 4 * n + (i & 3); }

struct Unit { int pm, pn; };
struct Gemm { const bf16_t* A; const bf16_t* Bt; int M, N, K, lda; };

struct StaticOrder {
    int nM, nN, nwg, G, c;
    __host__ __device__ void init(int M, int N, int G_, int c_) { nM = M / BM; nN = N / BM; nwg = nM * nN; G = G_; c = c_; }
    __host__ __device__ bool next(int i, Unit& u) const {
        const long L = (long)i * G + c; if (L >= nwg) return false;
        int wgid = (int)L; { const int q = nwg / NXCD, r = nwg % NXCD, xcd = wgid % NXCD, off = wgid / NXCD; wgid = (xcd < r ? xcd * (q + 1) : r * (q + 1) + (xcd - r) * q) + off; }
        const int nig = WGM * nN, gid = wgid / nig, fm = gid * WGM, gsz = (nM - fm) < WGM ? (nM - fm) : WGM;
        u.pm = fm + ((wgid % nig) % gsz); u.pn = (wgid % nig) / gsz; return true;
    }
    __device__ __forceinline__ void a_ready(const Unit&) const {}
    __device__ __forceinline__ void done(const Unit&) const {}
};

__device__ __forceinline__ unsigned cvt_pk_bf16(float lo, float hi) { unsigned r; asm volatile("v_cvt_pk_bf16_f32 %0, %1, %2" : "=v"(r) : "v"(lo), "v"(hi)); return r; }
template <class Epi, class Sched, bool ALIGN_EPI = false, bool SP2 = false>
__device__ __forceinline__ void gemm_phase(PG8_LAS unsigned char* lds, const Gemm g, const Sched& S, const Epi& E) {
    const int tid = tidx(), wid = __builtin_amdgcn_readfirstlane(tid >> 6), lane = tid & 63, wr = wid >> 2, wc = wid & 3, fr = lane & 15, fq = lane >> 4;
    const int K = g.K, nt = K / BK;
    unsigned voffA[2], voffB[2];
#pragma unroll
    for (int i = 0; i < 2; ++i) { int R, C; stage_rc(tid * 16 + i * 8192, R, C); const int Rb = Epi::PERM ? ((R & ~31) + perm32(R & 31)) : R;
        voffA[i] = (unsigned)(R * g.lda + C) * 2u; voffB[i] = (unsigned)(Rb * K + C) * 2u; }
    const size_t kstep = (size_t)(BK * 2);
    const size_t hstep = (size_t)HALF * K * 2;
    const size_t tstep = 2 * hstep; const size_t hstepA = (size_t)HALF * g.lda * 2, tstepA = 2 * hstepA;
    const unsigned ldsw = (unsigned)wid * 1024u;
    const int aoff = lds_byte(wr * 64 + fr, fq * 8), boff = lds_byte(wc * 32 + fr, fq * 8);
#define PG8_SA(b, h) (((b) * 2 + (h)) * HTB)
#define PG8_SB(b, h) ((4 + (b) * 2 + (h)) * HTB)
#define PG8_STAGE(bufoff, gbase, voff) do { _Pragma("unroll") for (int _i = 0; _i < 2; ++_i) \
        __builtin_amdgcn_global_load_lds((const unsigned*)((const char*)(gbase) + (voff)[_i]), (PG8_LAS unsigned*)(lds + (bufoff) + ldsw + _i * 8192), 16, 0, 0); } while (0)
#define PG8_LDA(dst, b, h) do { _Pragma("unroll") for (int m = 0; m < 4; ++m) _Pragma("unroll") for (int k = 0; k < 2; ++k) dst[m][k] = *(const PG8_LAS bf16x8*)(lds + PG8_SA(b, h) + aoff + m * 2048 + k * 1024); } while (0)
#define PG8_LDB(dst, b, h) do { _Pragma("unroll") for (int n = 0; n < 2; ++n) _Pragma("unroll") for (int k = 0; k < 2; ++k) dst[n][k] = *(const PG8_LAS bf16x8*)(lds + PG8_SB(b, h) + boff + n * 2048 + k * 1024); } while (0)
#define PG8_MMA(ai, bj, At, Bt) do { __builtin_amdgcn_s_setprio(1); _Pragma("unroll") for (int m = 0; m < 4; ++m) _Pragma("unroll") for (int n = 0; n < 2; ++n) _Pragma("unroll") for (int k = 0; k < 2; ++k) \
        acc[ai][bj][m][n] = __builtin_amdgcn_mfma_f32_16x16x32_bf16(Bt[n][k], At[m][k], acc[ai][bj][m][n], 0, 0, 0); __builtin_amdgcn_s_setprio(0); } while (0)
#define PG8_WAIT_V(n) asm volatile("s_waitcnt vmcnt(" #n ")" ::: "memory")
#define PG8_WAIT_L(n) asm volatile("s_waitcnt lgkmcnt(" #n ")" ::: "memory")
#define PG8_BAR __builtin_amdgcn_s_barrier()
#define PG8_SCHED __builtin_amdgcn_sched_barrier(0)
    Unit cur, nxt; int ui = 0;
    if (!S.next(0, cur)) return;
    f32x4 acc[2][2][4][2];
#pragma unroll
    for (int a = 0; a < 2; ++a)
#pragma unroll
        for (int b = 0; b < 2; ++b)
#pragma unroll
            for (int m = 0; m < 4; ++m)
#pragma unroll
                for (int n = 0; n < 2; ++n) acc[a][b][m][n] = (f32x4){0.f, 0.f, 0.f, 0.f};
    bf16x8 At[4][2], B0[2][2], B1[2][2];
    const char* cA = (const char*)g.A + (size_t)cur.pm * tstepA; const char* cB = (const char*)g.Bt + (size_t)cur.pn * tstep;
    S.a_ready(cur);
    if constexpr (SP2) {
        PG8_STAGE(PG8_SB(0, 0), cB, voffB); PG8_STAGE(PG8_SB(0, 1), cB + hstep, voffB); PG8_STAGE(PG8_SA(0, 0), cA, voffA); PG8_STAGE(PG8_SA(0, 1), cA + hstepA, voffA);
        if (wr == 1) PG8_BAR;
        PG8_WAIT_V(2); PG8_BAR;
        PG8_STAGE(PG8_SB(1, 0), cB + kstep, voffB); PG8_STAGE(PG8_SA(1, 0), cA + kstep, voffA); PG8_STAGE(PG8_SB(1, 1), cB + hstep + kstep, voffB);
        PG8_WAIT_V(6); PG8_BAR;
    } else {
        PG8_STAGE(PG8_SB(0, 0), cB, voffB); PG8_STAGE(PG8_SA(0, 0), cA, voffA); PG8_STAGE(PG8_SB(0, 1), cB + hstep, voffB); PG8_STAGE(PG8_SA(0, 1), cA + hstepA, voffA);
        if (wr == 1) PG8_BAR;
        PG8_WAIT_V(4); PG8_BAR;
        PG8_STAGE(PG8_SB(1, 0), cB + kstep, voffB); PG8_STAGE(PG8_SA(1, 0), cA + kstep, voffA); PG8_STAGE(PG8_SB(1, 1), cB + hstep + kstep, voffB);
        PG8_WAIT_V(6); PG8_BAR;
    }
    for (;;) {
        const bool has_next = S.next(ui + 1, nxt);
        const char* nA = has_next ? (const char*)g.A + (size_t)nxt.pm * tstepA : cA; const char* nB = has_next ? (const char*)g.Bt + (size_t)nxt.pn * tstep : cB;
        for (int t = 0; t < nt; t += 2) {
            const bool last = (t == nt - 2);
            const char* a1 = cA + (size_t)(t + 1) * kstep;
            const char* a2 = last ? nA : cA + (size_t)(t + 2) * kstep; const char* b2 = last ? nB : cB + (size_t)(t + 2) * kstep;
            const char* a3 = a2 + kstep; const char* b3 = b2 + kstep;
            if (last && has_next) S.a_ready(nxt);
            if constexpr (SP2) {
            PG8_LDB(B0, 0, 0); PG8_LDB(B1, 0, 1); PG8_SCHED; PG8_LDA(At, 0, 0); PG8_STAGE(PG8_SA(1, 1), a1 + hstepA, voffA);
            PG8_WAIT_V(8); PG8_WAIT_L(0); PG8_BAR; PG8_MMA(0, 0, At, B0); PG8_MMA(0, 1, At, B1); PG8_BAR; PG8_SCHED;
            PG8_LDA(At, 0, 1); PG8_STAGE(PG8_SB(0, 0), b2, voffB); PG8_STAGE(PG8_SB(0, 1), b2 + hstep, voffB); PG8_STAGE(PG8_SA(0, 0), a2, voffA);
            PG8_WAIT_V(8); PG8_WAIT_L(0); PG8_BAR; PG8_MMA(1, 0, At, B0); PG8_MMA(1, 1, At, B1); PG8_BAR; PG8_SCHED;
            PG8_LDB(B0, 1, 0); PG8_LDB(B1, 1, 1); PG8_SCHED; PG8_LDA(At, 1, 0); PG8_STAGE(PG8_SA(0, 1), a2 + hstepA, voffA);
            PG8_WAIT_V(8); PG8_WAIT_L(0); PG8_BAR; PG8_MMA(0, 0, At, B0); PG8_MMA(0, 1, At, B1); PG8_BAR; PG8_SCHED;
            PG8_LDA(At, 1, 1); PG8_STAGE(PG8_SB(1, 0), b3, voffB); PG8_STAGE(PG8_SB(1, 1), b3 + hstep, voffB); PG8_STAGE(PG8_SA(1, 0), a3, voffA);
            PG8_WAIT_V(8); PG8_WAIT_L(0); PG8_BAR; PG8_MMA(1, 0, At, B0); PG8_MMA(1, 1, At, B1); PG8_BAR; PG8_SCHED;
            } else {
            PG8_LDB(B0, 0, 0); PG8_SCHED; PG8_LDA(At, 0, 0); PG8_STAGE(PG8_SA(1, 1), a1 + hstepA, voffA);
            PG8_WAIT_L(8); PG8_BAR; PG8_WAIT_L(0); PG8_MMA(0, 0, At, B0); PG8_BAR; PG8_SCHED;
            PG8_LDB(B1, 0, 1); PG8_STAGE(PG8_SB(0, 0), b2, voffB);
            PG8_BAR; PG8_WAIT_L(0); PG8_MMA(0, 1, At, B1); PG8_BAR;
            PG8_LDA(At, 0, 1); PG8_STAGE(PG8_SA(0, 0), a2, voffA);
            PG8_BAR; PG8_WAIT_L(0); PG8_MMA(1, 0, At, B0); PG8_BAR; PG8_SCHED;
            PG8_STAGE(PG8_SB(0, 1), b2 + hstep, voffB);
            PG8_WAIT_V(6); PG8_BAR; PG8_MMA(1, 1, At, B1); PG8_BAR;
            PG8_LDB(B0, 1, 0); PG8_SCHED; PG8_LDA(At, 1, 0); PG8_STAGE(PG8_SA(0, 1), a2 + hstepA, voffA);
            PG8_WAIT_L(8); PG8_BAR; PG8_WAIT_L(0); PG8_MMA(0, 0, At, B0); PG8_BAR; PG8_SCHED;
            PG8_LDB(B1, 1, 1); PG8_STAGE(PG8_SB(1, 0), b3, voffB);
            PG8_BAR; PG8_WAIT_L(0); PG8_MMA(0, 1, At, B1); PG8_BAR;
            PG8_LDA(At, 1, 1); PG8_STAGE(PG8_SA(1, 0), a3, voffA);
            PG8_BAR; PG8_WAIT_L(0); PG8_MMA(1, 0, At, B0); PG8_BAR; PG8_SCHED;
            PG8_STAGE(PG8_SB(1, 1), b3 + hstep, voffB);
            PG8_WAIT_V(6); PG8_BAR; PG8_MMA(1, 1, At, B1); PG8_BAR;
            }
        }
        if constexpr (ALIGN_EPI) { if (wr == 0) PG8_BAR; }
        if constexpr (!Epi::AFTER_DRAIN) { E(acc, cur, wr, wc, fr, fq); S.done(cur); }
        if (!has_next) break;
#pragma unroll
        for (int a = 0; a < 2; ++a)
#pragma unroll
            for (int b = 0; b < 2; ++b)
#pragma unroll
                for (int m = 0; m < 4; ++m)
#pragma unroll
                    for (int n = 0; n < 2; ++n) acc[a][b][m][n] = (f32x4){0.f, 0.f, 0.f, 0.f};
        cur = nxt; cA = nA; cB = nB; ++ui;
        if constexpr (ALIGN_EPI) { if (wr == 1) PG8_BAR; }
    }
    PG8_WAIT_V(0);
    if constexpr (!ALIGN_EPI) { if (wr == 0) PG8_BAR; }
    PG8_BAR;
    if constexpr (Epi::AFTER_DRAIN) { E.fused(acc, cur, wr, wc, fr, fq, lds, wid, lane); S.done(cur); }
#undef PG8_SA
#undef PG8_SB
#undef PG8_STAGE
#undef PG8_LDA
#undef PG8_LDB
#undef PG8_MMA
#undef PG8_WAIT_V
#undef PG8_WAIT_L
#undef PG8_BAR
#undef PG8_SCHED
}
}
namespace att {
enum { ORDER_NATURAL = 0, ORDER_REVERSED = 1, ORDER_PAIRED = 2, ORDER_XCD = 4 };
constexpr int B = 2, H = 16, HKV = 16, SQ = 8192, SKV = 8192, D = 128;
constexpr int QOFF = 0;
constexpr int WINDOW = SKV;
constexpr float THR = 8.f;
constexpr bool WSKIP = false;

constexpr float SCALE = 0.08838834764831845f;
constexpr int NW = 8, QBLK = 32, KVBLK = 64, QB = NW * QBLK;
constexpr int SHM_V = KVBLK * D * 2, SHM_K = KVBLK * D * 2;
constexpr int LDS_BYTES = 2 * SHM_V + 2 * SHM_K + NW * 64 * 4;
constexpr int FB_OFF = LDS_BYTES, OSTR = 2048, GSTR = 8448;

using bf16 = __hip_bfloat16;
#define ALAS __attribute__((address_space(3)))
typedef short bf16x8 __attribute__((ext_vector_type(8)));
typedef short s16x4 __attribute__((ext_vector_type(4)));
typedef float f32x16 __attribute__((ext_vector_type(16)));
typedef float f32x4 __attribute__((ext_vector_type(4)));
typedef unsigned u32x4 __attribute__((ext_vector_type(4)));
template <class A, class Bt> struct same_t { static constexpr bool v = false; };
template <class A> struct same_t<A, A> { static constexpr bool v = true; };

#define KSWZ(row, colB) ((row) * 256 + ((colB) ^ (((row) & 7) << 4)))
#define SBAR() __builtin_amdgcn_sched_barrier(0)
__device__ __forceinline__ int v_st(int k, int c) { const int kk = (k & ~0xC) | ((k & 4) << 1) | ((k & 8) >> 1); return ((kk >> 3) * 4 + (c >> 5)) * 512 + ((kk & 7) * 32 + (c & 31)) * 2; }
__device__ __forceinline__ int v_rd_base(int lane) { return ((lane & 3) << 3) | (((lane >> 2) & 3) << 6) | (((lane >> 4) & 1) << 5) | (((lane >> 5) & 1) << 8); }
constexpr int v_rd_off(int d0, int ks, int half) { return d0 * 512 + ks * 4096 + half * 2048; }
__device__ __forceinline__ int crow(int r, int hi) { return (r & 3) + 8 * (r >> 2) + 4 * hi; }
__device__ __forceinline__ unsigned cvtpk(float lo, float hi) {
    unsigned r; asm volatile("v_cvt_pk_bf16_f32 %0, %1, %2" : "=v"(r) : "v"(lo), "v"(hi)); return r;
}
__device__ __forceinline__ bf16x8 pack8(f32x4 a, f32x4 b) {
    u32x4 w = {cvtpk(a[0], a[1]), cvtpk(a[2], a[3]), cvtpk(b[0], b[1]), cvtpk(b[2], b[3])};
    return *reinterpret_cast<bf16x8*>(&w);
}
template <class T> __device__ __forceinline__ bf16x8 load8(const T* p) {
    if constexpr (same_t<T, float>::v) { return pack8(*(const f32x4*)p, *(const f32x4*)(p + 4)); }
    else { return *reinterpret_cast<const bf16x8*>(p); }
}
__device__ __forceinline__ void mask_tile(f32x16& p0, f32x16& p1, int dq, unsigned W) {
    const float NEG = -__builtin_inff();
#pragma unroll
    for (int r = 0; r < 16; ++r) {
        const int c = (r & 3) + 8 * (r >> 2);
        if ((unsigned)(dq - c) >= W) p0[r] = NEG;
        if ((unsigned)(dq - c - 32) >= W) p1[r] = NEG;
    }
}
__device__ __forceinline__ void partialSM(f32x16& p0, f32x16& p1, float& m_reg, float& mn, float& alpha) {
    float pmax = p0[0]; for (int r = 1; r < 16; ++r) pmax = fmaxf(pmax, p0[r]); for (int r = 0; r < 16; ++r) pmax = fmaxf(pmax, p1[r]);
    { auto rr = __builtin_amdgcn_permlane32_swap(__float_as_uint(pmax), __float_as_uint(pmax), false, false);
      pmax = fmaxf(__uint_as_float(rr[0]), __uint_as_float(rr[1])); }
    constexpr float C2 = 1.4426950408889634f * SCALE;
    if (__builtin_expect(__all((pmax - m_reg) * SCALE <= THR), 1)) { mn = m_reg; alpha = 1.f; }
    else { mn = fmaxf(m_reg, pmax); alpha = __builtin_amdgcn_exp2f((m_reg - mn) * C2); m_reg = mn; }
    const float mnL = -mn * C2;
    for (int r = 0; r < 16; ++r) p0[r] = fmaf(p0[r], C2, mnL); for (int r = 0; r < 16; ++r) p1[r] = fmaf(p1[r], C2, mnL);
    for (int r = 0; r < 16; ++r) p0[r] = __builtin_amdgcn_exp2f(p0[r]);
}
__device__ __forceinline__ void finishSM(f32x16& p0, f32x16& p1, float alpha, float& l_reg, bf16x8& pa0, bf16x8& pa1, bf16x8& pa2, bf16x8& pa3) {
    for (int r = 0; r < 16; ++r) p1[r] = __builtin_amdgcn_exp2f(p1[r]);
    float ps = 0; for (int r = 0; r < 16; ++r) ps += p0[r]; for (int r = 0; r < 16; ++r) ps += p1[r];
    { auto rr = __builtin_amdgcn_permlane32_swap(__float_as_uint(ps), __float_as_uint(ps), false, false);
      ps = __uint_as_float(rr[0]) + __uint_as_float(rr[1]); }
    l_reg = l_reg * alpha + ps;
#define PK4(P, B_, OUT) do { unsigned a0 = cvtpk(P[B_+0], P[B_+1]), a1 = cvtpk(P[B_+2], P[B_+3]);                          \
        unsigned b0 = cvtpk(P[B_+4], P[B_+5]), b1 = cvtpk(P[B_+6], P[B_+7]);                                             \
        auto r0 = __builtin_amdgcn_permlane32_swap(a0, b0, false, false); auto r1 = __builtin_amdgcn_permlane32_swap(a1, b1, false, false); \
        u32x4 w = {r0[0], r1[0], r0[1], r1[1]}; OUT = *reinterpret_cast<bf16x8*>(&w); } while (0)
    PK4(p0, 0, pa0); PK4(p0, 8, pa1); PK4(p1, 0, pa2); PK4(p1, 8, pa3);
#undef PK4
}
template <int KB, bool SK>
__device__ __forceinline__ void qkt(f32x16& p0, f32x16& p1, const char* K_lds, int r32, int hi, const bf16x8* qr, bool act, const ALAS float* fbp) {
    if (SK && !act) { const float NEG = -__builtin_inff();
#pragma unroll
        for (int r = 0; r < 16; ++r) { p0[r] = NEG; p1[r] = NEG; } return; }
#pragma unroll
    for (int a = 0; a < 4; ++a) { const f32x4 t0 = *(const ALAS f32x4*)(fbp + 8 * a), t1 = *(const ALAS f32x4*)(fbp + 32 + 8 * a);
        p0[4 * a] = t0[0]; p0[4 * a + 1] = t0[1]; p0[4 * a + 2] = t0[2]; p0[4 * a + 3] = t0[3];
        p1[4 * a] = t1[0]; p1[4 * a + 1] = t1[1]; p1[4 * a + 2] = t1[2]; p1[4 * a + 3] = t1[3]; }
    const char* kb[4];
#pragma unroll
    for (int dd = 0; dd < 4; ++dd) kb[dd] = K_lds + KB * SHM_K + KSWZ(r32, (dd * 16 + hi * 8) * 2);
#pragma unroll
    for (int d0 = 0; d0 < 8; ++d0) { const char* a = kb[d0 & 3] + (d0 >> 2) * 128;
        bf16x8 b0 = *reinterpret_cast<const bf16x8*>(a);
        bf16x8 b1 = *reinterpret_cast<const bf16x8*>(a + 32 * 256);
        p0 = __builtin_amdgcn_mfma_f32_32x32x16_bf16(b0, qr[d0], p0, 0, 0, 0);
        p1 = __builtin_amdgcn_mfma_f32_32x32x16_bf16(b1, qr[d0], p1, 0, 0, 0); }
}
template <int VB, bool SK>
__device__ __forceinline__ void pv_tile(f32x16* o, int vb0, bf16x8 pa0, bf16x8 pa1, bf16x8 pa2, bf16x8 pa3, bool act) {
    if (SK && !act) return;
#define TRRD(dst, off) asm volatile("ds_read_b64_tr_b16 %0, %1 offset:%2" : "=&v"(dst) : "v"(vb0), "i"(off) : "memory")
#define PV_D0(d0) do { s16x4 l0, l1, l2, l3, h0, h1, h2, h3; constexpr int b_ = VB * SHM_V + v_rd_off(d0, 0, 0);     \
        TRRD(l0, b_); TRRD(h0, b_ + 2048); TRRD(l1, b_ + 4096); TRRD(h1, b_ + 6144); TRRD(l2, b_ + 8192); TRRD(h2, b_ + 10240); TRRD(l3, b_ + 12288); TRRD(h3, b_ + 14336); \
        asm volatile("s_waitcnt lgkmcnt(0)" ::: "memory"); SBAR();                 \
        o[d0] = __builtin_amdgcn_mfma_f32_32x32x16_bf16(pa0, (bf16x8){l0[0], l0[1], l0[2], l0[3], h0[0], h0[1], h0[2], h0[3]}, o[d0], 0, 0, 0);   \
        o[d0] = __builtin_amdgcn_mfma_f32_32x32x16_bf16(pa1, (bf16x8){l1[0], l1[1], l1[2], l1[3], h1[0], h1[1], h1[2], h1[3]}, o[d0], 0, 0, 0);   \
        o[d0] = __builtin_amdgcn_mfma_f32_32x32x16_bf16(pa2, (bf16x8){l2[0], l2[1], l2[2], l2[3], h2[0], h2[1], h2[2], h2[3]}, o[d0], 0, 0, 0);   \
        o[d0] = __builtin_amdgcn_mfma_f32_32x32x16_bf16(pa3, (bf16x8){l3[0], l3[1], l3[2], l3[3], h3[0], h3[1], h3[2], h3[3]}, o[d0], 0, 0, 0); } while (0)
    PV_D0(0); PV_D0(1); PV_D0(2); PV_D0(3);
#undef PV_D0
#undef TRRD
}

template <class TIn, class TOut> struct BlockRef { const TIn* Q; const TIn* K; const TIn* V; TOut* O; const TIn* G; int P0; int JLO; };
template <class TIn> struct Seam {
    bf16x8 qr[8];
    bf16x8 st_v0, st_v1, st_k0, st_k1; f32x4 sf0, sf1, sf2, sf3;
    f32x4 tq[16];
};
__device__ __forceinline__ int swa_jlo(int P0, int W) { const int lowk = P0 - W + 1; return lowk > 0 ? lowk / KVBLK : 0; }
#define ROW(p, k0, rr) ((p) + (size_t)((k0) + (rr)) * D + sc)
#define VMW() asm volatile("s_waitcnt vmcnt(0)" ::: "memory")
#define VMWN(n) asm volatile("s_waitcnt vmcnt(%0)" :: "i"(n) : "memory")
#define SLOAD_H(Kp, Vp, k0) do { S.st_v0 = load8<TIn>(ROW(Vp, k0, sr)); S.st_v1 = load8<TIn>(ROW(Vp, k0, 32 + sr));              \
                         S.st_k0 = load8<TIn>(ROW(Kp, k0, sr)); S.st_k1 = load8<TIn>(ROW(Kp, k0, 32 + sr)); } while (0)
#define SWRITE_HK(bf) do { *(bf16x8*)(K_lds + (bf) * SHM_K + kws) = S.st_k0; *(bf16x8*)(K_lds + (bf) * SHM_K + kws + 32 * 256) = S.st_k1; } while (0)
#define SWRITE_HV(bf) do { *(bf16x8*)(V_lds + (bf) * SHM_V + vst0) = S.st_v0; *(bf16x8*)(V_lds + (bf) * SHM_V + vst1) = S.st_v1; } while (0)
#define SWRITE_H(bf) do { SWRITE_HV(bf); SWRITE_HK(bf); } while (0)
#define SLOAD_F(p, k0) do { S.sf0 = *(const f32x4*)ROW(p, k0, sr); S.sf1 = *(const f32x4*)(ROW(p, k0, sr) + 4);                \
                            S.sf2 = *(const f32x4*)ROW(p, k0, 32 + sr); S.sf3 = *(const f32x4*)(ROW(p, k0, 32 + sr) + 4); } while (0)
#define SWRITE_KF(bf) do { *(bf16x8*)(K_lds + (bf) * SHM_K + kws) = pack8(S.sf0, S.sf1); *(bf16x8*)(K_lds + (bf) * SHM_K + kws + 32 * 256) = pack8(S.sf2, S.sf3); } while (0)
#define SWRITE_VF(bf) do { *(bf16x8*)(V_lds + (bf) * SHM_V + vst0) = pack8(S.sf0, S.sf1); *(bf16x8*)(V_lds + (bf) * SHM_V + vst1) = pack8(S.sf2, S.sf3); } while (0)
template <class TIn, class TOut>
__device__ __forceinline__ void causal_swa_prime(const BlockRef<TIn, TOut>& cur, int W, char* lds, Seam<TIn>& S) {
    constexpr bool F32 = same_t<TIn, float>::v;
    const int tid = tidx(), wid = __builtin_amdgcn_readfirstlane(tid >> 6), lane = tid & 63, r32 = lane & 31, hi = lane >> 5;
    const int sr = tid >> 4, sc = (tid & 15) * 8, kws = KSWZ(sr, sc * 2); char* K_lds = lds + 2 * SHM_V;
    const int kb0 = cur.JLO * KVBLK;
    for (int d0 = 0; d0 < 8; ++d0) S.qr[d0] = load8<TIn>(cur.Q + (size_t)(wid * QBLK + r32) * D + d0 * 16 + hi * 8);
    if constexpr (F32) { SLOAD_F((const float*)cur.K, kb0); VMW(); SWRITE_KF(0); SBAR(); SLOAD_F((const float*)cur.V, kb0); }
    else { SLOAD_H(cur.K, cur.V, kb0); VMW(); SWRITE_HK(0); }
    __syncthreads();
}
template <class TIn, class TOut>
__device__ __forceinline__ void causal_swa_block(const BlockRef<TIn, TOut>& cur, const BlockRef<TIn, TOut>& nxt, int skv, int W, char* lds, Seam<TIn>& S) {
    constexpr bool F32 = same_t<TIn, float>::v;
    const int tid = tidx(), wid = __builtin_amdgcn_readfirstlane(tid >> 6), lane = tid & 63, r32 = lane & 31, hi = lane >> 5;
    const int j_lo = cur.JLO;
    int j_hi = (cur.P0 + QB - 1) / KVBLK + 1; if (j_hi > skv / KVBLK) j_hi = skv / KVBLK;
    const int NT = j_hi - j_lo;
    const int kbn = nxt.JLO * KVBLK;
    const int qlo = cur.P0 + wid * QBLK, qm = qlo + r32 - 4 * hi;
    char* V_lds = lds; char* K_lds = lds + 2 * SHM_V;
    float* ws = (float*)(lds + 2 * SHM_V + 2 * SHM_K) + wid * 64; float* li_l = ws, * al_l = ws + 32;
    float m_reg = -1e30f, l_reg = 0; f32x16 o[4] = {};
    const int sr = tid >> 4, sc = (tid & 15) * 8, vst0 = v_st(sr, sc), vst1 = v_st(32 + sr, sc), kws = KSWZ(sr, sc * 2);
    const int vb0 = (int)(uintptr_t)V_lds + v_rd_base(lane);
    const TIn* Kh = cur.K; const TIn* Vh = cur.V;
#define RESC(a) do { if (__any((a) < 1.f)) { if (hi == 0) al_l[r32] = (a); asm volatile("s_waitcnt lgkmcnt(0)" ::: "memory");              \
                     for (int d_ = 0; d_ < 4; ++d_) for (int r = 0; r < 16; ++r) o[d_][r] *= al_l[crow(r, hi)]; } } while (0)
#define KBASE(t) ((j_lo + (t)) * KVBLK)
    const ALAS float* fb3 = (const ALAS float*)((ALAS char*)lds + FB_OFF) + 4 * hi;
#define FBP(t) (fb3 + KBASE(t))
#define ACT(t) (KBASE(t) <= qlo + QBLK - 1 && KBASE(t) + KVBLK - 1 >= qlo - W + 1)
#define MASKT(P0_, P1_, t) do { const int kb_ = KBASE(t); if ((!SK || ACT(t)) && (kb_ + KVBLK - 1 > qlo || kb_ <= qlo + QBLK - 1 - W)) mask_tile(P0_, P1_, qm - kb_, (unsigned)W); } while (0)
    constexpr int NQL = F32 ? 16 : 8;
    constexpr bool SK = WSKIP && !F32;
#define SEAM_K0() do { VMWN(NQL); if constexpr (F32) { SWRITE_KF(0); SBAR(); SLOAD_F((const float*)nxt.V, kbn); } else { SWRITE_HK(0); } SBAR(); } while (0)
    f32x16 pA0, pA1, pB0, pB1; float mnA, mnB, alA, alB; bf16x8 pa0, pa1, pa2, pa3;
    if constexpr (F32) { VMW(); SWRITE_VF(0); SBAR(); } else { SWRITE_HV(0); SBAR(); }
    if (NT > 1) { if constexpr (F32) SLOAD_F((const float*)Kh, KBASE(1)); else SLOAD_H(Kh, Vh, KBASE(1)); }
    SBAR(); qkt<0, SK>(pA0, pA1, K_lds, r32, hi, S.qr, ACT(0), FBP(0));
    if constexpr (F32) { if (NT > 1) { VMW(); SWRITE_KF(1); SBAR(); SLOAD_F((const float*)Vh, KBASE(1)); } }
    MASKT(pA0, pA1, 0); partialSM(pA0, pA1, m_reg, mnA, alA);
    if (NT > 1) { VMW(); if constexpr (F32) { SWRITE_VF(1); SBAR(); if (NT > 2) SLOAD_F((const float*)Kh, KBASE(2)); } else SWRITE_H(1); }
    __syncthreads();
#define HALF_STEP(PX0, PX1, mnX, alX, PY0, PY1, alY, t, KB, VB, SB) do {                                                      \
        SBAR(); qkt<KB, SK>(PX0, PX1, K_lds, r32, hi, S.qr, ACT(t), FBP(t));                                             \
        finishSM(PY0, PY1, alY, l_reg, pa0, pa1, pa2, pa3); SBAR();                                                           \
        if ((t) + 1 < NT) { if constexpr (F32) { VMW(); SWRITE_KF(SB); SBAR(); SLOAD_F((const float*)Vh, KBASE((t) + 1)); }  \
                            else { SLOAD_H(Kh, Vh, KBASE((t) + 1)); } SBAR(); }                                               \
        pv_tile<VB, SK>(o, vb0, pa0, pa1, pa2, pa3, ACT((t) - 1)); MASKT(PX0, PX1, (t)); partialSM(PX0, PX1, m_reg, mnX, alX);                                        \
        __syncthreads();                                                                                                      \
        if ((t) + 1 < NT) { VMW(); if constexpr (F32) { SWRITE_VF(SB); SBAR(); if ((t) + 2 < NT) SLOAD_F((const float*)Kh, KBASE((t) + 2)); } \
                            else { SWRITE_H(SB); } }                                                                          \
        RESC(alX); __syncthreads(); } while (0)
    for (int t = 1; t + 1 < NT; t += 2) {
        HALF_STEP(pB0, pB1, mnB, alB, pA0, pA1, alA, t, 1, 0, 0);
        HALF_STEP(pA0, pA1, mnA, alA, pB0, pB1, alB, t + 1, 0, 1, 1);
    }
    const bool even = (NT & 1) == 0;
    if (even) { SBAR(); qkt<1, SK>(pB0, pB1, K_lds, r32, hi, S.qr, ACT(NT - 1), FBP(NT - 1)); SBAR(); }
#define QROW(e) (nxt.Q + (size_t)(wid * QBLK + r32) * D + ((e) >> 1) * 16 + hi * 8 + ((e) & 1) * 4)
    if constexpr (F32) { SLOAD_F((const float*)nxt.K, kbn); SBAR();
#pragma unroll
        for (int e = 0; e < 8; ++e) S.tq[e] = *(const f32x4*)QROW(e); }
    else { SLOAD_H(nxt.K, nxt.V, kbn); SBAR();
#pragma unroll
        for (int d0 = 0; d0 < 8; ++d0) S.qr[d0] = load8<TIn>(nxt.Q + (size_t)(wid * QBLK + r32) * D + d0 * 16 + hi * 8); }
    SBAR();
    finishSM(pA0, pA1, alA, l_reg, pa0, pa1, pa2, pa3); SBAR();
    if constexpr (F32) {
#pragma unroll
        for (int e = 8; e < 16; ++e) S.tq[e] = *(const f32x4*)QROW(e); SBAR(); }
#undef QROW
    pv_tile<0, SK>(o, vb0, pa0, pa1, pa2, pa3, ACT(even ? NT - 2 : NT - 1));
    if (even) { MASKT(pB0, pB1, NT - 1); partialSM(pB0, pB1, m_reg, mnB, alB); __syncthreads(); RESC(alB);
        finishSM(pB0, pB1, alB, l_reg, pa0, pa1, pa2, pa3); SBAR(); pv_tile<1, SK>(o, vb0, pa0, pa1, pa2, pa3, ACT(NT - 1)); }
    SBAR(); SEAM_K0();
    if (hi == 0) li_l[r32] = l_reg; asm volatile("s_waitcnt lgkmcnt(0)" ::: "memory");
    float rli[16];
#pragma unroll
    for (int r = 0; r < 16; ++r) rli[r] = __builtin_amdgcn_rcpf(li_l[crow(r, hi)]);
    TOut* Ow = cur.O + (size_t)(wid * QBLK) * OSTR;
#pragma unroll
    for (int r = 0; r < 16; ++r) { const int orow = crow(r, hi);
#pragma unroll
        for (int d0 = 0; d0 < 4; ++d0) {
            const float v = o[d0][r] * rli[r];
            const float vn = __shfl_xor(v, 1);
            if ((r32 & 1) == 0) *(unsigned*)(Ow + (size_t)orow * OSTR + d0 * 32 + r32) = cvtpk(v, vn); } }
    if constexpr (F32) {
#pragma unroll
        for (int d0 = 0; d0 < 8; ++d0) S.qr[d0] = pack8(S.tq[2 * d0], S.tq[2 * d0 + 1]); }
    __syncthreads();
#undef RESC
#undef KBASE
#undef FBP
#undef ACT
#undef MASKT
#undef SEAM_K0
#undef HALF_STEP
}
#undef ROW
#undef VMW
#undef VMWN
#undef SLOAD_H
#undef SWRITE_HK
#undef SWRITE_HV
#undef SWRITE_H
#undef SLOAD_F
#undef SWRITE_KF
#undef SWRITE_VF

}

#define LAS __attribute__((address_space(3)))
typedef unsigned short bf16_t;
typedef short bf16x8 __attribute__((ext_vector_type(8)));
typedef short s16x4 __attribute__((ext_vector_type(4)));
typedef float f32x4 __attribute__((ext_vector_type(4)));
typedef unsigned u32x4 __attribute__((ext_vector_type(4)));
typedef unsigned u32x2 __attribute__((ext_vector_type(2)));

constexpr int NB = 2, SEQ = 8192, T = NB * SEQ, DM = 2048, DFF = 5632;
constexpr int NTHR = 512, NWV = 8;
constexpr float EPS = 1e-6f;
constexpr int FOX_N = 8208, FOX_LD = 8448;
constexpr int GDN_ROWS = 12544;

constexpr size_t MiB = 1u << 20;
constexpr size_t WS_MODS = 0, WS_FL = 1 * MiB, WS_FB = 2 * MiB, WS_AB = 3 * MiB, WS_GB = 7 * MiB, WS_TB = 11 * MiB;
constexpr size_t WS_WA = 17 * MiB, WS_WB = 66 * MiB, WS_H = 88 * MiB, WS_Y = 152 * MiB, WS_BIG = 216 * MiB;
constexpr size_t WS_P = WS_BIG, WS_QH = WS_BIG + 264 * MiB, WS_KH = WS_QH + 64 * MiB, WS_VH = WS_KH + 64 * MiB;
constexpr size_t WS_GV = WS_BIG;
constexpr size_t WS_QKV = WS_BIG, WS_QN = WS_BIG + 256 * MiB, WS_KN = WS_QN + 64 * MiB, WS_KT = WS_KN + 64 * MiB, WS_VT = WS_KT + 64 * MiB;
constexpr size_t WS_TM = WS_BIG, WS_QKM = WS_BIG + 64 * MiB, WS_O = WS_BIG + 128 * MiB, WS_Z = WS_QN;
constexpr size_t WS_END = WS_VT + 128 * MiB;
static_assert((size_t)GDN_ROWS * DM * 2 <= WS_WB - WS_WA && (size_t)DM * DFF * 2 <= WS_H - WS_WB, "weight regions");

constexpr int LDS_TOTAL = 147456;

__device__ __forceinline__ float bf2f(unsigned h) { return __uint_as_float(h << 16); }
typedef float f32x2_t __attribute__((ext_vector_type(2))); typedef __bf16 bf16x2_t __attribute__((ext_vector_type(2)));
__device__ __forceinline__ unsigned pk2(float lo, float hi) { const f32x2_t v = {lo, hi}; const bf16x2_t b = __builtin_convertvector(v, bf16x2_t); return __builtin_bit_cast(unsigned, b); }
__device__ __forceinline__ void unpack8(u32x4 w, float* f) {
    f[0] = __uint_as_float(w.x << 16); f[1] = __uint_as_float(w.x & 0xffff0000u); f[2] = __uint_as_float(w.y << 16); f[3] = __uint_as_float(w.y & 0xffff0000u);
    f[4] = __uint_as_float(w.z << 16); f[5] = __uint_as_float(w.z & 0xffff0000u); f[6] = __uint_as_float(w.w << 16); f[7] = __uint_as_float(w.w & 0xffff0000u);
}
__device__ __forceinline__ u32x4 pack8f(const float* f) { u32x4 w; w.x = pk2(f[0], f[1]); w.y = pk2(f[2], f[3]); w.z = pk2(f[4], f[5]); w.w = pk2(f[6], f[7]); return w; }
__device__ __forceinline__ float wave_sum(float v) {
#pragma unroll
    for (int o = 1; o < 64; o <<= 1) v += __shfl_xor(v, o);
    return v;
}
__device__ __forceinline__ float sum16(float v) { v += __shfl_xor(v, 1); v += __shfl_xor(v, 2); v += __shfl_xor(v, 4); v += __shfl_xor(v, 8); return v; }
__device__ __forceinline__ float sigmoidf_(float x) { return 1.f / (1.f + __expf(-x)); }
__device__ __forceinline__ float siluf_(float x) { return x / (1.f + __expf(-x)); }

struct EpiStore {
    static constexpr bool PERM = true, AFTER_DRAIN = false;
    bf16_t* O; int ldc; int ncols; float* aux; int aux_tile, aux_n;
    __device__ __forceinline__ void operator()(const pg8::f32x4 (&acc)[2][2][4][2], const pg8::Unit& u, int wr, int wc, int fr, int fq) const {
        const int row0 = u.pm * 256 + wr * 64 + fr, col0 = u.pn * 256 + wc * 32 + 8 * fq;
#pragma unroll
        for (int ai = 0; ai < 2; ++ai)
#pragma unroll
            for (int m = 0; m < 4; ++m) { const int row = row0 + ai * 128 + m * 16; bf16_t* rowp = O + (size_t)row * ldc + col0;
#pragma unroll
                for (int bj = 0; bj < 2; ++bj) { const pg8::f32x4 v0 = acc[ai][bj][m][0], v1 = acc[ai][bj][m][1];
                    if (col0 + bj * 128 < ncols) { u32x4 w; w.x = pk2(v0[0], v0[1]); w.y = pk2(v0[2], v0[3]); w.z = pk2(v1[0], v1[1]); w.w = pk2(v1[2], v1[3]);
                        *(u32x4*)(rowp + bj * 128) = w; }
                    if (u.pn == aux_tile) { const int ct = wc * 32 + 8 * fq + bj * 128;
                        if (ct < aux_n) { float* ap = aux + (size_t)row * aux_n + ct; *(pg8::f32x4*)ap = v0; *(pg8::f32x4*)(ap + 4) = v1; } } } }
    }
};
__device__ __forceinline__ void run_gemm(LAS unsigned char* lds, const bf16_t* A, int lda, const bf16_t* Bt, int N, int K, bf16_t* O, int ldc, int ncols, float* aux, int aux_tile, int aux_n) {
    pg8::Gemm g{A, Bt, T, N, K, lda}; pg8::StaticOrder S; S.init(T, N, (int)gridDim.x, (int)blockIdx.x);
    EpiStore E{O, ldc, ncols, aux, aux_tile, aux_n};
    pg8::gemm_phase<EpiStore, pg8::StaticOrder, true, true>(lds, g, S, E);
}

__device__ __forceinline__ void convert_weight(LAS unsigned char* lds, const float* W, int K, int N, bf16_t* WT, int seg1, int add1, int seg2, int add2) {
    const int lane = tidx() & 63, wave = tidx() >> 6;
    LAS float* scr = (LAS float*)(lds + wave * 16384);
    const int gw = blockIdx.x * NWV + wave, NGW = gridDim.x * NWV;
    const int nblk = (N + 31) / 32, nitems = (K / 64) * nblk;
    for (int item = gw; item < nitems; item += NGW) {
        const int kb = item / nblk, nb = item % nblk, k0 = 64 * kb, n0 = 32 * nb;
        const int c4 = (lane & 7) * 4, nn = n0 + c4; const bool ok = nn < N;
        f32x4 vld[8];
#pragma unroll
        for (int i = 0; i < 8; ++i) { const int kk = 8 * i + (lane >> 3); vld[i] = ok ? *(const f32x4*)(W + (size_t)(k0 + kk) * N + nn) : (f32x4){0.f, 0.f, 0.f, 0.f}; }
#pragma unroll
        for (int i = 0; i < 8; ++i) { const int kk = 8 * i + (lane >> 3); LAS float* sp = scr + kk * 33 + c4; sp[0] = vld[i][0]; sp[1] = vld[i][1]; sp[2] = vld[i][2]; sp[3] = vld[i][3]; }
        asm volatile("s_waitcnt lgkmcnt(0)" ::: "memory");
        const int c = lane & 7;
#pragma unroll
        for (int j = 0; j < 4; ++j) { const int nl = (lane >> 3) + 8 * j, n = n0 + nl; const LAS float* s = scr + (8 * c) * 33 + nl;
            u32x4 o; o.x = pk2(s[0 * 33], s[1 * 33]); o.y = pk2(s[2 * 33], s[3 * 33]); o.z = pk2(s[4 * 33], s[5 * 33]); o.w = pk2(s[6 * 33], s[7 * 33]);
            if (n < N) { const int row = n + (n >= seg2 ? add2 : (n >= seg1 ? add1 : 0)); *(u32x4*)(WT + (size_t)row * K + k0 + 8 * c) = o; } }
        asm volatile("s_waitcnt lgkmcnt(0)" ::: "memory");
    }
    __syncthreads();
}
constexpr int NOSEG = 0x7fffffff;

__device__ __forceinline__ void mods_phase(LAS unsigned char* lds, const float* c, const float* ada_w, const float* ada_b, float* Mods) {
    const int tid = tidx(), lane = tid & 63, wave = tid >> 6, e4 = lane & 15, ds = lane >> 4;
    LAS float* red = (LAS float*)lds;
    for (int u = blockIdx.x; u < 4 * 96; u += gridDim.x) {
        const int is = u / 96, e0 = (u % 96) * 64;
        f32x4 a0 = {0.f, 0.f, 0.f, 0.f}, a1 = {0.f, 0.f, 0.f, 0.f};
#pragma unroll 8
        for (int it = 0; it < 64; ++it) { const int d = 256 * wave + 4 * it + ds;
            const f32x4 wv = *(const f32x4*)(ada_w + ((size_t)is * DM + d) * (3 * DM) + e0 + 4 * e4);
            const float c0 = siluf_(c[d]), c1 = siluf_(c[DM + d]);
            a0 += wv * c0; a1 += wv * c1; }
#pragma unroll
        for (int k = 0; k < 4; ++k) { a0[k] += __shfl_xor(a0[k], 16); a0[k] += __shfl_xor(a0[k], 32); a1[k] += __shfl_xor(a1[k], 16); a1[k] += __shfl_xor(a1[k], 32); }
        if (lane < 16) {
#pragma unroll
            for (int k = 0; k < 4; ++k) { red[(wave * 2 + 0) * 64 + 4 * e4 + k] = a0[k]; red[(wave * 2 + 1) * 64 + 4 * e4 + k] = a1[k]; } }
        __syncthreads();
        if (tid < 128) { const int b = tid >> 6, e = tid & 63; float s = 0.f;
#pragma unroll
            for (int w = 0; w < 8; ++w) s += red[(w * 2 + b) * 64 + e];
            Mods[((size_t)is * 2 + b) * (3 * DM) + e0 + e] = s + ada_b[(size_t)is * (3 * DM) + e0 + e]; }
        __syncthreads();
    }
}

__device__ __forceinline__ void row_phase(const float* xin, float* xout, const bf16_t* Yb, const float* gate, const float* gpost, bf16_t* Hout, const float* gpre, const float* shift, const float* scale) {
    const int lane = tidx() & 63, wave = __builtin_amdgcn_readfirstlane(tidx() >> 6);
    const int gw = blockIdx.x * NWV + wave, NGW = gridDim.x * NWV;
    for (int row = gw; row < T; row += 2 * NGW) {
        const int row1 = row + NGW; const int b = row >> 13; const size_t mo = (size_t)b * 3 * DM;
        f32x4 x0[8], x1[8];
#pragma unroll
        for (int j = 0; j < 8; ++j) { x0[j] = *(const f32x4*)(xin + (size_t)row * DM + 4 * lane + 256 * j); x1[j] = *(const f32x4*)(xin + (size_t)row1 * DM + 4 * lane + 256 * j); }
        if (Yb) {
            u32x2 w0[8], w1[8]; float s0 = 0.f, s1 = 0.f;
#define UNPK4(w) ((f32x4){__uint_as_float((w).x << 16), __uint_as_float((w).x & 0xffff0000u), __uint_as_float((w).y << 16), __uint_as_float((w).y & 0xffff0000u)})
#pragma unroll
            for (int j = 0; j < 8; ++j) { w0[j] = *(const u32x2*)(Yb + (size_t)row * DM + 4 * lane + 256 * j); w1[j] = *(const u32x2*)(Yb + (size_t)row1 * DM + 4 * lane + 256 * j);
                const f32x4 a = UNPK4(w0[j]), c = UNPK4(w1[j]);
                s0 += (a[0] * a[0] + a[1] * a[1]) + (a[2] * a[2] + a[3] * a[3]); s1 += (c[0] * c[0] + c[1] * c[1]) + (c[2] * c[2] + c[3] * c[3]); }
            const float r0 = rsqrtf(wave_sum(s0) * (1.f / DM) + EPS), r1 = rsqrtf(wave_sum(s1) * (1.f / DM) + EPS);
#pragma unroll
            for (int j = 0; j < 8; ++j) { const int c = 4 * lane + 256 * j; const f32x4 m = *(const f32x4*)(gate + mo + c) * *(const f32x4*)(gpost + c);
                x0[j] += m * (UNPK4(w0[j]) * r0); x1[j] += m * (UNPK4(w1[j]) * r1); }
#undef UNPK4
        }
        if (xout) {
#pragma unroll
            for (int j = 0; j < 8; ++j) { *(f32x4*)(xout + (size_t)row * DM + 4 * lane + 256 * j) = x0[j]; *(f32x4*)(xout + (size_t)row1 * DM + 4 * lane + 256 * j) = x1[j]; }
        }
        if (Hout) {
            float s0 = 0.f, s1 = 0.f;
#pragma unroll
            for (int j = 0; j < 8; ++j) { s0 += (x0[j][0] * x0[j][0] + x0[j][1] * x0[j][1]) + (x0[j][2] * x0[j][2] + x0[j][3] * x0[j][3]);
                s1 += (x1[j][0] * x1[j][0] + x1[j][1] * x1[j][1]) + (x1[j][2] * x1[j][2] + x1[j][3] * x1[j][3]); }
            const float r0 = rsqrtf(wave_sum(s0) * (1.f / DM) + EPS), r1 = rsqrtf(wave_sum(s1) * (1.f / DM) + EPS);
#pragma unroll
            for (int j = 0; j < 8; ++j) { const int c = 4 * lane + 256 * j; const f32x4 a = *(const f32x4*)(gpre + c) * (*(const f32x4*)(scale + mo + c) + 1.f), sh = *(const f32x4*)(shift + mo + c);
                const f32x4 h0 = x0[j] * r0 * a + sh, h1 = x1[j] * r1 * a + sh; u32x2 w0, w1; w0.x = pk2(h0[0], h0[1]); w0.y = pk2(h0[2], h0[3]); w1.x = pk2(h1[0], h1[1]); w1.y = pk2(h1[2], h1[3]);
                *(u32x2*)(Hout + (size_t)row * DM + c) = w0; *(u32x2*)(Hout + (size_t)row1 * DM + c) = w1; }
        }
    }
}

__device__ __forceinline__ void fox_prep(const bf16_t* P, const float* FL, const float* fbias, const float* qg, const float* kg, bf16_t* Qh, bf16_t* Kh, bf16_t* Vh, float* FB) {
    const int lane = tidx() & 63, wave = tidx() >> 6;
    const int gw = blockIdx.x * NWV + wave, NGW = gridDim.x * NWV;
    const int dl = (lane & 15) * 8;
    float gq[8], gk[8];
#pragma unroll
    for (int j = 0; j < 8; ++j) { gq[j] = qg[dl + j]; gk[j] = kg[dl + j]; }
    for (int row = gw; row < T; row += NGW) {
        const int b = row >> 13, s = row & (SEQ - 1);
#pragma unroll
        for (int part = 0; part < 3; ++part) {
#pragma unroll
            for (int p = 0; p < 4; ++p) {
                const int col = p * 512 + lane * 8, h = col >> 7;
                const u32x4 w = *(const u32x4*)(P + (size_t)row * FOX_LD + part * 2048 + col);
                bf16_t* dst = (part == 0 ? Qh : (part == 1 ? Kh : Vh)) + (((size_t)(b * 16 + h) * SEQ + s) * 128 + dl);
                if (part == 2) { *(u32x4*)dst = w; }
                else { float f[8]; unpack8(w, f); float ss = 0.f;
#pragma unroll
                    for (int j = 0; j < 8; ++j) ss += f[j] * f[j];
                    const float r = rsqrtf(sum16(ss) * (1.f / 128.f) + EPS);
#pragma unroll
                    for (int j = 0; j < 8; ++j) f[j] = f[j] * r * (part == 0 ? gq[j] : gk[j]);
                    *(u32x4*)dst = pack8f(f); }
            }
        }
    }
    if (wave == 0 && blockIdx.x < 32) {
        const int bh = blockIdx.x, b = bh >> 4, h = bh & 15; const float fb = fbias[h];
        const float* src = FL + ((size_t)b * SEQ + lane * 128) * 16 + h;
        float tot = 0.f;
#pragma unroll 16
        for (int i = 0; i < 128; ++i) { const float x = src[(size_t)i * 16] + fb; tot += (x >= 0.f) ? -log1pf(expf(-x)) : (x - log1pf(expf(x))); }
        float incl = tot;
#pragma unroll
        for (int o = 1; o < 64; o <<= 1) { const float t = __shfl_up(incl, o); if (lane >= o) incl += t; }
        float run = incl - tot;
        float* dst = FB + (size_t)bh * SEQ + lane * 128;
#pragma unroll 16
        for (int i = 0; i < 128; ++i) { const float x = src[(size_t)i * 16] + fb; run += (x >= 0.f) ? -log1pf(expf(-x)) : (x - log1pf(expf(x))); dst[i] = -run * 11.313708498984761f; }
    }
}

__device__ __forceinline__ void fox_attention(char* lds, const bf16_t* Qh, const bf16_t* Kh, const bf16_t* Vh, const bf16_t* P, const float* FB, bf16_t* AO, const float* qg, const float* kg) {
    using abf = att::bf16; typedef att::BlockRef<abf, abf> Ref;
    float thr_t;
    { const int ll = tidx() & 63; float mq = fmaxf(fabsf(qg[ll]), fabsf(qg[64 + ll])), mk = fmaxf(fabsf(kg[ll]), fabsf(kg[64 + ll]));
#pragma unroll
      for (int o = 1; o < 64; o <<= 1) { mq = fmaxf(mq, __shfl_xor(mq, o)); mk = fmaxf(mk, __shfl_xor(mk, o)); }
      thr_t = 2.04f * 128.f * mq * mk + 32.f * 11.313708498984761f; }
    for (int L = blockIdx.x; L < 512; L += gridDim.x) {
        const int bh = L >> 4, x = L & 15, b = bh >> 4, h = bh & 15;
        __syncthreads();
        {
            const f32x4* src = (const f32x4*)(FB + (size_t)bh * SEQ); LAS f32x4* dst = (LAS f32x4*)((LAS char*)lds + att::FB_OFF);
            const int tl = tidx();
#pragma unroll
            for (int i = 0; i < 4; ++i) dst[tl + i * NTHR] = src[tl + i * NTHR];
        }
        Ref r0, r1;
        const int qb0 = x, qb1 = 31 - x;
        __syncthreads();
        int jl[2];
#pragma unroll
        for (int pass = 0; pass < 2; ++pass) { const int P0 = (pass ? qb1 : qb0) * 256; const LAS float* tbl = (const LAS float*)((LAS char*)lds + att::FB_OFF);
            const float ref = tbl[P0]; int lo = 0, hi = P0 >> 6;
            while (lo < hi) { const int mid = (lo + hi + 1) >> 1; if (ref - tbl[64 * mid - 1] > thr_t) lo = mid; else hi = mid - 1; }
            jl[pass] = __builtin_amdgcn_readfirstlane(lo); }
        r0.Q = (const abf*)Qh + ((size_t)bh * SEQ + (size_t)qb0 * 256) * 128; r0.K = (const abf*)Kh + (size_t)bh * SEQ * 128; r0.V = (const abf*)Vh + (size_t)bh * SEQ * 128;
        r0.O = (abf*)AO + ((size_t)b * SEQ + (size_t)qb0 * 256) * DM + h * 128; r0.G = nullptr; r0.P0 = qb0 * 256; r0.JLO = jl[0];
        r1 = r0;
        r1.Q = (const abf*)Qh + ((size_t)bh * SEQ + (size_t)qb1 * 256) * 128;
        r1.O = (abf*)AO + ((size_t)b * SEQ + (size_t)qb1 * 256) * DM + h * 128; r1.P0 = qb1 * 256; r1.JLO = jl[1];
        att::Seam<abf> S;
        att::causal_swa_prime<abf, abf>(r0, SEQ, lds, S);
        att::causal_swa_block<abf, abf>(r0, r1, SEQ, SEQ, lds, S);
        att::causal_swa_block<abf, abf>(r1, r1, SEQ, SEQ, lds, S);
        asm volatile("s_waitcnt vmcnt(0)" ::: "memory");
        __syncthreads();
#pragma unroll 1
        for (int pass = 0; pass < 2; ++pass) { const int qb = pass ? qb1 : qb0;
#pragma unroll 2
            for (int i = 0; i < 8; ++i) { const int idx = tidx() + NTHR * i, row = idx >> 4, c8 = idx & 15; const size_t trow = (size_t)b * SEQ + (size_t)qb * 256 + row;
                bf16_t* op = AO + trow * DM + h * 128 + c8 * 8; const bf16_t* gp = P + trow * FOX_LD + 6160 + h * 128 + c8 * 8;
                float o[8], g[8]; unpack8(*(const u32x4*)op, o); unpack8(*(const u32x4*)gp, g);
#pragma unroll
                for (int j = 0; j < 8; ++j) o[j] *= sigmoidf_(g[j]);
                *(u32x4*)op = pack8f(o); } }
    }
    asm volatile("s_waitcnt vmcnt(0)" ::: "memory");
    __syncthreads();
}

__device__ __forceinline__ void glu_phase(bf16_t* GV, const float* cw, const float* cb) {
    constexpr int LD = 2 * DFF, NCG = DFF / 8, RUN = 32, NTASK = (T / RUN) * NCG;
    const int gt = blockIdx.x * NTHR + tidx(), NGT = gridDim.x * NTHR;
    for (int task = gt; task < NTASK; task += NGT) {
        const int run = task / NCG, cgp = task % NCG, col = cgp * 8, t0 = run * RUN;
        float w0[8], w1[8], w2[8], bb[8];
#pragma unroll
        for (int j = 0; j < 8; ++j) { w0[j] = cw[col + j]; w1[j] = cw[DFF + col + j]; w2[j] = cw[2 * DFF + col + j]; bb[j] = cb[col + j]; }
        float h0[8], h1[8];
        if ((t0 & (SEQ - 1)) == 0) {
#pragma unroll
            for (int j = 0; j < 8; ++j) { h0[j] = 0.f; h1[j] = 0.f; }
        } else { unpack8(*(const u32x4*)(GV + (size_t)(t0 - 2) * LD + col), h0); unpack8(*(const u32x4*)(GV + (size_t)(t0 - 1) * LD + col), h1); }
#pragma unroll 4
        for (int i = 0; i < RUN; ++i) {
            bf16_t* rp = GV + (size_t)(t0 + i) * LD + col;
            float g[8], v[8], o[8]; unpack8(*(const u32x4*)rp, g); unpack8(*(const u32x4*)(rp + DFF), v);
#pragma unroll
            for (int j = 0; j < 8; ++j) { const float a = w0[j] * h0[j] + w1[j] * h1[j] + w2[j] * g[j] + bb[j];
                o[j] = 0.5f * a * (1.f + erff(a * 0.70710678118654752f)) * v[j]; h0[j] = h1[j]; h1[j] = g[j]; }
            *(u32x4*)(rp + DFF) = pack8f(o);
        }
    }
}

__device__ __forceinline__ void gdn_prep(const bf16_t* QKV, const float* AB, const float* cw, const float* a_log, const float* dt_bias,
                                         bf16_t* qn, bf16_t* kn, bf16_t* kT, bf16_t* vT, float* Gt, float* Bt) {
    const int gt = blockIdx.x * NTHR + tidx(), NGT = gridDim.x * NTHR;
    for (int i = gt; i < T * 32; i += NGT) { const int t = i >> 5, hv = i & 31;
        const float a = AB[(size_t)t * 64 + hv] + dt_bias[hv], bq = AB[(size_t)t * 64 + 32 + hv];
        const float sp = a > 20.f ? a : log1pf(expf(a));
        Gt[i] = -expf(a_log[hv]) * sp; Bt[i] = 1.f / (1.f + expf(-bq)); }
    for (int task = gt; task < 256 * 1024; task += NGT) {
        const int chunk = task >> 10, cgp = task & 1023, col = cgp * 8, n = chunk & 127, row0 = chunk * 64;
        const int type = col < 2048 ? 0 : (col < 4096 ? 1 : 2);
        float w0[8], w1[8], w2[8], w3[8], h0[8], h1[8], h2[8];
#pragma unroll
        for (int j = 0; j < 8; ++j) { w0[j] = cw[col + j]; w1[j] = cw[8192 + col + j]; w2[j] = cw[2 * 8192 + col + j]; w3[j] = cw[3 * 8192 + col + j]; }
        if (n == 0) {
#pragma unroll
            for (int j = 0; j < 8; ++j) { h0[j] = 0.f; h1[j] = 0.f; h2[j] = 0.f; }
        } else { unpack8(*(const u32x4*)(QKV + (size_t)(row0 - 3) * 8192 + col), h0); unpack8(*(const u32x4*)(QKV + (size_t)(row0 - 2) * 8192 + col), h1); unpack8(*(const u32x4*)(QKV + (size_t)(row0 - 1) * 8192 + col), h2); }
        const float qs = type == 0 ? 0.08838834764831845f : 1.f;
        for (int rb = 0; rb < 8; ++rb) {
            float yv[8][8];
#pragma unroll
            for (int rr = 0; rr < 8; ++rr) {
                const int t = row0 + rb * 8 + rr; float xv[8]; unpack8(*(const u32x4*)(QKV + (size_t)t * 8192 + col), xv);
                float ss = 0.f;
#pragma unroll
                for (int j = 0; j < 8; ++j) { float y = w0[j] * h0[j] + w1[j] * h1[j] + w2[j] * h2[j] + w3[j] * xv[j]; h0[j] = h1[j]; h1[j] = h2[j]; h2[j] = xv[j];
                    y = siluf_(y); yv[rr][j] = y; ss += y * y; }
                if (type < 2) { const float r = rsqrtf(sum16(ss) + EPS) * qs;
#pragma unroll
                    for (int j = 0; j < 8; ++j) yv[rr][j] *= r;
                    *(u32x4*)((type == 0 ? qn : kn) + (size_t)t * 2048 + (col & 2047)) = pack8f(yv[rr]); }
            }
            if (type > 0) {
                const int cc = type == 1 ? col - 2048 : col - 4096, hh = cc >> 7, d0 = cc & 127;
                bf16_t* base = type == 1 ? kT + ((size_t)chunk * 16 + hh) * 8192 + (size_t)(rb * 128 + d0) * 8 : vT + ((size_t)chunk * 32 + hh) * 8192 + (size_t)(rb * 128 + d0) * 8;
#pragma unroll
                for (int j = 0; j < 8; ++j) { u32x4 w; w.x = pk2(yv[0][j], yv[1][j]); w.y = pk2(yv[2][j], yv[3][j]); w.z = pk2(yv[4][j], yv[5][j]); w.w = pk2(yv[6][j], yv[7][j]);
                    *(u32x4*)(base + (size_t)j * 8) = w; }
            }
        }
    }
}

__device__ __forceinline__ void gdn_g1(LAS unsigned char* lds, const bf16_t* qn, const bf16_t* kn, const float* Gt, const float* Bt, bf16_t* Tm, bf16_t* QKm, float* TB) {
    const int tid = tidx(), lane = tid & 63, wid = __builtin_amdgcn_readfirstlane(tid >> 6), r = lane & 15, g = lane >> 4;
    const int grp = wid >> 1, lw = wid & 1;
    LAS float* Am = (LAS float*)(lds + grp * 35840);
    LAS float* gcs = (LAS float*)(lds + grp * 35840 + 34816);
    LAS float* bts = (LAS float*)(lds + grp * 35840 + 35328);
    for (int u0 = blockIdx.x; u0 < 1024; u0 += gridDim.x) {
        const int unit = u0 + grp * 1024;
        const int chunk = unit >> 4, hk = unit & 15, row0 = chunk * 64;
        { const int hv = 2 * hk + lw;
            const float gv = Gt[(size_t)(row0 + lane) * 32 + hv], bv = Bt[(size_t)(row0 + lane) * 32 + hv];
            float sc = gv;
#pragma unroll
            for (int o = 1; o < 64; o <<= 1) { const float t = __shfl_up(sc, o); if (lane >= o) sc += t; }
            const float gl = __shfl(sc, 63);
            gcs[lw * 64 + lane] = sc; bts[lw * 64 + lane] = bv;
            float* tb = TB + ((size_t)chunk * 32 + hv) * 192;
            tb[lane] = bv; tb[64 + lane] = expf(sc); tb[128 + lane] = expf(gl - sc); }
        __syncthreads();
#pragma unroll 1
        for (int nt2 = 0; nt2 < 2; ++nt2) {
            const int nt = 2 * lw + nt2, c = 16 * nt + r;
            bf16x8 kY[4], qY[4];
            const bf16_t* yb = kn + (size_t)(row0 + 16 * nt + r) * 2048 + hk * 128 + 8 * g; const bf16_t* qb = qn + (size_t)(row0 + 16 * nt + r) * 2048 + hk * 128 + 8 * g;
#pragma unroll
            for (int ks = 0; ks < 4; ++ks) { kY[ks] = *(const bf16x8*)(yb + 32 * ks); qY[ks] = *(const bf16x8*)(qb + 32 * ks); }
#pragma unroll
            for (int mt = 0; mt < 4; ++mt) {
                const bf16_t* xb = kn + (size_t)(row0 + 16 * mt + r) * 2048 + hk * 128 + 8 * g;
                f32x4 kk = {0.f, 0.f, 0.f, 0.f}, qk = {0.f, 0.f, 0.f, 0.f};
#pragma unroll
                for (int ks = 0; ks < 4; ++ks) { const bf16x8 X = *(const bf16x8*)(xb + 32 * ks);
                    kk = __builtin_amdgcn_mfma_f32_16x16x32_bf16(X, kY[ks], kk, 0, 0, 0); qk = __builtin_amdgcn_mfma_f32_16x16x32_bf16(X, qY[ks], qk, 0, 0, 0); }
#pragma unroll
                for (int j = 0; j < 2; ++j) { const float gcc = gcs[j * 64 + c], bc = bts[j * 64 + c]; const f32x4 gcp = *(const LAS f32x4*)(gcs + j * 64 + 16 * mt + 4 * g);
                    f32x4 av; float qv[4];
#pragma unroll
                    for (int i = 0; i < 4; ++i) { const int cp = 16 * mt + 4 * g + i; const float e = __expf(fminf(gcc - gcp[i], 0.f));
                        av[i] = (c > cp) ? kk[i] * bc * e : 0.f; qv[i] = (c >= cp) ? qk[i] * e : 0.f; }
                    *(LAS f32x4*)(Am + (j * 64 + c) * 68 + 16 * mt + 4 * g) = av;
                    u32x2 w; w.x = pk2(qv[0], qv[1]); w.y = pk2(qv[2], qv[3]);
                    *(u32x2*)(QKm + (((size_t)chunk * 32 + 2 * hk + j) * 64 + c) * 64 + 16 * mt + 4 * g) = w; }
            }
        }
        __syncthreads();
        {
            const LAS float* A = Am + lw * 64 * 68; float t[64];
#pragma unroll
            for (int i = 0; i < 64; ++i) t[i] = 0.f;
#pragma unroll
            for (int i = 0; i < 64; ++i) { float acc = (lane == i) ? 1.f : 0.f, acc1 = 0.f, acc2 = 0.f, acc3 = 0.f;
#pragma unroll
                for (int jb = 0; jb < (i + 3) / 4; ++jb) { const f32x4 a = *(const LAS f32x4*)(A + i * 68 + 4 * jb);
                    acc -= a[0] * t[4 * jb]; acc1 -= a[1] * t[4 * jb + 1]; acc2 -= a[2] * t[4 * jb + 2]; acc3 -= a[3] * t[4 * jb + 3]; }
                t[i] = (acc + acc1) + (acc2 + acc3); }
            bf16_t* tp = Tm + ((size_t)chunk * 32 + 2 * hk + lw) * 4096 + lane;
#pragma unroll
            for (int i = 0; i < 64; ++i) tp[i * 64] = (bf16_t)(pk2(t[i], 0.f) & 0xffffu);
        }
        __syncthreads();
    }
}

__device__ __forceinline__ s16x4 ldsrd8(const LAS unsigned char* p) { return *(const LAS s16x4*)p; }
__device__ __forceinline__ bf16x8 join8(s16x4 a, s16x4 b) { return (bf16x8){a[0], a[1], a[2], a[3], b[0], b[1], b[2], b[3]}; }
__device__ __forceinline__ bf16x8 packf8(f32x4 a, f32x4 b) { u32x4 w; w.x = pk2(a[0], a[1]); w.y = pk2(a[2], a[3]); w.z = pk2(b[0], b[1]); w.w = pk2(b[2], b[3]); return __builtin_bit_cast(bf16x8, w); }
__device__ __forceinline__ void gdn_g2(LAS unsigned char* lds, const bf16_t* qn, const bf16_t* kn, const bf16_t* kT, const bf16_t* vT, const bf16_t* Tm, const bf16_t* QKm, const float* TB, bf16_t* O) {
    if (blockIdx.x >= 128) return;
    const int tid = tidx(), lane = tid & 63, wid = __builtin_amdgcn_readfirstlane(tid >> 6), r = lane & 15, g = lane >> 4;
    const int b = blockIdx.x >> 6, hv = (blockIdx.x >> 1) & 31, hk = hv >> 1, e0 = (blockIdx.x & 1) * 64 + (wid & 3) * 16;
    constexpr int O_KN = 0, O_QN = 16384, O_KT = 32768, O_TT = 49152, O_QK = 57344, BUFB = 65536, O_TB = 131072;
    int off128[8], off64[4];
#pragma unroll
    for (int q = 0; q < 8; ++q) { const int p = 2 * q + (g >> 1); off128[q] = r * 256 + ((p ^ r) << 4) + 8 * (g & 1); }
#pragma unroll
    for (int q = 0; q < 4; ++q) { const int p = 2 * q + (g >> 1); off64[q] = r * 128 + ((p ^ ((r >> 1) & 7)) << 4) + 8 * (g & 1); }
    f32x4 S[8];
#pragma unroll
    for (int i = 0; i < 8; ++i) S[i] = (f32x4){0.f, 0.f, 0.f, 0.f};
    f32x4 tbreg = {0.f, 0.f, 0.f, 0.f};
#define G2_ISSUE(n_, bf_) do { const int chunk_ = b * 128 + (n_); \
        _Pragma("unroll") for (int i_ = 0; i_ < 8; ++i_) { const int q_ = wid * 64 + lane + 512 * i_; const bf16_t* src_; \
            if (i_ < 4) { const int ql = q_ & 1023, row = ql >> 4, p = (ql & 15) ^ (row & 15); src_ = (i_ < 2 ? kn : qn) + (size_t)(chunk_ * 64 + row) * 2048 + hk * 128 + p * 8; } \
            else if (i_ < 6) { const int ql = q_ - 2048, row = ql >> 3, p = (ql & 7) ^ ((row >> 1) & 7); src_ = kT + ((size_t)chunk_ * 16 + hk) * 8192 + (size_t)(p * 128 + row) * 8; } \
            else { const int ql = q_ - (i_ == 6 ? 3072 : 3584), row = ql >> 3, p = (ql & 7) ^ ((row >> 1) & 7); src_ = (i_ == 6 ? Tm : QKm) + (((size_t)chunk_ * 32 + hv) * 64 + row) * 64 + p * 8; } \
            __builtin_amdgcn_global_load_lds((const unsigned*)src_, (LAS unsigned*)(lds + (bf_) * BUFB + (512 * i_ + wid * 64) * 16), 16, 0, 0); } \
        if (tid < 48) tbreg = *(const f32x4*)(TB + ((size_t)chunk_ * 32 + hv) * 192 + tid * 4); } while (0)
    G2_ISSUE(0, 0);
    if (tid < 48) *(LAS f32x4*)(lds + O_TB + tid * 16) = tbreg;
    for (int n = 0; n < 128; ++n) {
        const int bf = n & 1; const int chunk = b * 128 + n;
        asm volatile("s_waitcnt vmcnt(0)" ::: "memory");
        __syncthreads();
        if (n + 1 < 128) G2_ISSUE(n + 1, bf ^ 1);
        if (wid < 4) {
        f32x4 vv[4];
        { const bf16_t* vp = vT + ((size_t)chunk * 32 + hv) * 8192 + (size_t)((g >> 1) * 128 + e0 + r) * 8 + 4 * (g & 1);
#pragma unroll
          for (int mt = 0; mt < 4; ++mt) { const u32x2 w = *(const u32x2*)(vp + 2048 * mt);
              vv[mt] = (f32x4){__uint_as_float(w.x << 16), __uint_as_float(w.x & 0xffff0000u), __uint_as_float(w.y << 16), __uint_as_float(w.y & 0xffff0000u)}; } }
        const LAS unsigned char* B0 = lds + bf * BUFB;
        const LAS float* tb = (const LAS float*)(lds + O_TB + bf * 768);
        bf16x8 Sb[4];
#pragma unroll
        for (int ks = 0; ks < 4; ++ks) Sb[ks] = packf8(S[2 * ks], S[2 * ks + 1]);
        f32x4 kS[4], qS[4];
#pragma unroll
        for (int mt = 0; mt < 4; ++mt) { kS[mt] = (f32x4){0.f, 0.f, 0.f, 0.f}; qS[mt] = (f32x4){0.f, 0.f, 0.f, 0.f};
#pragma unroll
            for (int ks = 0; ks < 4; ++ks) {
                const bf16x8 xk = join8(ldsrd8(B0 + O_KN + mt * 4096 + off128[2 * ks]), ldsrd8(B0 + O_KN + mt * 4096 + off128[2 * ks + 1]));
                const bf16x8 xq = join8(ldsrd8(B0 + O_QN + mt * 4096 + off128[2 * ks]), ldsrd8(B0 + O_QN + mt * 4096 + off128[2 * ks + 1]));
                kS[mt] = __builtin_amdgcn_mfma_f32_16x16x32_bf16(xk, Sb[ks], kS[mt], 0, 0, 0);
                qS[mt] = __builtin_amdgcn_mfma_f32_16x16x32_bf16(xq, Sb[ks], qS[mt], 0, 0, 0); } }
        f32x4 beta[4], eg[4], ed[4];
#pragma unroll
        for (int mt = 0; mt < 4; ++mt) { beta[mt] = *(const LAS f32x4*)(tb + 16 * mt + 4 * g); eg[mt] = *(const LAS f32x4*)(tb + 64 + 16 * mt + 4 * g); ed[mt] = *(const LAS f32x4*)(tb + 128 + 16 * mt + 4 * g); }
        const float egl = tb[64 + 63];
        f32x4 rr[4];
#pragma unroll
        for (int mt = 0; mt < 4; ++mt) rr[mt] = beta[mt] * (vv[mt] - eg[mt] * kS[mt]);
        bf16x8 rb[2] = {packf8(rr[0], rr[1]), packf8(rr[2], rr[3])};
        f32x4 vn[4];
#pragma unroll
        for (int mt = 0; mt < 4; ++mt) { vn[mt] = (f32x4){0.f, 0.f, 0.f, 0.f};
#pragma unroll
            for (int ks = 0; ks < 2; ++ks) { const bf16x8 xt = join8(ldsrd8(B0 + O_TT + mt * 2048 + off64[2 * ks]), ldsrd8(B0 + O_TT + mt * 2048 + off64[2 * ks + 1]));
                vn[mt] = __builtin_amdgcn_mfma_f32_16x16x32_bf16(xt, rb[ks], vn[mt], 0, 0, 0); } }
        bf16x8 vnb[2] = {packf8(vn[0], vn[1]), packf8(vn[2], vn[3])};
        f32x4 o[4];
#pragma unroll
        for (int mt = 0; mt < 4; ++mt) { o[mt] = eg[mt] * qS[mt];
#pragma unroll
            for (int ks = 0; ks < 2; ++ks) { const bf16x8 xq = join8(ldsrd8(B0 + O_QK + mt * 2048 + off64[2 * ks]), ldsrd8(B0 + O_QK + mt * 2048 + off64[2 * ks + 1]));
                o[mt] = __builtin_amdgcn_mfma_f32_16x16x32_bf16(xq, vnb[ks], o[mt], 0, 0, 0); } }
        bf16x8 vdb[2] = {packf8(vn[0] * ed[0], vn[1] * ed[1]), packf8(vn[2] * ed[2], vn[3] * ed[3])};
#pragma unroll
        for (int dt = 0; dt < 8; ++dt) { S[dt] = S[dt] * egl;
#pragma unroll
            for (int ks = 0; ks < 2; ++ks) { const bf16x8 xk = join8(ldsrd8(B0 + O_KT + dt * 2048 + off64[2 * ks]), ldsrd8(B0 + O_KT + dt * 2048 + off64[2 * ks + 1]));
                S[dt] = __builtin_amdgcn_mfma_f32_16x16x32_bf16(xk, vdb[ks], S[dt], 0, 0, 0); } }
        { bf16_t* op = O + (size_t)(chunk * 64 + 4 * g) * 4096 + hv * 128 + e0 + r;
#pragma unroll
          for (int mt = 0; mt < 4; ++mt)
#pragma unroll
              for (int i = 0; i < 4; ++i) op[(size_t)(16 * mt + i) * 4096] = (bf16_t)(pk2(o[mt][i], 0.f) & 0xffffu); }
        }
        if (n + 1 < 128 && tid < 48) *(LAS f32x4*)(lds + O_TB + (bf ^ 1) * 768 + tid * 16) = tbreg;
    }
#undef G2_ISSUE
    asm volatile("s_waitcnt vmcnt(0)" ::: "memory");
    __syncthreads();
}

__device__ __forceinline__ void gdn_g3(bf16_t* O, const bf16_t* Z, const float* gn) {
    const int gt = blockIdx.x * NTHR + tidx(), NGT = gridDim.x * NTHR;
    const int dl = (tidx() & 15) * 8; float gv[8];
#pragma unroll
    for (int j = 0; j < 8; ++j) gv[j] = gn[dl + j];
#pragma unroll 4
    for (int idx = gt; idx < T * 512; idx += NGT) {
        float o[8], z[8]; unpack8(*(const u32x4*)(O + (size_t)idx * 8), o); unpack8(*(const u32x4*)(Z + (size_t)idx * 8), z);
        float ss = 0.f;
#pragma unroll
        for (int j = 0; j < 8; ++j) ss += o[j] * o[j];
        const float rn = rsqrtf(sum16(ss) * (1.f / 128.f) + EPS);
#pragma unroll
        for (int j = 0; j < 8; ++j) o[j] = o[j] * rn * gv[j] * siluf_(z[j]);
        *(u32x4*)(O + (size_t)idx * 8) = pack8f(o);
    }
}

#define XB_TMO      128
#define XB_XCNT(j)  (256  + 64 * (j))
#define XB_XSUB(j)  (1280 + 64 * (j))
#define XB_XGEN(j)  (2304 + 64 * (j))
#define XB_TOP      3328
#define XB_TOPGEN   3392
#define XCD_BAR_WORDS 3456
#define XB_SPIN_CAP (1u << 18)

__device__ __forceinline__ unsigned xb_ld(unsigned* p)              { return __hip_atomic_load(p, __ATOMIC_RELAXED, __HIP_MEMORY_SCOPE_AGENT); }
__device__ __forceinline__ unsigned xb_add(unsigned* p, unsigned v) { return __hip_atomic_fetch_add(p, v, __ATOMIC_RELAXED, __HIP_MEMORY_SCOPE_AGENT); }
__device__ __forceinline__ unsigned xb_xcc_id() { return (unsigned)__builtin_amdgcn_s_getreg((3 << 11) | 20) & 0xFu; }
#define XB_SPIN(cond, bar) do { unsigned _sp = 0; while (cond) { __builtin_amdgcn_s_sleep(1); \
    if ((++_sp & 255u) == 0u) { if (xb_ld(&(bar)[XB_TMO])) break; if (_sp > XB_SPIN_CAP) { atomicAdd(&(bar)[XB_TMO], 1u); break; } } } } while (0)

struct XcdBarrier {
    unsigned* bar; unsigned x;
    volatile LAS unsigned* st;
};

__device__ __forceinline__ XcdBarrier xcd_barrier_post(unsigned* bar, volatile LAS unsigned* st) {
    XcdBarrier b; b.bar = bar; b.x = xb_xcc_id(); b.st = st;
    if (threadIdx.x == 0) (void)xb_add(&bar[XB_XCNT(b.x)], 1u);
    return b;
}
__device__ __forceinline__ void xcd_barrier_complete(unsigned* bar, unsigned x, unsigned& nloc, unsigned& nx) {
    const unsigned G = gridDim.x * gridDim.y * gridDim.z;
    unsigned sum, cnt, mine, sp = 0u;
    for (;;) {
        sum = 0u; cnt = 0u; mine = 0u;
#pragma unroll
        for (unsigned j = 0; j < 16; ++j) { const unsigned c = xb_ld(&bar[XB_XCNT(j)]); sum += c; cnt += (c > 0u) ? 1u : 0u; mine = (j == x) ? c : mine; }
        if (sum == G) break;
        __builtin_amdgcn_s_sleep(1);
        if ((++sp & 255u) == 0u) { if (xb_ld(&bar[XB_TMO])) break; if (sp > XB_SPIN_CAP) { atomicAdd(&bar[XB_TMO], 1u); break; } }
    }
    nloc = mine > 0u ? mine : 1u; nx = cnt > 0u ? cnt : 1u;
}

__device__ __forceinline__ void xcd_barrier(const XcdBarrier& b) {
    asm volatile("s_waitcnt vmcnt(0)" ::: "memory");
    __syncthreads();
    if (threadIdx.x == 0) {
        unsigned* bar = b.bar;
        __builtin_amdgcn_s_waitcnt(0);
        unsigned nloc = b.st[0], nx = b.st[1];
        if (nloc == 0u) { xcd_barrier_complete(bar, b.x, nloc, nx); b.st[0] = nloc; b.st[1] = nx; }
        const unsigned old = xb_add(&bar[XB_XSUB(b.x)], 1u);
        const unsigned gen = old / nloc;
        if (old + 1u == (gen + 1u) * nloc) {
            __builtin_amdgcn_fence(__ATOMIC_RELEASE, "agent");
            asm volatile("s_waitcnt vmcnt(0)" ::: "memory");
            const unsigned og = xb_add(&bar[XB_TOP], 1u);
            const unsigned tg = og / nx;
            if (og + 1u == (tg + 1u) * nx) xb_add(&bar[XB_TOPGEN], 1u);
            else XB_SPIN(xb_ld(&bar[XB_TOPGEN]) == tg, bar);
            __builtin_amdgcn_fence(__ATOMIC_ACQUIRE, "agent");
            xb_add(&bar[XB_XGEN(b.x)], 1u);
            asm volatile("s_waitcnt vmcnt(0)" ::: "memory");
        } else {
            XB_SPIN(xb_ld(&bar[XB_XGEN(b.x)]) == gen, bar);
            __builtin_amdgcn_fence(__ATOMIC_ACQUIRE, "agent");
            asm volatile("s_waitcnt vmcnt(0)" ::: "memory");
        }
    }
    __syncthreads();
}

constexpr size_t WS_BAR = 256 * 1024;
struct Args { const float* in[20]; float* out; unsigned char* ws; int ph_lo, ph_hi; };
constexpr int NPHASE = 23;
#ifndef ONLY_PH
#define ONLY_PH -1
#endif
#define EN(k) (ONLY_PH < 0 || ONLY_PH == (k))
#ifndef MK_COOP
#define MK_COOP 1
#endif

__global__ void __launch_bounds__(NTHR) fwd_megakernel(Args a) {
    extern __shared__ __attribute__((aligned(16))) unsigned char lds_raw[];
    LAS unsigned char* lds = (LAS unsigned char*)lds_raw;
    unsigned char* ws = a.ws;
    const float* x = a.in[0]; const float* cvec = a.in[1]; const float* ada_w = a.in[2]; const float* ada_b = a.in[3]; const float* norm_g = a.in[4];
    float* Mods = (float*)(ws + WS_MODS); float* FL = (float*)(ws + WS_FL); float* FB = (float*)(ws + WS_FB); float* AB = (float*)(ws + WS_AB);
    float* Gt = (float*)(ws + WS_GB); float* Btb = Gt + (size_t)T * 32; float* TB = (float*)(ws + WS_TB);
    bf16_t* WA = (bf16_t*)(ws + WS_WA); bf16_t* WB = (bf16_t*)(ws + WS_WB); bf16_t* Hb = (bf16_t*)(ws + WS_H); bf16_t* Yb = (bf16_t*)(ws + WS_Y);
    bf16_t* Pb = (bf16_t*)(ws + WS_P); bf16_t* Qh = (bf16_t*)(ws + WS_QH); bf16_t* Kh = (bf16_t*)(ws + WS_KH); bf16_t* Vh = (bf16_t*)(ws + WS_VH);
    bf16_t* GV = (bf16_t*)(ws + WS_GV); bf16_t* QKV = (bf16_t*)(ws + WS_QKV); bf16_t* qn = (bf16_t*)(ws + WS_QN); bf16_t* kn = (bf16_t*)(ws + WS_KN);
    bf16_t* kT = (bf16_t*)(ws + WS_KT); bf16_t* vT = (bf16_t*)(ws + WS_VT); bf16_t* Tm = (bf16_t*)(ws + WS_TM); bf16_t* QKm = (bf16_t*)(ws + WS_QKM);
    bf16_t* Ob = (bf16_t*)(ws + WS_O); bf16_t* Zb = (bf16_t*)(ws + WS_Z);
#define mods(layer, sub) (Mods + (size_t)((layer) * 2 + (sub)) * 2 * 3 * DM)
#define ng(layer, k) (norm_g + (size_t)((layer) * 4 + (k)) * DM)
    const int lo = a.ph_lo, hi = a.ph_hi;
    volatile LAS unsigned* xst = (volatile LAS unsigned*)(lds + LDS_TOTAL - 64);
    if (tidx() < 2) xst[tidx()] = 0u;
    __syncthreads();
    XcdBarrier xbar = xcd_barrier_post((unsigned*)(ws + WS_BAR), xst);
    if (__builtin_amdgcn_readfirstlane(tidx() >> 6) == 0) { __threadfence(); asm volatile("s_waitcnt vmcnt(0)" ::: "memory"); } __syncthreads();
#define IN(k) (lo <= (k) && (k) < hi && EN(k))
#define SEAM(k) do { if (lo <= (k) && (k) + 1 < hi) { if ((k) == 0) { asm volatile("s_waitcnt vmcnt(0) lgkmcnt(0)" ::: "memory"); __syncthreads(); cg::this_grid().sync(); if (__builtin_amdgcn_readfirstlane(tidx() >> 6) == 0) { __builtin_amdgcn_fence(__ATOMIC_ACQUIRE, "agent"); asm volatile("s_waitcnt vmcnt(0)" ::: "memory"); } __syncthreads(); } else { xcd_barrier(xbar); } } } while (0)
#define CONV(W_, K_, N_, T_, s1, a1, s2, a2) do { __syncthreads(); convert_weight(lds, W_, K_, N_, T_, s1, a1, s2, a2); } while (0)
#define ROWP(xin_, first_, last_, gl, gs, gk, hl, hs, hk) row_phase(xin_, (first_) ? nullptr : a.out, (first_) ? nullptr : Yb, mods(gl, gs) + 2 * DM, ng(gl, gk), (last_) ? nullptr : Hb, ng(hl, hk), mods(hl, hs), mods(hl, hs) + DM)
    if (IN(0)) { mods_phase(lds, cvec, ada_w, ada_b, Mods); CONV(a.in[5], DM, FOX_N, WA, NOSEG, 0, NOSEG, 0); } SEAM(0);
    if (IN(1)) { ROWP(x, true, false, 0, 0, 0, 0, 0, 0); CONV(a.in[9], DM, DM, WB, NOSEG, 0, NOSEG, 0); } SEAM(1);
    if (IN(2)) { run_gemm(lds, Hb, DM, WA, FOX_LD, DM, Pb, FOX_LD, FOX_N, FL, 24, 16); } SEAM(2);
    if (IN(3)) { fox_prep(Pb, FL, a.in[6], a.in[7], a.in[8], Qh, Kh, Vh, FB); CONV(a.in[16], DM, 2 * DFF, WA, NOSEG, 0, NOSEG, 0); } SEAM(3);
    if (IN(4)) { fox_attention((char*)lds_raw, Qh, Kh, Vh, Pb, FB, Hb, a.in[7], a.in[8]); } SEAM(4);
    if (IN(5)) { run_gemm(lds, Hb, DM, WB, DM, DM, Yb, DM, DM, nullptr, -1, 0); } SEAM(5);
    if (IN(6)) { ROWP(x, false, false, 0, 0, 1, 0, 1, 2); CONV(a.in[19], DFF, DM, WB, NOSEG, 0, NOSEG, 0); } SEAM(6);
    if (IN(7)) { run_gemm(lds, Hb, DM, WA, 2 * DFF, DM, GV, 2 * DFF, 2 * DFF, nullptr, -1, 0); } SEAM(7);
    if (IN(8)) { glu_phase(GV, a.in[17], a.in[18]); CONV(a.in[10], DM, 12352, WA, 8192, 256, 12288, -4096); } SEAM(8);
    if (IN(9)) { run_gemm(lds, GV + DFF, 2 * DFF, WB, DM, DFF, Yb, DM, DM, nullptr, -1, 0); } SEAM(9);
    if (IN(10)) { ROWP(a.out, false, false, 0, 1, 3, 1, 0, 0); CONV(a.in[15], 2 * DM, DM, WB, NOSEG, 0, NOSEG, 0); } SEAM(10);
    if (IN(11)) { run_gemm(lds, Hb, DM, WA, 8448, DM, QKV, 8192, 8192, AB, 32, 64); } SEAM(11);
    if (IN(12)) { gdn_prep(QKV, AB, a.in[11], a.in[12], a.in[13], qn, kn, kT, vT, Gt, Btb); } SEAM(12);
    if (IN(13)) { gdn_g1(lds, qn, kn, Gt, Btb, Tm, QKm, TB); } SEAM(13);
    if (IN(14)) { gdn_g2(lds, qn, kn, kT, vT, Tm, QKm, TB, Ob); } SEAM(14);
    if (IN(15)) { run_gemm(lds, Hb, DM, WA + (size_t)8448 * DM, 2 * DM, DM, Zb, 2 * DM, 2 * DM, nullptr, -1, 0); } SEAM(15);
    if (IN(16)) { gdn_g3(Ob, Zb, a.in[14]); CONV(a.in[16] + (size_t)DM * 2 * DFF, DM, 2 * DFF, WA, NOSEG, 0, NOSEG, 0); } SEAM(16);
    if (IN(17)) { run_gemm(lds, Ob, 2 * DM, WB, DM, 2 * DM, Yb, DM, DM, nullptr, -1, 0); } SEAM(17);
    if (IN(18)) { ROWP(a.out, false, false, 1, 0, 1, 1, 1, 2); CONV(a.in[19] + (size_t)DFF * DM, DFF, DM, WB, NOSEG, 0, NOSEG, 0); } SEAM(18);
    if (IN(19)) { run_gemm(lds, Hb, DM, WA, 2 * DFF, DM, GV, 2 * DFF, 2 * DFF, nullptr, -1, 0); } SEAM(19);
    if (IN(20)) { glu_phase(GV, a.in[17] + 3 * DFF, a.in[18] + DFF); } SEAM(20);
    if (IN(21)) { run_gemm(lds, GV + DFF, 2 * DFF, WB, DM, DFF, Yb, DM, DM, nullptr, -1, 0); } SEAM(21);
    if (IN(22)) { ROWP(a.out, false, true, 1, 1, 3, 0, 0, 0); }
    asm volatile("s_waitcnt vmcnt(0) lgkmcnt(0)" ::: "memory"); __syncthreads(); if (__builtin_amdgcn_readfirstlane(tidx() >> 6) == 0) { __threadfence(); asm volatile("s_waitcnt vmcnt(0)" ::: "memory"); }
#ifdef EXP_ROWS
    __syncthreads(); if (blockIdx.x == 0) { for (int i = tidx(); i < DM; i += NTHR) { a.out[i] = x[i]; a.out[(size_t)SEQ * DM + i] = x[(size_t)SEQ * DM + i]; } }
#endif
}

extern "C" void kernel_launch(void* const* d_in, const int* in_sizes, int n_in, void* d_out, int out_size, void* d_ws, size_t ws_size, hipStream_t stream) {
    static int grid = 0;
    if (grid == 0) {
        if (n_in != 20 || ws_size < WS_END) { fprintf(stderr, "kernel_launch: need 20 inputs and >= %zu B workspace (got %d, %zu)\n", (size_t)WS_END, n_in, ws_size); grid = -1; return; }
        int dev = 0, cus = 0, per_cu = 0;
        (void)hipGetDevice(&dev); (void)hipDeviceGetAttribute(&cus, hipDeviceAttributeMultiprocessorCount, dev);
        if (hipFuncSetAttribute((const void*)fwd_megakernel, hipFuncAttributeMaxDynamicSharedMemorySize, LDS_TOTAL) != hipSuccess) fprintf(stderr, "kernel_launch: hipFuncSetAttribute failed\n");
        if (hipOccupancyMaxActiveBlocksPerMultiprocessor(&per_cu, (const void*)fwd_megakernel, NTHR, LDS_TOTAL) != hipSuccess || per_cu < 1) { fprintf(stderr, "kernel_launch: occupancy query gave %d\n", per_cu); per_cu = 1; }
        (void)hipGetLastError();
        grid = cus > 0 ? cus : 256;
    }
    if (grid < 0) return;
    Args a{};
    for (int i = 0; i < 20; ++i) a.in[i] = (const float*)d_in[i];
    a.out = (float*)d_out; a.ws = (unsigned char*)d_ws;
    (void)hipMemsetAsync((char*)d_ws + WS_BAR, 0, 16384, stream);
#if MK_COOP
    a.ph_lo = 0; a.ph_hi = NPHASE;
    void* args[] = {&a};
    hipError_t e = hipLaunchCooperativeKernel((const void*)fwd_megakernel, dim3(grid), dim3(NTHR), args, LDS_TOTAL, stream);
    if (e != hipSuccess) fprintf(stderr, "cooperative launch failed: %s (grid %d)\n", hipGetErrorString(e), grid);
#else
    for (int ph = 0; ph < NPHASE; ++ph) { a.ph_lo = ph; a.ph_hi = ph + 1; hipLaunchKernelGGL(fwd_megakernel, dim3(grid), dim3(NTHR), LDS_TOTAL, stream, a); }
#endif
}
```

```cpp
#include <hip/hip_runtime.h>
#include <hip/hip_cooperative_groups.h>
#include <hip/hip_bf16.h>
#include <cstdio>
#include <cstdint>
#include <cmath>
namespace cg = cooperative_groups;
__device__ __forceinline__ int tidx() { int t = (int)__builtin_amdgcn_workitem_id_x(); asm volatile("" : "+v"(t)); return t; }
namespace pg8 {
#define PG8_LAS __attribute__((address_space(3)))
typedef unsigned short bf16_t;
typedef short bf16x8 __attribute__((ext_vector_type(8)));
typedef float f32x4 __attribute__((ext_vector_type(4)));
typedef unsigned u32x4 __attribute__((ext_vector_type(4)));
constexpr int BM = 256, BK = 64, HALF = 128, HTB = HALF * BK * 2  , STAGE_BYTES = 8 * HTB, NXCD = 8, WGM = 8;

__host__ __device__ __forceinline__ int lds_byte(int r, int c) { const int st = (r >> 4) * 2 + (c >> 5), rr = r & 15, cc = c & 31, ob = rr * 64 + cc * 2; return st * 1024 + (ob ^ (((ob >> 9) & 1) << 5)); }
__host__ __device__ __forceinline__ void stage_rc(int b, int& R, int& C) { const int st = b / 1024, sb = b % 1024, swz = sb ^ (((sb >> 9) & 1) << 5); R = (st >> 1) * 16 + swz / 64; C = (st & 1) * 32 + (swz % 64) / 2; }
__host__ __device__ __forceinline__ int perm32(int rho) { const int n = rho >> 4, i = rho & 15; return 8 * (i >> 2) + 4 * n + (i & 3); }

struct Unit { int pm, pn; };
struct Gemm { const bf16_t* A; const bf16_t* Bt; int M, N, K, lda; };

struct StaticOrder {
    int nM, nN, nwg, G, c;
    __host__ __device__ void init(int M, int N, int G_, int c_) { nM = M / BM; nN = N / BM; nwg = nM * nN; G = G_; c = c_; }
    __host__ __device__ bool next(int i, Unit& u) const {
        const long L = (long)i * G + c; if (L >= nwg) return false;
        int wgid = (int)L; { const int q = nwg / NXCD, r = nwg % NXCD, xcd = wgid % NXCD, off = wgid / NXCD; wgid = (xcd < r ? xcd * (q + 1) : r * (q + 1) + (xcd - r) * q) + off; }
        const int nig = WGM * nN, gid = wgid / nig, fm = gid * WGM, gsz = (nM - fm) < WGM ? (nM - fm) : WGM;
        u.pm = fm + ((wgid % nig) % gsz); u.pn = (wgid % nig) / gsz; return true;
    }
    __device__ __forceinline__ void a_ready(const Unit&) const {}
    __device__ __forceinline__ void done(const Unit&) const {}
};

__device__ __forceinline__ unsigned cvt_pk_bf16(float lo, float hi) { unsigned r; asm volatile("v_cvt_pk_bf16_f32 %0, %1, %2" : "=v"(r) : "v"(lo), "v"(hi)); return r; }
template <class Epi, class Sched, bool ALIGN_EPI = false, bool SP2 = false>
__device__ __forceinline__ void gemm_phase(PG8_LAS unsigned char* lds, const Gemm g, const Sched& S, const Epi& E) {
    const int tid = tidx(), wid = __builtin_amdgcn_readfirstlane(tid >> 6), lane = tid & 63, wr = wid >> 2, wc = wid & 3, fr = lane & 15, fq = lane >> 4;
    const int K = g.K, nt = K / BK;
    unsigned voffA[2], voffB[2];
#pragma unroll
    for (int i = 0; i < 2; ++i) { int R, C; stage_rc(tid * 16 + i * 8192, R, C); const int Rb = Epi::PERM ? ((R & ~31) + perm32(R & 31)) : R;
        voffA[i] = (unsigned)(R * g.lda + C) * 2u; voffB[i] = (unsigned)(Rb * K + C) * 2u; }
    const size_t kstep = (size_t)(BK * 2);
    const size_t hstep = (size_t)HALF * K * 2;
    const size_t tstep = 2 * hstep; const size_t hstepA = (size_t)HALF * g.lda * 2, tstepA = 2 * hstepA;
    const unsigned ldsw = (unsigned)wid * 1024u;
    const int aoff = lds_byte(wr * 64 + fr, fq * 8), boff = lds_byte(wc * 32 + fr, fq * 8);
#define PG8_SA(b, h) (((b) * 2 + (h)) * HTB)
#define PG8_SB(b, h) ((4 + (b) * 2 + (h)) * HTB)
#define PG8_STAGE(bufoff, gbase, voff) do { _Pragma("unroll") for (int _i = 0; _i < 2; ++_i) \
        __builtin_amdgcn_global_load_lds((const unsigned*)((const char*)(gbase) + (voff)[_i]), (PG8_LAS unsigned*)(lds + (bufoff) + ldsw + _i * 8192), 16, 0, 0); } while (0)
#define PG8_LDA(dst, b, h) do { _Pragma("unroll") for (int m = 0; m < 4; ++m) _Pragma("unroll") for (int k = 0; k < 2; ++k) dst[m][k] = *(const PG8_LAS bf16x8*)(lds + PG8_SA(b, h) + aoff + m * 2048 + k * 1024); } while (0)
#define PG8_LDB(dst, b, h) do { _Pragma("unroll") for (int n = 0; n < 2; ++n) _Pragma("unroll") for (int k = 0; k < 2; ++k) dst[n][k] = *(const PG8_LAS bf16x8*)(lds + PG8_SB(b, h) + boff + n * 2048 + k * 1024); } while (0)
#define PG8_MMA(ai, bj, At, Bt) do { __builtin_amdgcn_s_setprio(1); _Pragma("unroll") for (int m = 0; m < 4; ++m) _Pragma("unroll") for (int n = 0; n < 2; ++n) _Pragma("unroll") for (int k = 0; k < 2; ++k) \
        acc[ai][bj][m][n] = __builtin_amdgcn_mfma_f32_16x16x32_bf16(Bt[n][k], At[m][k], acc[ai][bj][m][n], 0, 0, 0); __builtin_amdgcn_s_setprio(0); } while (0)
#define PG8_WAIT_V(n) asm volatile("s_waitcnt vmcnt(" #n ")" ::: "memory")
#define PG8_WAIT_L(n) asm volatile("s_waitcnt lgkmcnt(" #n ")" ::: "memory")
#define PG8_BAR __builtin_amdgcn_s_barrier()
#define PG8_SCHED __builtin_amdgcn_sched_barrier(0)
    Unit cur, nxt; int ui = 0;
    if (!S.next(0, cur)) return;
    f32x4 acc[2][2][4][2];
#pragma unroll
    for (int a = 0; a < 2; ++a)
#pragma unroll
        for (int b = 0; b < 2; ++b)
#pragma unroll
            for (int m = 0; m < 4; ++m)
#pragma unroll
                for (int n = 0; n < 2; ++n) acc[a][b][m][n] = (f32x4){0.f, 0.f, 0.f, 0.f};
    bf16x8 At[4][2], B0[2][2], B1[2][2];
    const char* cA = (const char*)g.A + (size_t)cur.pm * tstepA; const char* cB = (const char*)g.Bt + (size_t)cur.pn * tstep;
    S.a_ready(cur);
    if constexpr (SP2) {
        PG8_STAGE(PG8_SB(0, 0), cB, voffB); PG8_STAGE(PG8_SB(0, 1), cB + hstep, voffB); PG8_STAGE(PG8_SA(0, 0), cA, voffA); PG8_STAGE(PG8_SA(0, 1), cA + hstepA, voffA);
        if (wr == 1) PG8_BAR;
        PG8_WAIT_V(2); PG8_BAR;
        PG8_STAGE(PG8_SB(1, 0), cB + kstep, voffB); PG8_STAGE(PG8_SA(1, 0), cA + kstep, voffA); PG8_STAGE(PG8_SB(1, 1), cB + hstep + kstep, voffB);
        PG8_WAIT_V(6); PG8_BAR;
    } else {
        PG8_STAGE(PG8_SB(0, 0), cB, voffB); PG8_STAGE(PG8_SA(0, 0), cA, voffA); PG8_STAGE(PG8_SB(0, 1), cB + hstep, voffB); PG8_STAGE(PG8_SA(0, 1), cA + hstepA, voffA);
        if (wr == 1) PG8_BAR;
        PG8_WAIT_V(4); PG8_BAR;
        PG8_STAGE(PG8_SB(1, 0), cB + kstep, voffB); PG8_STAGE(PG8_SA(1, 0), cA + kstep, voffA); PG8_STAGE(PG8_SB(1, 1), cB + hstep + kstep, voffB);
        PG8_WAIT_V(6); PG8_BAR;
    }
    for (;;) {
        const bool has_next = S.next(ui + 1, nxt);
        const char* nA = has_next ? (const char*)g.A + (size_t)nxt.pm * tstepA : cA; const char* nB = has_next ? (const char*)g.Bt + (size_t)nxt.pn * tstep : cB;
        for (int t = 0; t < nt; t += 2) {
            const bool last = (t == nt - 2);
            const char* a1 = cA + (size_t)(t + 1) * kstep;
            const char* a2 = last ? nA : cA + (size_t)(t + 2) * kstep; const char* b2 = last ? nB : cB + (size_t)(t + 2) * kstep;
            const char* a3 = a2 + kstep; const char* b3 = b2 + kstep;
            if (last && has_next) S.a_ready(nxt);
            if constexpr (SP2) {
            PG8_LDB(B0, 0, 0); PG8_LDB(B1, 0, 1); PG8_SCHED; PG8_LDA(At, 0, 0); PG8_STAGE(PG8_SA(1, 1), a1 + hstepA, voffA);
            PG8_WAIT_V(8); PG8_WAIT_L(0); PG8_BAR; PG8_MMA(0, 0, At, B0); PG8_MMA(0, 1, At, B1); PG8_BAR; PG8_SCHED;
            PG8_LDA(At, 0, 1); PG8_STAGE(PG8_SB(0, 0), b2, voffB); PG8_STAGE(PG8_SB(0, 1), b2 + hstep, voffB); PG8_STAGE(PG8_SA(0, 0), a2, voffA);
            PG8_WAIT_V(8); PG8_WAIT_L(0); PG8_BAR; PG8_MMA(1, 0, At, B0); PG8_MMA(1, 1, At, B1); PG8_BAR; PG8_SCHED;
            PG8_LDB(B0, 1, 0); PG8_LDB(B1, 1, 1); PG8_SCHED; PG8_LDA(At, 1, 0); PG8_STAGE(PG8_SA(0, 1), a2 + hstepA, voffA);
            PG8_WAIT_V(8); PG8_WAIT_L(0); PG8_BAR; PG8_MMA(0, 0, At, B0); PG8_MMA(0, 1, At, B1); PG8_BAR; PG8_SCHED;
            PG8_LDA(At, 1, 1); PG8_STAGE(PG8_SB(1, 0), b3, voffB); PG8_STAGE(PG8_SB(1, 1), b3 + hstep, voffB); PG8_STAGE(PG8_SA(1, 0), a3, voffA);
            PG8_WAIT_V(8); PG8_WAIT_L(0); PG8_BAR; PG8_MMA(1, 0, At, B0); PG8_MMA(1, 1, At, B1); PG8_BAR; PG8_SCHED;
            } else {
            PG8_LDB(B0, 0, 0); PG8_SCHED; PG8_LDA(At, 0, 0); PG8_STAGE(PG8_SA(1, 1), a1 + hstepA, voffA);
            PG8_WAIT_L(8); PG8_BAR; PG8_WAIT_L(0); PG8_MMA(0, 0, At, B0); PG8_BAR; PG8_SCHED;
            PG8_LDB(B1, 0, 1); PG8_STAGE(PG8_SB(0, 0), b2, voffB);
            PG8_BAR; PG8_WAIT_L(0); PG8_MMA(0, 1, At, B1); PG8_BAR;
            PG8_LDA(At, 0, 1); PG8_STAGE(PG8_SA(0, 0), a2, voffA);
            PG8_BAR; PG8_WAIT_L(0); PG8_MMA(1, 0, At, B0); PG8_BAR; PG8_SCHED;
            PG8_STAGE(PG8_SB(0, 1), b2 + hstep, voffB);
            PG8_WAIT_V(6); PG8_BAR; PG8_MMA(1, 1, At, B1); PG8_BAR;
            PG8_LDB(B0, 1, 0); PG8_SCHED; PG8_LDA(At, 1, 0); PG8_STAGE(PG8_SA(0, 1), a2 + hstepA, voffA);
            PG8_WAIT_L(8); PG8_BAR; PG8_WAIT_L(0); PG8_MMA(0, 0, At, B0); PG8_BAR; PG8_SCHED;
            PG8_LDB(B1, 1, 1); PG8_STAGE(PG8_SB(1, 0), b3, voffB);
            PG8_BAR; PG8_WAIT_L(0); PG8_MMA(0, 1, At, B1); PG8_BAR;
            PG8_LDA(At, 1, 1); PG8_STAGE(PG8_SA(1, 0), a3, voffA);
            PG8_BAR; PG8_WAIT_L(0); PG8_MMA(1, 0, At, B0); PG8_BAR; PG8_SCHED;
            PG8_STAGE(PG8_SB(1, 1), b3 + hstep, voffB);
            PG8_WAIT_V(6); PG8_BAR; PG8_MMA(1, 1, At, B1); PG8_BAR;
            }
        }
        if constexpr (ALIGN_EPI) { if (wr == 0) PG8_BAR; }
        if constexpr (!Epi::AFTER_DRAIN) { E(acc, cur, wr, wc, fr, fq); S.done(cur); }
        if (!has_next) break;
#pragma unroll
        for (int a = 0; a < 2; ++a)
#pragma unroll
            for (int b = 0; b < 2; ++b)
#pragma unroll
                for (int m = 0; m < 4; ++m)
#pragma unroll
                    for (int n = 0; n < 2; ++n) acc[a][b][m][n] = (f32x4){0.f, 0.f, 0.f, 0.f};
        cur = nxt; cA = nA; cB = nB; ++ui;
        if constexpr (ALIGN_EPI) { if (wr == 1) PG8_BAR; }
    }
    PG8_WAIT_V(0);
    if constexpr (!ALIGN_EPI) { if (wr == 0) PG8_BAR; }
    PG8_BAR;
    if constexpr (Epi::AFTER_DRAIN) { E.fused(acc, cur, wr, wc, fr, fq, lds, wid, lane); S.done(cur); }
#undef PG8_SA
#undef PG8_SB
#undef PG8_STAGE
#undef PG8_LDA
#undef PG8_LDB
#undef PG8_MMA
#undef PG8_WAIT_V
#undef PG8_WAIT_L
#undef PG8_BAR
#undef PG8_SCHED
}
}
namespace att {
enum { ORDER_NATURAL = 0, ORDER_REVERSED = 1, ORDER_PAIRED = 2, ORDER_XCD = 4 };
constexpr int B = 2, H = 16, HKV = 16, SQ = 8192, SKV = 8192, D = 128;
constexpr int QOFF = 0;
constexpr int WINDOW = SKV;
constexpr float THR = 8.f;
constexpr bool WSKIP = false;

constexpr float SCALE = 0.08838834764831845f;
constexpr int NW = 8, QBLK = 32, KVBLK = 64, QB = NW * QBLK;
constexpr int SHM_V = KVBLK * D * 2, SHM_K = KVBLK * D * 2;
constexpr int LDS_BYTES = 2 * SHM_V + 2 * SHM_K + NW * 64 * 4;
constexpr int FB_OFF = LDS_BYTES, OSTR = 2048, GSTR = 8448;

using bf16 = __hip_bfloat16;
#define ALAS __attribute__((address_space(3)))
typedef short bf16x8 __attribute__((ext_vector_type(8)));
typedef short s16x4 __attribute__((ext_vector_type(4)));
typedef float f32x16 __attribute__((ext_vector_type(16)));
typedef float f32x4 __attribute__((ext_vector_type(4)));
typedef unsigned u32x4 __attribute__((ext_vector_type(4)));
template <class A, class Bt> struct same_t { static constexpr bool v = false; };
template <class A> struct same_t<A, A> { static constexpr bool v = true; };

#define KSWZ(row, colB) ((row) * 256 + ((colB) ^ (((row) & 7) << 4)))
#define SBAR() __builtin_amdgcn_sched_barrier(0)
__device__ __forceinline__ int v_st(int k, int c) { const int kk = (k & ~0xC) | ((k & 4) << 1) | ((k & 8) >> 1); return ((kk >> 3) * 4 + (c >> 5)) * 512 + ((kk & 7) * 32 + (c & 31)) * 2; }
__device__ __forceinline__ int v_rd_base(int lane) { return ((lane & 3) << 3) | (((lane >> 2) & 3) << 6) | (((lane >> 4) & 1) << 5) | (((lane >> 5) & 1) << 8); }
constexpr int v_rd_off(int d0, int ks, int half) { return d0 * 512 + ks * 4096 + half * 2048; }
__device__ __forceinline__ int crow(int r, int hi) { return (r & 3) + 8 * (r >> 2) + 4 * hi; }
__device__ __forceinline__ unsigned cvtpk(float lo, float hi) {
    unsigned r; asm volatile("v_cvt_pk_bf16_f32 %0, %1, %2" : "=v"(r) : "v"(lo), "v"(hi)); return r;
}
__device__ __forceinline__ bf16x8 pack8(f32x4 a, f32x4 b) {
    u32x4 w = {cvtpk(a[0], a[1]), cvtpk(a[2], a[3]), cvtpk(b[0], b[1]), cvtpk(b[2], b[3])};
    return *reinterpret_cast<bf16x8*>(&w);
}
template <class T> __device__ __forceinline__ bf16x8 load8(const T* p) {
    if constexpr (same_t<T, float>::v) { return pack8(*(const f32x4*)p, *(const f32x4*)(p + 4)); }
    else { return *reinterpret_cast<const bf16x8*>(p); }
}
__device__ __forceinline__ void mask_tile(f32x16& p0, f32x16& p1, int dq, unsigned W) {
    const float NEG = -__builtin_inff();
#pragma unroll
    for (int r = 0; r < 16; ++r) {
        const int c = (r & 3) + 8 * (r >> 2);
        if ((unsigned)(dq - c) >= W) p0[r] = NEG;
        if ((unsigned)(dq - c - 32) >= W) p1[r] = NEG;
    }
}
__device__ __forceinline__ void partialSM(f32x16& p0, f32x16& p1, float& m_reg, float& mn, float& alpha) {
    float pmax = p0[0]; for (int r = 1; r < 16; ++r) pmax = fmaxf(pmax, p0[r]); for (int r = 0; r < 16; ++r) pmax = fmaxf(pmax, p1[r]);
    { auto rr = __builtin_amdgcn_permlane32_swap(__float_as_uint(pmax), __float_as_uint(pmax), false, false);
      pmax = fmaxf(__uint_as_float(rr[0]), __uint_as_float(rr[1])); }
    constexpr float C2 = 1.4426950408889634f * SCALE;
    if (__builtin_expect(__all((pmax - m_reg) * SCALE <= THR), 1)) { mn = m_reg; alpha = 1.f; }
    else { mn = fmaxf(m_reg, pmax); alpha = __builtin_amdgcn_exp2f((m_reg - mn) * C2); m_reg = mn; }
    const float mnL = -mn * C2;
    for (int r = 0; r < 16; ++r) p0[r] = fmaf(p0[r], C2, mnL); for (int r = 0; r < 16; ++r) p1[r] = fmaf(p1[r], C2, mnL);
    for (int r = 0; r < 16; ++r) p0[r] = __builtin_amdgcn_exp2f(p0[r]);
}
__device__ __forceinline__ void finishSM(f32x16& p0, f32x16& p1, float alpha, float& l_reg, bf16x8& pa0, bf16x8& pa1, bf16x8& pa2, bf16x8& pa3) {
    for (int r = 0; r < 16; ++r) p1[r] = __builtin_amdgcn_exp2f(p1[r]);
    float ps = 0; for (int r = 0; r < 16; ++r) ps += p0[r]; for (int r = 0; r < 16; ++r) ps += p1[r];
    { auto rr = __builtin_amdgcn_permlane32_swap(__float_as_uint(ps), __float_as_uint(ps), false, false);
      ps = __uint_as_float(rr[0]) + __uint_as_float(rr[1]); }
    l_reg = l_reg * alpha + ps;
#define PK4(P, B_, OUT) do { unsigned a0 = cvtpk(P[B_+0], P[B_+1]), a1 = cvtpk(P[B_+2], P[B_+3]);                          \
        unsigned b0 = cvtpk(P[B_+4], P[B_+5]), b1 = cvtpk(P[B_+6], P[B_+7]);                                             \
        auto r0 = __builtin_amdgcn_permlane32_swap(a0, b0, false, false); auto r1 = __builtin_amdgcn_permlane32_swap(a1, b1, false, false); \
        u32x4 w = {r0[0], r1[0], r0[1], r1[1]}; OUT = *reinterpret_cast<bf16x8*>(&w); } while (0)
    PK4(p0, 0, pa0); PK4(p0, 8, pa1); PK4(p1, 0, pa2); PK4(p1, 8, pa3);
#undef PK4
}
template <int KB, bool SK>
__device__ __forceinline__ void qkt(f32x16& p0, f32x16& p1, const char* K_lds, int r32, int hi, const bf16x8* qr, bool act, const ALAS float* fbp) {
    if (SK && !act) { const float NEG = -__builtin_inff();
#pragma unroll
        for (int r = 0; r < 16; ++r) { p0[r] = NEG; p1[r] = NEG; } return; }
#pragma unroll
    for (int a = 0; a < 4; ++a) { const f32x4 t0 = *(const ALAS f32x4*)(fbp + 8 * a), t1 = *(const ALAS f32x4*)(fbp + 32 + 8 * a);
        p0[4 * a] = t0[0]; p0[4 * a + 1] = t0[1]; p0[4 * a + 2] = t0[2]; p0[4 * a + 3] = t0[3];
        p1[4 * a] = t1[0]; p1[4 * a + 1] = t1[1]; p1[4 * a + 2] = t1[2]; p1[4 * a + 3] = t1[3]; }
    const char* kb[4];
#pragma unroll
    for (int dd = 0; dd < 4; ++dd) kb[dd] = K_lds + KB * SHM_K + KSWZ(r32, (dd * 16 + hi * 8) * 2);
#pragma unroll
    for (int d0 = 0; d0 < 8; ++d0) { const char* a = kb[d0 & 3] + (d0 >> 2) * 128;
        bf16x8 b0 = *reinterpret_cast<const bf16x8*>(a);
        bf16x8 b1 = *reinterpret_cast<const bf16x8*>(a + 32 * 256);
        p0 = __builtin_amdgcn_mfma_f32_32x32x16_bf16(b0, qr[d0], p0, 0, 0, 0);
        p1 = __builtin_amdgcn_mfma_f32_32x32x16_bf16(b1, qr[d0], p1, 0, 0, 0); }
}
template <int VB, bool SK>
__device__ __forceinline__ void pv_tile(f32x16* o, int vb0, bf16x8 pa0, bf16x8 pa1, bf16x8 pa2, bf16x8 pa3, bool act) {
    if (SK && !act) return;
#define TRRD(dst, off) asm volatile("ds_read_b64_tr_b16 %0, %1 offset:%2" : "=&v"(dst) : "v"(vb0), "i"(off) : "memory")
#define PV_D0(d0) do { s16x4 l0, l1, l2, l3, h0, h1, h2, h3; constexpr int b_ = VB * SHM_V + v_rd_off(d0, 0, 0);     \
        TRRD(l0, b_); TRRD(h0, b_ + 2048); TRRD(l1, b_ + 4096); TRRD(h1, b_ + 6144); TRRD(l2, b_ + 8192); TRRD(h2, b_ + 10240); TRRD(l3, b_ + 12288); TRRD(h3, b_ + 14336); \
        asm volatile("s_waitcnt lgkmcnt(0)" ::: "memory"); SBAR();                 \
        o[d0] = __builtin_amdgcn_mfma_f32_32x32x16_bf16(pa0, (bf16x8){l0[0], l0[1], l0[2], l0[3], h0[0], h0[1], h0[2], h0[3]}, o[d0], 0, 0, 0);   \
        o[d0] = __builtin_amdgcn_mfma_f32_32x32x16_bf16(pa1, (bf16x8){l1[0], l1[1], l1[2], l1[3], h1[0], h1[1], h1[2], h1[3]}, o[d0], 0, 0, 0);   \
        o[d0] = __builtin_amdgcn_mfma_f32_32x32x16_bf16(pa2, (bf16x8){l2[0], l2[1], l2[2], l2[3], h2[0], h2[1], h2[2], h2[3]}, o[d0], 0, 0, 0);   \
        o[d0] = __builtin_amdgcn_mfma_f32_32x32x16_bf16(pa3, (bf16x8){l3[0], l3[1], l3[2], l3[3], h3[0], h3[1], h3[2], h3[3]}, o[d0], 0, 0, 0); } while (0)
    PV_D0(0); PV_D0(1); PV_D0(2); PV_D0(3);
#undef PV_D0
#undef TRRD
}

template <class TIn, class TOut> struct BlockRef { const TIn* Q; const TIn* K; const TIn* V; TOut* O; const TIn* G; int P0; int JLO; };
template <class TIn> struct Seam {
    bf16x8 qr[8];
    bf16x8 st_v0, st_v1, st_k0, st_k1; f32x4 sf0, sf1, sf2, sf3;
    f32x4 tq[16];
};
__device__ __forceinline__ int swa_jlo(int P0, int W) { const int lowk = P0 - W + 1; return lowk > 0 ? lowk / KVBLK : 0; }
#define ROW(p, k0, rr) ((p) + (size_t)((k0) + (rr)) * D + sc)
#define ROWV(p, k0, rr) ((p) + (size_t)((k0) + (rr)) * GSTR + sc)
#define VMW() asm volatile("s_waitcnt vmcnt(0)" ::: "memory")
#define VMWN(n) asm volatile("s_waitcnt vmcnt(%0)" :: "i"(n) : "memory")
#define SLOAD_H(Kp, Vp, k0) do { S.st_v0 = load8<TIn>(ROWV(Vp, k0, sr)); S.st_v1 = load8<TIn>(ROWV(Vp, k0, 32 + sr));              \
                         S.st_k0 = load8<TIn>(ROW(Kp, k0, sr)); S.st_k1 = load8<TIn>(ROW(Kp, k0, 32 + sr)); } while (0)
#define SWRITE_HK(bf) do { *(bf16x8*)(K_lds + (bf) * SHM_K + kws) = S.st_k0; *(bf16x8*)(K_lds + (bf) * SHM_K + kws + 32 * 256) = S.st_k1; } while (0)
#define SWRITE_HV(bf) do { *(bf16x8*)(V_lds + (bf) * SHM_V + vst0) = S.st_v0; *(bf16x8*)(V_lds + (bf) * SHM_V + vst1) = S.st_v1; } while (0)
#define SWRITE_H(bf) do { SWRITE_HV(bf); SWRITE_HK(bf); } while (0)
#define SLOAD_F(p, k0) do { S.sf0 = *(const f32x4*)ROW(p, k0, sr); S.sf1 = *(const f32x4*)(ROW(p, k0, sr) + 4);                \
                            S.sf2 = *(const f32x4*)ROW(p, k0, 32 + sr); S.sf3 = *(const f32x4*)(ROW(p, k0, 32 + sr) + 4); } while (0)
#define SWRITE_KF(bf) do { *(bf16x8*)(K_lds + (bf) * SHM_K + kws) = pack8(S.sf0, S.sf1); *(bf16x8*)(K_lds + (bf) * SHM_K + kws + 32 * 256) = pack8(S.sf2, S.sf3); } while (0)
#define SWRITE_VF(bf) do { *(bf16x8*)(V_lds + (bf) * SHM_V + vst0) = pack8(S.sf0, S.sf1); *(bf16x8*)(V_lds + (bf) * SHM_V + vst1) = pack8(S.sf2, S.sf3); } while (0)
template <class TIn, class TOut>
__device__ __forceinline__ void causal_swa_prime(const BlockRef<TIn, TOut>& cur, int W, char* lds, Seam<TIn>& S) {
    constexpr bool F32 = same_t<TIn, float>::v;
    const int tid = tidx(), wid = __builtin_amdgcn_readfirstlane(tid >> 6), lane = tid & 63, r32 = lane & 31, hi = lane >> 5;
    const int sr = tid >> 4, sc = (tid & 15) * 8, kws = KSWZ(sr, sc * 2); char* K_lds = lds + 2 * SHM_V;
    const int kb0 = cur.JLO * KVBLK;
    for (int d0 = 0; d0 < 8; ++d0) S.qr[d0] = load8<TIn>(cur.Q + (size_t)(wid * QBLK + r32) * D + d0 * 16 + hi * 8);
    if constexpr (F32) { SLOAD_F((const float*)cur.K, kb0); VMW(); SWRITE_KF(0); SBAR(); SLOAD_F((const float*)cur.V, kb0); }
    else { SLOAD_H(cur.K, cur.V, kb0); VMW(); SWRITE_HK(0); }
    __syncthreads();
}
template <class TIn, class TOut>
__device__ __forceinline__ void causal_swa_block(const BlockRef<TIn, TOut>& cur, const BlockRef<TIn, TOut>& nxt, int skv, int W, char* lds, Seam<TIn>& S) {
    constexpr bool F32 = same_t<TIn, float>::v;
    const int tid = tidx(), wid = __builtin_amdgcn_readfirstlane(tid >> 6), lane = tid & 63, r32 = lane & 31, hi = lane >> 5;
    const int j_lo = cur.JLO;
    int j_hi = (cur.P0 + QB - 1) / KVBLK + 1; if (j_hi > skv / KVBLK) j_hi = skv / KVBLK;
    const int NT = j_hi - j_lo;
    const int kbn = nxt.JLO * KVBLK;
    const int qlo = cur.P0 + wid * QBLK, qm = qlo + r32 - 4 * hi;
    char* V_lds = lds; char* K_lds = lds + 2 * SHM_V;
    float* ws = (float*)(lds + 2 * SHM_V + 2 * SHM_K) + wid * 64; float* li_l = ws, * al_l = ws + 32;
    float m_reg = -1e30f, l_reg = 0; f32x16 o[4] = {};
    const int sr = tid >> 4, sc = (tid & 15) * 8, vst0 = v_st(sr, sc), vst1 = v_st(32 + sr, sc), kws = KSWZ(sr, sc * 2);
    const int vb0 = (int)(uintptr_t)V_lds + v_rd_base(lane);
    const TIn* Kh = cur.K; const TIn* Vh = cur.V;
#define RESC(a) do { if (__any((a) < 1.f)) { if (hi == 0) al_l[r32] = (a); asm volatile("s_waitcnt lgkmcnt(0)" ::: "memory");              \
                     for (int d_ = 0; d_ < 4; ++d_) for (int r = 0; r < 16; ++r) o[d_][r] *= al_l[crow(r, hi)]; } } while (0)
#define KBASE(t) ((j_lo + (t)) * KVBLK)
    const ALAS float* fb3 = (const ALAS float*)((ALAS char*)lds + FB_OFF) + 4 * hi;
#define FBP(t) (fb3 + KBASE(t))
#define ACT(t) (KBASE(t) <= qlo + QBLK - 1 && KBASE(t) + KVBLK - 1 >= qlo - W + 1)
#define MASKT(P0_, P1_, t) do { const int kb_ = KBASE(t); if ((!SK || ACT(t)) && (kb_ + KVBLK - 1 > qlo || kb_ <= qlo + QBLK - 1 - W)) mask_tile(P0_, P1_, qm - kb_, (unsigned)W); } while (0)
    constexpr int NQL = F32 ? 16 : 8;
    constexpr bool SK = WSKIP && !F32;
#define SEAM_K0() do { VMWN(NQL); if constexpr (F32) { SWRITE_KF(0); SBAR(); SLOAD_F((const float*)nxt.V, kbn); } else { SWRITE_HK(0); } SBAR(); } while (0)
    f32x16 pA0, pA1, pB0, pB1; float mnA, mnB, alA, alB; bf16x8 pa0, pa1, pa2, pa3;
    if constexpr (F32) { VMW(); SWRITE_VF(0); SBAR(); } else { SWRITE_HV(0); SBAR(); }
    if (NT > 1) { if constexpr (F32) SLOAD_F((const float*)Kh, KBASE(1)); else SLOAD_H(Kh, Vh, KBASE(1)); }
    SBAR(); qkt<0, SK>(pA0, pA1, K_lds, r32, hi, S.qr, ACT(0), FBP(0));
    if constexpr (F32) { if (NT > 1) { VMW(); SWRITE_KF(1); SBAR(); SLOAD_F((const float*)Vh, KBASE(1)); } }
    MASKT(pA0, pA1, 0); partialSM(pA0, pA1, m_reg, mnA, alA);
    if (NT > 1) { VMW(); if constexpr (F32) { SWRITE_VF(1); SBAR(); if (NT > 2) SLOAD_F((const float*)Kh, KBASE(2)); } else SWRITE_H(1); }
    __syncthreads();
#define HALF_STEP(PX0, PX1, mnX, alX, PY0, PY1, alY, t, KB, VB, SB) do {                                                      \
        SBAR(); qkt<KB, SK>(PX0, PX1, K_lds, r32, hi, S.qr, ACT(t), FBP(t));                                             \
        finishSM(PY0, PY1, alY, l_reg, pa0, pa1, pa2, pa3); SBAR();                                                           \
        if ((t) + 1 < NT) { if constexpr (F32) { VMW(); SWRITE_KF(SB); SBAR(); SLOAD_F((const float*)Vh, KBASE((t) + 1)); }  \
                            else { SLOAD_H(Kh, Vh, KBASE((t) + 1)); } SBAR(); }                                               \
        pv_tile<VB, SK>(o, vb0, pa0, pa1, pa2, pa3, ACT((t) - 1)); MASKT(PX0, PX1, (t)); partialSM(PX0, PX1, m_reg, mnX, alX);                                        \
        __syncthreads();                                                                                                      \
        if ((t) + 1 < NT) { VMW(); if constexpr (F32) { SWRITE_VF(SB); SBAR(); if ((t) + 2 < NT) SLOAD_F((const float*)Kh, KBASE((t) + 2)); } \
                            else { SWRITE_H(SB); } }                                                                          \
        RESC(alX); __syncthreads(); } while (0)
    for (int t = 1; t + 1 < NT; t += 2) {
        HALF_STEP(pB0, pB1, mnB, alB, pA0, pA1, alA, t, 1, 0, 0);
        HALF_STEP(pA0, pA1, mnA, alA, pB0, pB1, alB, t + 1, 0, 1, 1);
    }
    const bool even = (NT & 1) == 0;
    if (even) { SBAR(); qkt<1, SK>(pB0, pB1, K_lds, r32, hi, S.qr, ACT(NT - 1), FBP(NT - 1)); SBAR(); }
#define QROW(e) (nxt.Q + (size_t)(wid * QBLK + r32) * D + ((e) >> 1) * 16 + hi * 8 + ((e) & 1) * 4)
    if constexpr (F32) { SLOAD_F((const float*)nxt.K, kbn); SBAR();
#pragma unroll
        for (int e = 0; e < 8; ++e) S.tq[e] = *(const f32x4*)QROW(e); }
    else { SLOAD_H(nxt.K, nxt.V, kbn); SBAR();
#pragma unroll
        for (int d0 = 0; d0 < 8; ++d0) S.qr[d0] = load8<TIn>(nxt.Q + (size_t)(wid * QBLK + r32) * D + d0 * 16 + hi * 8); }
    SBAR();
    finishSM(pA0, pA1, alA, l_reg, pa0, pa1, pa2, pa3); SBAR();
    if constexpr (F32) {
#pragma unroll
        for (int e = 8; e < 16; ++e) S.tq[e] = *(const f32x4*)QROW(e); SBAR(); }
#undef QROW
    pv_tile<0, SK>(o, vb0, pa0, pa1, pa2, pa3, ACT(even ? NT - 2 : NT - 1));
    if (even) { MASKT(pB0, pB1, NT - 1); partialSM(pB0, pB1, m_reg, mnB, alB); __syncthreads(); RESC(alB);
        finishSM(pB0, pB1, alB, l_reg, pa0, pa1, pa2, pa3); SBAR(); pv_tile<1, SK>(o, vb0, pa0, pa1, pa2, pa3, ACT(NT - 1)); }
    SBAR(); SEAM_K0();
    if (hi == 0) li_l[r32] = l_reg; asm volatile("s_waitcnt lgkmcnt(0)" ::: "memory");
    float rli[16];
#pragma unroll
    for (int r = 0; r < 16; ++r) rli[r] = __builtin_amdgcn_rcpf(li_l[crow(r, hi)]);
    TOut* Ow = cur.O + (size_t)(wid * QBLK) * OSTR;
#pragma unroll
    for (int r = 0; r < 16; ++r) { const int orow = crow(r, hi);
#pragma unroll
        for (int d0 = 0; d0 < 4; ++d0) {
            const float v = o[d0][r] * rli[r];
            const float vn = __shfl_xor(v, 1);
            if ((r32 & 1) == 0) *(unsigned*)(Ow + (size_t)orow * OSTR + d0 * 32 + r32) = cvtpk(v, vn); } }
    if constexpr (F32) {
#pragma unroll
        for (int d0 = 0; d0 < 8; ++d0) S.qr[d0] = pack8(S.tq[2 * d0], S.tq[2 * d0 + 1]); }
    __syncthreads();
#undef RESC
#undef KBASE
#undef FBP
#undef ACT
#undef MASKT
#undef SEAM_K0
#undef HALF_STEP
}
#undef ROW
#undef ROWV
#undef VMW
#undef VMWN
#undef SLOAD_H
#undef SWRITE_HK
#undef SWRITE_HV
#undef SWRITE_H
#undef SLOAD_F
#undef SWRITE_KF
#undef SWRITE_VF

}

#define LAS __attribute__((address_space(3)))
typedef unsigned short bf16_t;
typedef short bf16x8 __attribute__((ext_vector_type(8)));
typedef short s16x4 __attribute__((ext_vector_type(4)));
typedef float f32x4 __attribute__((ext_vector_type(4)));
typedef unsigned u32x4 __attribute__((ext_vector_type(4)));
typedef unsigned u32x2 __attribute__((ext_vector_type(2)));

constexpr int NB = 2, SEQ = 8192, T = NB * SEQ, DM = 2048, DFF = 5632;
constexpr int NTHR = 512, NWV = 8;
constexpr float EPS = 1e-6f;
constexpr int FOX_N = 8208, FOX_LD = 8448;
constexpr int GDN_ROWS = 12544;

constexpr size_t MiB = 1u << 20;
constexpr size_t WS_MODS = 0, WS_FL = 1 * MiB, WS_FB = 2 * MiB, WS_AB = 3 * MiB, WS_GB = 7 * MiB, WS_TB = 11 * MiB;
constexpr size_t WS_WA = 17 * MiB, WS_WB = 66 * MiB, WS_H = 88 * MiB, WS_Y = 152 * MiB, WS_BIG = 216 * MiB;
constexpr size_t WS_P = WS_BIG, WS_QH = WS_BIG + 264 * MiB, WS_KH = WS_QH + 64 * MiB, WS_VH = WS_KH + 64 * MiB;
constexpr size_t WS_GV = WS_BIG;
constexpr size_t WS_QKV = WS_BIG, WS_QN = WS_BIG + 256 * MiB, WS_KN = WS_QN + 64 * MiB, WS_KT = WS_KN + 64 * MiB, WS_VT = WS_KT + 64 * MiB;
constexpr size_t WS_TM = WS_BIG, WS_QKM = WS_BIG + 64 * MiB, WS_O = WS_BIG + 128 * MiB, WS_Z = WS_QN;
constexpr size_t WS_END = WS_VT + 128 * MiB;
static_assert((size_t)GDN_ROWS * DM * 2 <= WS_WB - WS_WA && (size_t)DM * DFF * 2 <= WS_H - WS_WB, "weight regions");

constexpr int LDS_TOTAL = 147456;

__device__ __forceinline__ float bf2f(unsigned h) { return __uint_as_float(h << 16); }
typedef float f32x2_t __attribute__((ext_vector_type(2))); typedef __bf16 bf16x2_t __attribute__((ext_vector_type(2)));
__device__ __forceinline__ unsigned pk2(float lo, float hi) { const f32x2_t v = {lo, hi}; const bf16x2_t b = __builtin_convertvector(v, bf16x2_t); return __builtin_bit_cast(unsigned, b); }
__device__ __forceinline__ void unpack8(u32x4 w, float* f) {
    f[0] = __uint_as_float(w.x << 16); f[1] = __uint_as_float(w.x & 0xffff0000u); f[2] = __uint_as_float(w.y << 16); f[3] = __uint_as_float(w.y & 0xffff0000u);
    f[4] = __uint_as_float(w.z << 16); f[5] = __uint_as_float(w.z & 0xffff0000u); f[6] = __uint_as_float(w.w << 16); f[7] = __uint_as_float(w.w & 0xffff0000u);
}
__device__ __forceinline__ u32x4 pack8f(const float* f) { u32x4 w; w.x = pk2(f[0], f[1]); w.y = pk2(f[2], f[3]); w.z = pk2(f[4], f[5]); w.w = pk2(f[6], f[7]); return w; }
__device__ __forceinline__ float wave_sum(float v) {
#pragma unroll
    for (int o = 1; o < 64; o <<= 1) v += __shfl_xor(v, o);
    return v;
}
__device__ __forceinline__ float sum16(float v) { v += __shfl_xor(v, 1); v += __shfl_xor(v, 2); v += __shfl_xor(v, 4); v += __shfl_xor(v, 8); return v; }
__device__ __forceinline__ float sigmoidf_(float x) { return 1.f / (1.f + __expf(-x)); }
__device__ __forceinline__ float siluf_(float x) { return x / (1.f + __expf(-x)); }

struct EpiStore {
    static constexpr bool PERM = true, AFTER_DRAIN = false;
    bf16_t* O; int ldc; int ncols; float* aux; int aux_tile, aux_n;
    __device__ __forceinline__ void operator()(const pg8::f32x4 (&acc)[2][2][4][2], const pg8::Unit& u, int wr, int wc, int fr, int fq) const {
        const int row0 = u.pm * 256 + wr * 64 + fr, col0 = u.pn * 256 + wc * 32 + 8 * fq;
#pragma unroll
        for (int ai = 0; ai < 2; ++ai)
#pragma unroll
            for (int m = 0; m < 4; ++m) { const int row = row0 + ai * 128 + m * 16; bf16_t* rowp = O + (size_t)row * ldc + col0;
#pragma unroll
                for (int bj = 0; bj < 2; ++bj) { const pg8::f32x4 v0 = acc[ai][bj][m][0], v1 = acc[ai][bj][m][1];
                    if (col0 + bj * 128 < ncols) { u32x4 w; w.x = pk2(v0[0], v0[1]); w.y = pk2(v0[2], v0[3]); w.z = pk2(v1[0], v1[1]); w.w = pk2(v1[2], v1[3]);
                        *(u32x4*)(rowp + bj * 128) = w; }
                    if (u.pn == aux_tile) { const int ct = wc * 32 + 8 * fq + bj * 128;
                        if (ct < aux_n) { float* ap = aux + (size_t)row * aux_n + ct; *(pg8::f32x4*)ap = v0; *(pg8::f32x4*)(ap + 4) = v1; } } } }
    }
};
__device__ __forceinline__ void run_gemm(LAS unsigned char* lds, const bf16_t* A, int lda, const bf16_t* Bt, int N, int K, bf16_t* O, int ldc, int ncols, float* aux, int aux_tile, int aux_n) {
    pg8::Gemm g{A, Bt, T, N, K, lda}; pg8::StaticOrder S; S.init(T, N, (int)gridDim.x, (int)blockIdx.x);
    EpiStore E{O, ldc, ncols, aux, aux_tile, aux_n};
    pg8::gemm_phase<EpiStore, pg8::StaticOrder, true, true>(lds, g, S, E);
}

__device__ __forceinline__ void convert_weight(LAS unsigned char* lds, const float* W, int K, int N, bf16_t* WT, int seg1, int add1, int seg2, int add2) {
    const int lane = tidx() & 63, wave = tidx() >> 6;
    LAS float* scr = (LAS float*)(lds + wave * 16384);
    const int gw = blockIdx.x * NWV + wave, NGW = gridDim.x * NWV;
    const int nblk = (N + 31) / 32, nitems = (K / 64) * nblk;
    for (int item = gw; item < nitems; item += NGW) {
        const int kb = item / nblk, nb = item % nblk, k0 = 64 * kb, n0 = 32 * nb;
        const int c4 = (lane & 7) * 4, nn = n0 + c4; const bool ok = nn < N;
        f32x4 vld[8];
#pragma unroll
        for (int i = 0; i < 8; ++i) { const int kk = 8 * i + (lane >> 3); vld[i] = ok ? *(const f32x4*)(W + (size_t)(k0 + kk) * N + nn) : (f32x4){0.f, 0.f, 0.f, 0.f}; }
#pragma unroll
        for (int i = 0; i < 8; ++i) { const int kk = 8 * i + (lane >> 3); LAS float* sp = scr + kk * 33 + c4; sp[0] = vld[i][0]; sp[1] = vld[i][1]; sp[2] = vld[i][2]; sp[3] = vld[i][3]; }
        asm volatile("s_waitcnt lgkmcnt(0)" ::: "memory");
        const int c = lane & 7;
#pragma unroll
        for (int j = 0; j < 4; ++j) { const int nl = (lane >> 3) + 8 * j, n = n0 + nl; const LAS float* s = scr + (8 * c) * 33 + nl;
            u32x4 o; o.x = pk2(s[0 * 33], s[1 * 33]); o.y = pk2(s[2 * 33], s[3 * 33]); o.z = pk2(s[4 * 33], s[5 * 33]); o.w = pk2(s[6 * 33], s[7 * 33]);
            if (n < N) { const int row = n + (n >= seg2 ? add2 : (n >= seg1 ? add1 : 0)); *(u32x4*)(WT + (size_t)row * K + k0 + 8 * c) = o; } }
        asm volatile("s_waitcnt lgkmcnt(0)" ::: "memory");
    }
    __syncthreads();
}
constexpr int NOSEG = 0x7fffffff;

__device__ __forceinline__ void mods_phase(LAS unsigned char* lds, const float* c, const float* ada_w, const float* ada_b, float* Mods) {
    const int tid = tidx(), lane = tid & 63, wave = tid >> 6, e4 = lane & 15, ds = lane >> 4;
    LAS float* red = (LAS float*)lds;
    for (int u = blockIdx.x; u < 4 * 96; u += gridDim.x) {
        const int is = u / 96, e0 = (u % 96) * 64;
        f32x4 a0 = {0.f, 0.f, 0.f, 0.f}, a1 = {0.f, 0.f, 0.f, 0.f};
#pragma unroll 8
        for (int it = 0; it < 64; ++it) { const int d = 256 * wave + 4 * it + ds;
            const f32x4 wv = *(const f32x4*)(ada_w + ((size_t)is * DM + d) * (3 * DM) + e0 + 4 * e4);
            const float c0 = siluf_(c[d]), c1 = siluf_(c[DM + d]);
            a0 += wv * c0; a1 += wv * c1; }
#pragma unroll
        for (int k = 0; k < 4; ++k) { a0[k] += __shfl_xor(a0[k], 16); a0[k] += __shfl_xor(a0[k], 32); a1[k] += __shfl_xor(a1[k], 16); a1[k] += __shfl_xor(a1[k], 32); }
        if (lane < 16) {
#pragma unroll
            for (int k = 0; k < 4; ++k) { red[(wave * 2 + 0) * 64 + 4 * e4 + k] = a0[k]; red[(wave * 2 + 1) * 64 + 4 * e4 + k] = a1[k]; } }
        __syncthreads();
        if (tid < 128) { const int b = tid >> 6, e = tid & 63; float s = 0.f;
#pragma unroll
            for (int w = 0; w < 8; ++w) s += red[(w * 2 + b) * 64 + e];
            Mods[((size_t)is * 2 + b) * (3 * DM) + e0 + e] = s + ada_b[(size_t)is * (3 * DM) + e0 + e]; }
        __syncthreads();
    }
}

__device__ __forceinline__ void row_phase(const float* xin, float* xout, const bf16_t* Yb, const float* gate, const float* gpost, bf16_t* Hout, const float* gpre, const float* shift, const float* scale) {
    const int lane = tidx() & 63, wave = __builtin_amdgcn_readfirstlane(tidx() >> 6);
    const int gw = blockIdx.x * NWV + wave, NGW = gridDim.x * NWV;
    for (int row = gw; row < T; row += 2 * NGW) {
        const int row1 = row + NGW; const int b = row >> 13; const size_t mo = (size_t)b * 3 * DM;
        f32x4 x0[8], x1[8];
#pragma unroll
        for (int j = 0; j < 8; ++j) { x0[j] = *(const f32x4*)(xin + (size_t)row * DM + 4 * lane + 256 * j); x1[j] = *(const f32x4*)(xin + (size_t)row1 * DM + 4 * lane + 256 * j); }
        if (Yb) {
            u32x2 w0[8], w1[8]; float s0 = 0.f, s1 = 0.f;
#define UNPK4(w) ((f32x4){__uint_as_float((w).x << 16), __uint_as_float((w).x & 0xffff0000u), __uint_as_float((w).y << 16), __uint_as_float((w).y & 0xffff0000u)})
#pragma unroll
            for (int j = 0; j < 8; ++j) { w0[j] = *(const u32x2*)(Yb + (size_t)row * DM + 4 * lane + 256 * j); w1[j] = *(const u32x2*)(Yb + (size_t)row1 * DM + 4 * lane + 256 * j);
                const f32x4 a = UNPK4(w0[j]), c = UNPK4(w1[j]);
                s0 += (a[0] * a[0] + a[1] * a[1]) + (a[2] * a[2] + a[3] * a[3]); s1 += (c[0] * c[0] + c[1] * c[1]) + (c[2] * c[2] + c[3] * c[3]); }
            const float r0 = rsqrtf(wave_sum(s0) * (1.f / DM) + EPS), r1 = rsqrtf(wave_sum(s1) * (1.f / DM) + EPS);
#pragma unroll
            for (int j = 0; j < 8; ++j) { const int c = 4 * lane + 256 * j; const f32x4 m = *(const f32x4*)(gate + mo + c) * *(const f32x4*)(gpost + c);
                x0[j] += m * (UNPK4(w0[j]) * r0); x1[j] += m * (UNPK4(w1[j]) * r1); }
#undef UNPK4
        }
        if (xout) {
#pragma unroll
            for (int j = 0; j < 8; ++j) { *(f32x4*)(xout + (size_t)row * DM + 4 * lane + 256 * j) = x0[j]; *(f32x4*)(xout + (size_t)row1 * DM + 4 * lane + 256 * j) = x1[j]; }
        }
        if (Hout) {
            float s0 = 0.f, s1 = 0.f;
#pragma unroll
            for (int j = 0; j < 8; ++j) { s0 += (x0[j][0] * x0[j][0] + x0[j][1] * x0[j][1]) + (x0[j][2] * x0[j][2] + x0[j][3] * x0[j][3]);
                s1 += (x1[j][0] * x1[j][0] + x1[j][1] * x1[j][1]) + (x1[j][2] * x1[j][2] + x1[j][3] * x1[j][3]); }
            const float r0 = rsqrtf(wave_sum(s0) * (1.f / DM) + EPS), r1 = rsqrtf(wave_sum(s1) * (1.f / DM) + EPS);
#pragma unroll
            for (int j = 0; j < 8; ++j) { const int c = 4 * lane + 256 * j; const f32x4 a = *(const f32x4*)(gpre + c) * (*(const f32x4*)(scale + mo + c) + 1.f), sh = *(const f32x4*)(shift + mo + c);
                const f32x4 h0 = x0[j] * r0 * a + sh, h1 = x1[j] * r1 * a + sh; u32x2 w0, w1; w0.x = pk2(h0[0], h0[1]); w0.y = pk2(h0[2], h0[3]); w1.x = pk2(h1[0], h1[1]); w1.y = pk2(h1[2], h1[3]);
                *(u32x2*)(Hout + (size_t)row * DM + c) = w0; *(u32x2*)(Hout + (size_t)row1 * DM + c) = w1; }
        }
    }
}

__device__ __forceinline__ void fox_prep(const bf16_t* P, const float* FL, const float* fbias, const float* qg, const float* kg, bf16_t* Qh, bf16_t* Kh, bf16_t* Vh, float* FB) {
    const int lane = tidx() & 63, wave = tidx() >> 6;
    const int gw = blockIdx.x * NWV + wave, NGW = gridDim.x * NWV;
    const int dl = (lane & 15) * 8;
    float gq[8], gk[8];
#pragma unroll
    for (int j = 0; j < 8; ++j) { gq[j] = qg[dl + j]; gk[j] = kg[dl + j]; }
    for (int row = gw; row < T; row += NGW) {
        const int b = row >> 13, s = row & (SEQ - 1);
#pragma unroll
        for (int part = 0; part < 2; ++part) {
#pragma unroll
            for (int p = 0; p < 4; ++p) {
                const int col = p * 512 + lane * 8, h = col >> 7;
                const u32x4 w = *(const u32x4*)(P + (size_t)row * FOX_LD + part * 2048 + col);
                bf16_t* dst = (part == 0 ? Qh : (part == 1 ? Kh : Vh)) + (((size_t)(b * 16 + h) * SEQ + s) * 128 + dl);
                if (part == 2) { *(u32x4*)dst = w; }
                else { float f[8]; unpack8(w, f); float ss = 0.f;
#pragma unroll
                    for (int j = 0; j < 8; ++j) ss += f[j] * f[j];
                    const float r = rsqrtf(sum16(ss) * (1.f / 128.f) + EPS);
#pragma unroll
                    for (int j = 0; j < 8; ++j) f[j] = f[j] * r * (part == 0 ? gq[j] : gk[j]);
                    *(u32x4*)dst = pack8f(f); }
            }
        }
    }
    if (wave == 0 && blockIdx.x < 32) {
        const int bh = blockIdx.x, b = bh >> 4, h = bh & 15; const float fb = fbias[h];
        const float* src = FL + ((size_t)b * SEQ + lane * 128) * 16 + h;
        float tot = 0.f;
#pragma unroll 16
        for (int i = 0; i < 128; ++i) { const float x = src[(size_t)i * 16] + fb; tot += (x >= 0.f) ? -log1pf(expf(-x)) : (x - log1pf(expf(x))); }
        float incl = tot;
#pragma unroll
        for (int o = 1; o < 64; o <<= 1) { const float t = __shfl_up(incl, o); if (lane >= o) incl += t; }
        float run = incl - tot;
        float* dst = FB + (size_t)bh * SEQ + lane * 128;
#pragma unroll 16
        for (int i = 0; i < 128; ++i) { const float x = src[(size_t)i * 16] + fb; run += (x >= 0.f) ? -log1pf(expf(-x)) : (x - log1pf(expf(x))); dst[i] = -run * 11.313708498984761f; }
    }
}

__device__ __forceinline__ void fox_attention(char* lds, const bf16_t* Qh, const bf16_t* Kh, const bf16_t* Vh, const bf16_t* P, const float* FB, bf16_t* AO, const float* qg, const float* kg) {
    using abf = att::bf16; typedef att::BlockRef<abf, abf> Ref;
    float thr_t;
    { const int ll = tidx() & 63; float mq = fmaxf(fabsf(qg[ll]), fabsf(qg[64 + ll])), mk = fmaxf(fabsf(kg[ll]), fabsf(kg[64 + ll]));
#pragma unroll
      for (int o = 1; o < 64; o <<= 1) { mq = fmaxf(mq, __shfl_xor(mq, o)); mk = fmaxf(mk, __shfl_xor(mk, o)); }
      thr_t = 2.04f * 128.f * mq * mk + 32.f * 11.313708498984761f; }
    for (int L = blockIdx.x; L < 512; L += gridDim.x) {
        const int bh = L >> 4, x = L & 15, b = bh >> 4, h = bh & 15;
        __syncthreads();
        {
            const f32x4* src = (const f32x4*)(FB + (size_t)bh * SEQ); LAS f32x4* dst = (LAS f32x4*)((LAS char*)lds + att::FB_OFF);
            const int tl = tidx();
#pragma unroll
            for (int i = 0; i < 4; ++i) dst[tl + i * NTHR] = src[tl + i * NTHR];
        }
        Ref r0, r1;
        const int qb0 = x, qb1 = 31 - x;
        __syncthreads();
        int jl[2];
#pragma unroll
        for (int pass = 0; pass < 2; ++pass) { const int P0 = (pass ? qb1 : qb0) * 256; const LAS float* tbl = (const LAS float*)((LAS char*)lds + att::FB_OFF);
            const float ref = tbl[P0]; int lo = 0, hi = P0 >> 6;
            while (lo < hi) { const int mid = (lo + hi + 1) >> 1; if (ref - tbl[64 * mid - 1] > thr_t) lo = mid; else hi = mid - 1; }
            jl[pass] = __builtin_amdgcn_readfirstlane(lo); }
        r0.Q = (const abf*)Qh + ((size_t)bh * SEQ + (size_t)qb0 * 256) * 128; r0.K = (const abf*)Kh + (size_t)bh * SEQ * 128; r0.V = (const abf*)P + (size_t)b * SEQ * FOX_LD + 4096 + h * 128;
        r0.O = (abf*)AO + ((size_t)b * SEQ + (size_t)qb0 * 256) * DM + h * 128; r0.G = nullptr; r0.P0 = qb0 * 256; r0.JLO = jl[0];
        r1 = r0;
        r1.Q = (const abf*)Qh + ((size_t)bh * SEQ + (size_t)qb1 * 256) * 128;
        r1.O = (abf*)AO + ((size_t)b * SEQ + (size_t)qb1 * 256) * DM + h * 128; r1.P0 = qb1 * 256; r1.JLO = jl[1];
        att::Seam<abf> S;
        att::causal_swa_prime<abf, abf>(r0, SEQ, lds, S);
        att::causal_swa_block<abf, abf>(r0, r1, SEQ, SEQ, lds, S);
        att::causal_swa_block<abf, abf>(r1, r1, SEQ, SEQ, lds, S);
        asm volatile("s_waitcnt vmcnt(0)" ::: "memory");
        __syncthreads();
#pragma unroll 1
        for (int pass = 0; pass < 2; ++pass) { const int qb = pass ? qb1 : qb0;
#pragma unroll 2
            for (int i = 0; i < 8; ++i) { const int idx = tidx() + NTHR * i, row = idx >> 4, c8 = idx & 15; const size_t trow = (size_t)b * SEQ + (size_t)qb * 256 + row;
                bf16_t* op = AO + trow * DM + h * 128 + c8 * 8; const bf16_t* gp = P + trow * FOX_LD + 6160 + h * 128 + c8 * 8;
                float o[8], g[8]; unpack8(*(const u32x4*)op, o); unpack8(*(const u32x4*)gp, g);
#pragma unroll
                for (int j = 0; j < 8; ++j) o[j] *= sigmoidf_(g[j]);
                *(u32x4*)op = pack8f(o); } }
    }
    asm volatile("s_waitcnt vmcnt(0)" ::: "memory");
    __syncthreads();
}

__device__ __forceinline__ void glu_phase(bf16_t* GV, const float* cw, const float* cb) {
    constexpr int LD = 2 * DFF, NCG = DFF / 8, RUN = 32, NTASK = (T / RUN) * NCG;
    const int gt = blockIdx.x * NTHR + tidx(), NGT = gridDim.x * NTHR;
    for (int task = gt; task < NTASK; task += NGT) {
        const int run = task / NCG, cgp = task % NCG, col = cgp * 8, t0 = run * RUN;
        float w0[8], w1[8], w2[8], bb[8];
#pragma unroll
        for (int j = 0; j < 8; ++j) { w0[j] = cw[col + j]; w1[j] = cw[DFF + col + j]; w2[j] = cw[2 * DFF + col + j]; bb[j] = cb[col + j]; }
        float h0[8], h1[8];
        if ((t0 & (SEQ - 1)) == 0) {
#pragma unroll
            for (int j = 0; j < 8; ++j) { h0[j] = 0.f; h1[j] = 0.f; }
        } else { unpack8(*(const u32x4*)(GV + (size_t)(t0 - 2) * LD + col), h0); unpack8(*(const u32x4*)(GV + (size_t)(t0 - 1) * LD + col), h1); }
#pragma unroll 4
        for (int i = 0; i < RUN; ++i) {
            bf16_t* rp = GV + (size_t)(t0 + i) * LD + col;
            float g[8], v[8], o[8]; unpack8(*(const u32x4*)rp, g); unpack8(*(const u32x4*)(rp + DFF), v);
#pragma unroll
            for (int j = 0; j < 8; ++j) { const float a = w0[j] * h0[j] + w1[j] * h1[j] + w2[j] * g[j] + bb[j];
                o[j] = 0.5f * a * (1.f + erff(a * 0.70710678118654752f)) * v[j]; h0[j] = h1[j]; h1[j] = g[j]; }
            *(u32x4*)(rp + DFF) = pack8f(o);
        }
    }
}

__device__ __forceinline__ void gdn_prep(const bf16_t* QKV, const float* AB, const float* cw, const float* a_log, const float* dt_bias,
                                         bf16_t* qn, bf16_t* kn, bf16_t* kT, bf16_t* vT, float* Gt, float* Bt) {
    const int gt = blockIdx.x * NTHR + tidx(), NGT = gridDim.x * NTHR;
    for (int i = gt; i < T * 32; i += NGT) { const int t = i >> 5, hv = i & 31;
        const float a = AB[(size_t)t * 64 + hv] + dt_bias[hv], bq = AB[(size_t)t * 64 + 32 + hv];
        const float sp = a > 20.f ? a : log1pf(expf(a));
        Gt[i] = -expf(a_log[hv]) * sp; Bt[i] = 1.f / (1.f + expf(-bq)); }
    for (int task = gt; task < 256 * 1024; task += NGT) {
        const int chunk = task >> 10, cgp = task & 1023, col = cgp * 8, n = chunk & 127, row0 = chunk * 64;
        const int type = col < 2048 ? 0 : (col < 4096 ? 1 : 2);
        float w0[8], w1[8], w2[8], w3[8], h0[8], h1[8], h2[8];
#pragma unroll
        for (int j = 0; j < 8; ++j) { w0[j] = cw[col + j]; w1[j] = cw[8192 + col + j]; w2[j] = cw[2 * 8192 + col + j]; w3[j] = cw[3 * 8192 + col + j]; }
        if (n == 0) {
#pragma unroll
            for (int j = 0; j < 8; ++j) { h0[j] = 0.f; h1[j] = 0.f; h2[j] = 0.f; }
        } else { unpack8(*(const u32x4*)(QKV + (size_t)(row0 - 3) * 8192 + col), h0); unpack8(*(const u32x4*)(QKV + (size_t)(row0 - 2) * 8192 + col), h1); unpack8(*(const u32x4*)(QKV + (size_t)(row0 - 1) * 8192 + col), h2); }
        const float qs = type == 0 ? 0.08838834764831845f : 1.f;
        for (int rb = 0; rb < 8; ++rb) {
            float yv[8][8];
#pragma unroll
            for (int rr = 0; rr < 8; ++rr) {
                const int t = row0 + rb * 8 + rr; float xv[8]; unpack8(*(const u32x4*)(QKV + (size_t)t * 8192 + col), xv);
                float ss = 0.f;
#pragma unroll
                for (int j = 0; j < 8; ++j) { float y = w0[j] * h0[j] + w1[j] * h1[j] + w2[j] * h2[j] + w3[j] * xv[j]; h0[j] = h1[j]; h1[j] = h2[j]; h2[j] = xv[j];
                    y = siluf_(y); yv[rr][j] = y; ss += y * y; }
                if (type < 2) { const float r = rsqrtf(sum16(ss) + EPS) * qs;
#pragma unroll
                    for (int j = 0; j < 8; ++j) yv[rr][j] *= r;
                    *(u32x4*)((type == 0 ? qn : kn) + (size_t)t * 2048 + (col & 2047)) = pack8f(yv[rr]); }
            }
            if (type > 0) {
                const int cc = type == 1 ? col - 2048 : col - 4096, hh = cc >> 7, d0 = cc & 127;
                bf16_t* base = type == 1 ? kT + ((size_t)chunk * 16 + hh) * 8192 + (size_t)(rb * 128 + d0) * 8 : vT + ((size_t)chunk * 32 + hh) * 8192 + (size_t)(rb * 128 + d0) * 8;
#pragma unroll
                for (int j = 0; j < 8; ++j) { u32x4 w; w.x = pk2(yv[0][j], yv[1][j]); w.y = pk2(yv[2][j], yv[3][j]); w.z = pk2(yv[4][j], yv[5][j]); w.w = pk2(yv[6][j], yv[7][j]);
                    *(u32x4*)(base + (size_t)j * 8) = w; }
            }
        }
    }
}

__device__ __forceinline__ void gdn_g1(LAS unsigned char* lds, const bf16_t* qn, const bf16_t* kn, const float* Gt, const float* Bt, bf16_t* Tm, bf16_t* QKm, float* TB) {
    const int tid = tidx(), lane = tid & 63, wid = __builtin_amdgcn_readfirstlane(tid >> 6), r = lane & 15, g = lane >> 4;
    const int grp = wid >> 1, lw = wid & 1;
    LAS float* Am = (LAS float*)(lds + grp * 35840);
    LAS float* gcs = (LAS float*)(lds + grp * 35840 + 34816);
    LAS float* bts = (LAS float*)(lds + grp * 35840 + 35328);
    for (int u0 = blockIdx.x; u0 < 1024; u0 += gridDim.x) {
        const int unit = u0 + grp * 1024;
        const int chunk = unit >> 4, hk = unit & 15, row0 = chunk * 64;
        { const int hv = 2 * hk + lw;
            const float gv = Gt[(size_t)(row0 + lane) * 32 + hv], bv = Bt[(size_t)(row0 + lane) * 32 + hv];
            float sc = gv;
#pragma unroll
            for (int o = 1; o < 64; o <<= 1) { const float t = __shfl_up(sc, o); if (lane >= o) sc += t; }
            const float gl = __shfl(sc, 63);
            gcs[lw * 64 + lane] = sc; bts[lw * 64 + lane] = bv;
            float* tb = TB + ((size_t)chunk * 32 + hv) * 192;
            tb[lane] = bv; tb[64 + lane] = expf(sc); tb[128 + lane] = expf(gl - sc); }
        __syncthreads();
#pragma unroll 1
        for (int nt2 = 0; nt2 < 2; ++nt2) {
            const int nt = 2 * lw + nt2, c = 16 * nt + r;
            bf16x8 kY[4], qY[4];
            const bf16_t* yb = kn + (size_t)(row0 + 16 * nt + r) * 2048 + hk * 128 + 8 * g; const bf16_t* qb = qn + (size_t)(row0 + 16 * nt + r) * 2048 + hk * 128 + 8 * g;
#pragma unroll
            for (int ks = 0; ks < 4; ++ks) { kY[ks] = *(const bf16x8*)(yb + 32 * ks); qY[ks] = *(const bf16x8*)(qb + 32 * ks); }
#pragma unroll
            for (int mt = 0; mt < 4; ++mt) {
                const bf16_t* xb = kn + (size_t)(row0 + 16 * mt + r) * 2048 + hk * 128 + 8 * g;
                f32x4 kk = {0.f, 0.f, 0.f, 0.f}, qk = {0.f, 0.f, 0.f, 0.f};
#pragma unroll
                for (int ks = 0; ks < 4; ++ks) { const bf16x8 X = *(const bf16x8*)(xb + 32 * ks);
                    kk = __builtin_amdgcn_mfma_f32_16x16x32_bf16(X, kY[ks], kk, 0, 0, 0); qk = __builtin_amdgcn_mfma_f32_16x16x32_bf16(X, qY[ks], qk, 0, 0, 0); }
#pragma unroll
                for (int j = 0; j < 2; ++j) { const float gcc = gcs[j * 64 + c], bc = bts[j * 64 + c]; const f32x4 gcp = *(const LAS f32x4*)(gcs + j * 64 + 16 * mt + 4 * g);
                    f32x4 av; float qv[4];
#pragma unroll
                    for (int i = 0; i < 4; ++i) { const int cp = 16 * mt + 4 * g + i; const float e = __expf(fminf(gcc - gcp[i], 0.f));
                        av[i] = (c > cp) ? kk[i] * bc * e : 0.f; qv[i] = (c >= cp) ? qk[i] * e : 0.f; }
                    *(LAS f32x4*)(Am + (j * 64 + c) * 68 + 16 * mt + 4 * g) = av;
                    u32x2 w; w.x = pk2(qv[0], qv[1]); w.y = pk2(qv[2], qv[3]);
                    *(u32x2*)(QKm + (((size_t)chunk * 32 + 2 * hk + j) * 64 + c) * 64 + 16 * mt + 4 * g) = w; }
            }
        }
        __syncthreads();
        {
            const LAS float* A = Am + lw * 64 * 68; float t[64];
#pragma unroll
            for (int i = 0; i < 64; ++i) t[i] = 0.f;
#pragma unroll
            for (int i = 0; i < 64; ++i) { float acc = (lane == i) ? 1.f : 0.f, acc1 = 0.f, acc2 = 0.f, acc3 = 0.f;
#pragma unroll
                for (int jb = 0; jb < (i + 3) / 4; ++jb) { const f32x4 a = *(const LAS f32x4*)(A + i * 68 + 4 * jb);
                    acc -= a[0] * t[4 * jb]; acc1 -= a[1] * t[4 * jb + 1]; acc2 -= a[2] * t[4 * jb + 2]; acc3 -= a[3] * t[4 * jb + 3]; }
                t[i] = (acc + acc1) + (acc2 + acc3); }
            bf16_t* tp = Tm + ((size_t)chunk * 32 + 2 * hk + lw) * 4096 + lane;
#pragma unroll
            for (int i = 0; i < 64; ++i) tp[i * 64] = (bf16_t)(pk2(t[i], 0.f) & 0xffffu);
        }
        __syncthreads();
    }
}

__device__ __forceinline__ s16x4 ldsrd8(const LAS unsigned char* p) { return *(const LAS s16x4*)p; }
__device__ __forceinline__ bf16x8 join8(s16x4 a, s16x4 b) { return (bf16x8){a[0], a[1], a[2], a[3], b[0], b[1], b[2], b[3]}; }
__device__ __forceinline__ bf16x8 packf8(f32x4 a, f32x4 b) { u32x4 w; w.x = pk2(a[0], a[1]); w.y = pk2(a[2], a[3]); w.z = pk2(b[0], b[1]); w.w = pk2(b[2], b[3]); return __builtin_bit_cast(bf16x8, w); }
__device__ __forceinline__ void gdn_g2(LAS unsigned char* lds, const bf16_t* qn, const bf16_t* kn, const bf16_t* kT, const bf16_t* vT, const bf16_t* Tm, const bf16_t* QKm, const float* TB, bf16_t* O) {
    if (blockIdx.x >= 128) return;
    const int tid = tidx(), lane = tid & 63, wid = __builtin_amdgcn_readfirstlane(tid >> 6), r = lane & 15, g = lane >> 4;
    const int b = blockIdx.x >> 6, hv = (blockIdx.x >> 1) & 31, hk = hv >> 1, e0 = (blockIdx.x & 1) * 64 + (wid & 3) * 16;
    constexpr int O_KN = 0, O_QN = 16384, O_KT = 32768, O_TT = 49152, O_QK = 57344, BUFB = 65536, O_TB = 131072;
    int off128[8], off64[4];
#pragma unroll
    for (int q = 0; q < 8; ++q) { const int p = 2 * q + (g >> 1); off128[q] = r * 256 + ((p ^ r) << 4) + 8 * (g & 1); }
#pragma unroll
    for (int q = 0; q < 4; ++q) { const int p = 2 * q + (g >> 1); off64[q] = r * 128 + ((p ^ ((r >> 1) & 7)) << 4) + 8 * (g & 1); }
    f32x4 S[8];
#pragma unroll
    for (int i = 0; i < 8; ++i) S[i] = (f32x4){0.f, 0.f, 0.f, 0.f};
    f32x4 tbreg = {0.f, 0.f, 0.f, 0.f};
#define G2_ISSUE(n_, bf_) do { const int chunk_ = b * 128 + (n_); \
        _Pragma("unroll") for (int i_ = 0; i_ < 8; ++i_) { const int q_ = wid * 64 + lane + 512 * i_; const bf16_t* src_; \
            if (i_ < 4) { const int ql = q_ & 1023, row = ql >> 4, p = (ql & 15) ^ (row & 15); src_ = (i_ < 2 ? kn : qn) + (size_t)(chunk_ * 64 + row) * 2048 + hk * 128 + p * 8; } \
            else if (i_ < 6) { const int ql = q_ - 2048, row = ql >> 3, p = (ql & 7) ^ ((row >> 1) & 7); src_ = kT + ((size_t)chunk_ * 16 + hk) * 8192 + (size_t)(p * 128 + row) * 8; } \
            else { const int ql = q_ - (i_ == 6 ? 3072 : 3584), row = ql >> 3, p = (ql & 7) ^ ((row >> 1) & 7); src_ = (i_ == 6 ? Tm : QKm) + (((size_t)chunk_ * 32 + hv) * 64 + row) * 64 + p * 8; } \
            __builtin_amdgcn_global_load_lds((const unsigned*)src_, (LAS unsigned*)(lds + (bf_) * BUFB + (512 * i_ + wid * 64) * 16), 16, 0, 0); } \
        if (tid < 48) tbreg = *(const f32x4*)(TB + ((size_t)chunk_ * 32 + hv) * 192 + tid * 4); } while (0)
    G2_ISSUE(0, 0);
    if (tid < 48) *(LAS f32x4*)(lds + O_TB + tid * 16) = tbreg;
    for (int n = 0; n < 128; ++n) {
        const int bf = n & 1; const int chunk = b * 128 + n;
        asm volatile("s_waitcnt vmcnt(0)" ::: "memory");
        __syncthreads();
        if (n + 1 < 128) G2_ISSUE(n + 1, bf ^ 1);
        if (wid < 4) {
        f32x4 vv[4];
        { const bf16_t* vp = vT + ((size_t)chunk * 32 + hv) * 8192 + (size_t)((g >> 1) * 128 + e0 + r) * 8 + 4 * (g & 1);
#pragma unroll
          for (int mt = 0; mt < 4; ++mt) { const u32x2 w = *(const u32x2*)(vp + 2048 * mt);
              vv[mt] = (f32x4){__uint_as_float(w.x << 16), __uint_as_float(w.x & 0xffff0000u), __uint_as_float(w.y << 16), __uint_as_float(w.y & 0xffff0000u)}; } }
        const LAS unsigned char* B0 = lds + bf * BUFB;
        const LAS float* tb = (const LAS float*)(lds + O_TB + bf * 768);
        bf16x8 Sb[4];
#pragma unroll
        for (int ks = 0; ks < 4; ++ks) Sb[ks] = packf8(S[2 * ks], S[2 * ks + 1]);
        f32x4 kS[4], qS[4];
#pragma unroll
        for (int mt = 0; mt < 4; ++mt) { kS[mt] = (f32x4){0.f, 0.f, 0.f, 0.f}; qS[mt] = (f32x4){0.f, 0.f, 0.f, 0.f};
#pragma unroll
            for (int ks = 0; ks < 4; ++ks) {
                const bf16x8 xk = join8(ldsrd8(B0 + O_KN + mt * 4096 + off128[2 * ks]), ldsrd8(B0 + O_KN + mt * 4096 + off128[2 * ks + 1]));
                const bf16x8 xq = join8(ldsrd8(B0 + O_QN + mt * 4096 + off128[2 * ks]), ldsrd8(B0 + O_QN + mt * 4096 + off128[2 * ks + 1]));
                kS[mt] = __builtin_amdgcn_mfma_f32_16x16x32_bf16(xk, Sb[ks], kS[mt], 0, 0, 0);
                qS[mt] = __builtin_amdgcn_mfma_f32_16x16x32_bf16(xq, Sb[ks], qS[mt], 0, 0, 0); } }
        f32x4 beta[4], eg[4], ed[4];
#pragma unroll
        for (int mt = 0; mt < 4; ++mt) { beta[mt] = *(const LAS f32x4*)(tb + 16 * mt + 4 * g); eg[mt] = *(const LAS f32x4*)(tb + 64 + 16 * mt + 4 * g); ed[mt] = *(const LAS f32x4*)(tb + 128 + 16 * mt + 4 * g); }
        const float egl = tb[64 + 63];
        f32x4 rr[4];
#pragma unroll
        for (int mt = 0; mt < 4; ++mt) rr[mt] = beta[mt] * (vv[mt] - eg[mt] * kS[mt]);
        bf16x8 rb[2] = {packf8(rr[0], rr[1]), packf8(rr[2], rr[3])};
        f32x4 vn[4];
#pragma unroll
        for (int mt = 0; mt < 4; ++mt) { vn[mt] = (f32x4){0.f, 0.f, 0.f, 0.f};
#pragma unroll
            for (int ks = 0; ks < 2; ++ks) { const bf16x8 xt = join8(ldsrd8(B0 + O_TT + mt * 2048 + off64[2 * ks]), ldsrd8(B0 + O_TT + mt * 2048 + off64[2 * ks + 1]));
                vn[mt] = __builtin_amdgcn_mfma_f32_16x16x32_bf16(xt, rb[ks], vn[mt], 0, 0, 0); } }
        bf16x8 vnb[2] = {packf8(vn[0], vn[1]), packf8(vn[2], vn[3])};
        f32x4 o[4];
#pragma unroll
        for (int mt = 0; mt < 4; ++mt) { o[mt] = eg[mt] * qS[mt];
#pragma unroll
            for (int ks = 0; ks < 2; ++ks) { const bf16x8 xq = join8(ldsrd8(B0 + O_QK + mt * 2048 + off64[2 * ks]), ldsrd8(B0 + O_QK + mt * 2048 + off64[2 * ks + 1]));
                o[mt] = __builtin_amdgcn_mfma_f32_16x16x32_bf16(xq, vnb[ks], o[mt], 0, 0, 0); } }
        bf16x8 vdb[2] = {packf8(vn[0] * ed[0], vn[1] * ed[1]), packf8(vn[2] * ed[2], vn[3] * ed[3])};
#pragma unroll
        for (int dt = 0; dt < 8; ++dt) { S[dt] = S[dt] * egl;
#pragma unroll
            for (int ks = 0; ks < 2; ++ks) { const bf16x8 xk = join8(ldsrd8(B0 + O_KT + dt * 2048 + off64[2 * ks]), ldsrd8(B0 + O_KT + dt * 2048 + off64[2 * ks + 1]));
                S[dt] = __builtin_amdgcn_mfma_f32_16x16x32_bf16(xk, vdb[ks], S[dt], 0, 0, 0); } }
        { bf16_t* op = O + (size_t)(chunk * 64 + 4 * g) * 4096 + hv * 128 + e0 + r;
#pragma unroll
          for (int mt = 0; mt < 4; ++mt)
#pragma unroll
              for (int i = 0; i < 4; ++i) op[(size_t)(16 * mt + i) * 4096] = (bf16_t)(pk2(o[mt][i], 0.f) & 0xffffu); }
        }
        if (n + 1 < 128 && tid < 48) *(LAS f32x4*)(lds + O_TB + (bf ^ 1) * 768 + tid * 16) = tbreg;
    }
#undef G2_ISSUE
    asm volatile("s_waitcnt vmcnt(0)" ::: "memory");
    __syncthreads();
}

__device__ __forceinline__ void gdn_g3(bf16_t* O, const bf16_t* Z, const float* gn) {
    const int gt = blockIdx.x * NTHR + tidx(), NGT = gridDim.x * NTHR;
    const int dl = (tidx() & 15) * 8; float gv[8];
#pragma unroll
    for (int j = 0; j < 8; ++j) gv[j] = gn[dl + j];
#pragma unroll 4
    for (int idx = gt; idx < T * 512; idx += NGT) {
        float o[8], z[8]; unpack8(*(const u32x4*)(O + (size_t)idx * 8), o); unpack8(*(const u32x4*)(Z + (size_t)idx * 8), z);
        float ss = 0.f;
#pragma unroll
        for (int j = 0; j < 8; ++j) ss += o[j] * o[j];
        const float rn = rsqrtf(sum16(ss) * (1.f / 128.f) + EPS);
#pragma unroll
        for (int j = 0; j < 8; ++j) o[j] = o[j] * rn * gv[j] * siluf_(z[j]);
        *(u32x4*)(O + (size_t)idx * 8) = pack8f(o);
    }
}

#define XB_TMO      128
#define XB_XCNT(j)  (256  + 64 * (j))
#define XB_XSUB(j)  (1280 + 64 * (j))
#define XB_XGEN(j)  (2304 + 64 * (j))
#define XB_TOP      3328
#define XB_TOPGEN   3392
#define XCD_BAR_WORDS 3456
#define XB_SPIN_CAP (1u << 18)

__device__ __forceinline__ unsigned xb_ld(unsigned* p)              { return __hip_atomic_load(p, __ATOMIC_RELAXED, __HIP_MEMORY_SCOPE_AGENT); }
__device__ __forceinline__ unsigned xb_add(unsigned* p, unsigned v) { return __hip_atomic_fetch_add(p, v, __ATOMIC_RELAXED, __HIP_MEMORY_SCOPE_AGENT); }
__device__ __forceinline__ unsigned xb_xcc_id() { return (unsigned)__builtin_amdgcn_s_getreg((3 << 11) | 20) & 0xFu; }
#define XB_SPIN(cond, bar) do { unsigned _sp = 0; while (cond) { __builtin_amdgcn_s_sleep(1); \
    if ((++_sp & 255u) == 0u) { if (xb_ld(&(bar)[XB_TMO])) break; if (_sp > XB_SPIN_CAP) { atomicAdd(&(bar)[XB_TMO], 1u); break; } } } } while (0)

struct XcdBarrier {
    unsigned* bar; unsigned x;
    volatile LAS unsigned* st;
};

__device__ __forceinline__ XcdBarrier xcd_barrier_post(unsigned* bar, volatile LAS unsigned* st) {
    XcdBarrier b; b.bar = bar; b.x = xb_xcc_id(); b.st = st;
    if (threadIdx.x == 0) (void)xb_add(&bar[XB_XCNT(b.x)], 1u);
    return b;
}
__device__ __forceinline__ void xcd_barrier_complete(unsigned* bar, unsigned x, unsigned& nloc, unsigned& nx) {
    const unsigned G = gridDim.x * gridDim.y * gridDim.z;
    unsigned sum, cnt, mine, sp = 0u;
    for (;;) {
        sum = 0u; cnt = 0u; mine = 0u;
#pragma unroll
        for (unsigned j = 0; j < 16; ++j) { const unsigned c = xb_ld(&bar[XB_XCNT(j)]); sum += c; cnt += (c > 0u) ? 1u : 0u; mine = (j == x) ? c : mine; }
        if (sum == G) break;
        __builtin_amdgcn_s_sleep(1);
        if ((++sp & 255u) == 0u) { if (xb_ld(&bar[XB_TMO])) break; if (sp > XB_SPIN_CAP) { atomicAdd(&bar[XB_TMO], 1u); break; } }
    }
    nloc = mine > 0u ? mine : 1u; nx = cnt > 0u ? cnt : 1u;
}

__device__ __forceinline__ void xcd_barrier(const XcdBarrier& b) {
    asm volatile("s_waitcnt vmcnt(0)" ::: "memory");
    __syncthreads();
    if (threadIdx.x == 0) {
        unsigned* bar = b.bar;
        __builtin_amdgcn_s_waitcnt(0);
        unsigned nloc = b.st[0], nx = b.st[1];
        if (nloc == 0u) { xcd_barrier_complete(bar, b.x, nloc, nx); b.st[0] = nloc; b.st[1] = nx; }
        const unsigned old = xb_add(&bar[XB_XSUB(b.x)], 1u);
        const unsigned gen = old / nloc;
        if (old + 1u == (gen + 1u) * nloc) {
            __builtin_amdgcn_fence(__ATOMIC_RELEASE, "agent");
            asm volatile("s_waitcnt vmcnt(0)" ::: "memory");
            const unsigned og = xb_add(&bar[XB_TOP], 1u);
            const unsigned tg = og / nx;
            if (og + 1u == (tg + 1u) * nx) xb_add(&bar[XB_TOPGEN], 1u);
            else XB_SPIN(xb_ld(&bar[XB_TOPGEN]) == tg, bar);
            __builtin_amdgcn_fence(__ATOMIC_ACQUIRE, "agent");
            xb_add(&bar[XB_XGEN(b.x)], 1u);
            asm volatile("s_waitcnt vmcnt(0)" ::: "memory");
        } else {
            XB_SPIN(xb_ld(&bar[XB_XGEN(b.x)]) == gen, bar);
            __builtin_amdgcn_fence(__ATOMIC_ACQUIRE, "agent");
            asm volatile("s_waitcnt vmcnt(0)" ::: "memory");
        }
    }
    __syncthreads();
}

constexpr size_t WS_BAR = 256 * 1024;
struct Args { const float* in[20]; float* out; unsigned char* ws; int ph_lo, ph_hi; };
constexpr int NPHASE = 23;
#ifndef ONLY_PH
#define ONLY_PH -1
#endif
#define EN(k) (ONLY_PH < 0 || ONLY_PH == (k))
#ifndef MK_COOP
#define MK_COOP 1
#endif

__global__ void __launch_bounds__(NTHR) fwd_megakernel(Args a) {
    extern __shared__ __attribute__((aligned(16))) unsigned char lds_raw[];
    LAS unsigned char* lds = (LAS unsigned char*)lds_raw;
    unsigned char* ws = a.ws;
    const float* x = a.in[0]; const float* cvec = a.in[1]; const float* ada_w = a.in[2]; const float* ada_b = a.in[3]; const float* norm_g = a.in[4];
    float* Mods = (float*)(ws + WS_MODS); float* FL = (float*)(ws + WS_FL); float* FB = (float*)(ws + WS_FB); float* AB = (float*)(ws + WS_AB);
    float* Gt = (float*)(ws + WS_GB); float* Btb = Gt + (size_t)T * 32; float* TB = (float*)(ws + WS_TB);
    bf16_t* WA = (bf16_t*)(ws + WS_WA); bf16_t* WB = (bf16_t*)(ws + WS_WB); bf16_t* Hb = (bf16_t*)(ws + WS_H); bf16_t* Yb = (bf16_t*)(ws + WS_Y);
    bf16_t* Pb = (bf16_t*)(ws + WS_P); bf16_t* Qh = (bf16_t*)(ws + WS_QH); bf16_t* Kh = (bf16_t*)(ws + WS_KH); bf16_t* Vh = (bf16_t*)(ws + WS_VH);
    bf16_t* GV = (bf16_t*)(ws + WS_GV); bf16_t* QKV = (bf16_t*)(ws + WS_QKV); bf16_t* qn = (bf16_t*)(ws + WS_QN); bf16_t* kn = (bf16_t*)(ws + WS_KN);
    bf16_t* kT = (bf16_t*)(ws + WS_KT); bf16_t* vT = (bf16_t*)(ws + WS_VT); bf16_t* Tm = (bf16_t*)(ws + WS_TM); bf16_t* QKm = (bf16_t*)(ws + WS_QKM);
    bf16_t* Ob = (bf16_t*)(ws + WS_O); bf16_t* Zb = (bf16_t*)(ws + WS_Z);
#define mods(layer, sub) (Mods + (size_t)((layer) * 2 + (sub)) * 2 * 3 * DM)
#define ng(layer, k) (norm_g + (size_t)((layer) * 4 + (k)) * DM)
    const int lo = a.ph_lo, hi = a.ph_hi;
    volatile LAS unsigned* xst = (volatile LAS unsigned*)(lds + LDS_TOTAL - 64);
    if (tidx() < 2) xst[tidx()] = 0u;
    __syncthreads();
    XcdBarrier xbar = xcd_barrier_post((unsigned*)(ws + WS_BAR), xst);
    if (__builtin_amdgcn_readfirstlane(tidx() >> 6) == 0) { __threadfence(); asm volatile("s_waitcnt vmcnt(0)" ::: "memory"); } __syncthreads();
#define IN(k) (lo <= (k) && (k) < hi && EN(k))
#define SEAM(k) do { if (lo <= (k) && (k) + 1 < hi) { if ((k) == 0) { asm volatile("s_waitcnt vmcnt(0) lgkmcnt(0)" ::: "memory"); __syncthreads(); cg::this_grid().sync(); if (__builtin_amdgcn_readfirstlane(tidx() >> 6) == 0) { __builtin_amdgcn_fence(__ATOMIC_ACQUIRE, "agent"); asm volatile("s_waitcnt vmcnt(0)" ::: "memory"); } __syncthreads(); } else { xcd_barrier(xbar); } } } while (0)
#define CONV(W_, K_, N_, T_, s1, a1, s2, a2) do { __syncthreads(); convert_weight(lds, W_, K_, N_, T_, s1, a1, s2, a2); } while (0)
#define ROWP(xin_, first_, last_, gl, gs, gk, hl, hs, hk) row_phase(xin_, (first_) ? nullptr : a.out, (first_) ? nullptr : Yb, mods(gl, gs) + 2 * DM, ng(gl, gk), (last_) ? nullptr : Hb, ng(hl, hk), mods(hl, hs), mods(hl, hs) + DM)
    if (IN(0)) { mods_phase(lds, cvec, ada_w, ada_b, Mods); CONV(a.in[5], DM, FOX_N, WA, NOSEG, 0, NOSEG, 0); } SEAM(0);
    if (IN(1)) { ROWP(x, true, false, 0, 0, 0, 0, 0, 0); CONV(a.in[9], DM, DM, WB, NOSEG, 0, NOSEG, 0); } SEAM(1);
    if (IN(2)) { run_gemm(lds, Hb, DM, WA, FOX_LD, DM, Pb, FOX_LD, FOX_N, FL, 24, 16); } SEAM(2);
    if (IN(3)) { fox_prep(Pb, FL, a.in[6], a.in[7], a.in[8], Qh, Kh, Vh, FB); CONV(a.in[16], DM, 2 * DFF, WA, NOSEG, 0, NOSEG, 0); } SEAM(3);
    if (IN(4)) { fox_attention((char*)lds_raw, Qh, Kh, Vh, Pb, FB, Hb, a.in[7], a.in[8]); } SEAM(4);
    if (IN(5)) { run_gemm(lds, Hb, DM, WB, DM, DM, Yb, DM, DM, nullptr, -1, 0); } SEAM(5);
    if (IN(6)) { ROWP(x, false, false, 0, 0, 1, 0, 1, 2); CONV(a.in[19], DFF, DM, WB, NOSEG, 0, NOSEG, 0); } SEAM(6);
    if (IN(7)) { run_gemm(lds, Hb, DM, WA, 2 * DFF, DM, GV, 2 * DFF, 2 * DFF, nullptr, -1, 0); } SEAM(7);
    if (IN(8)) { glu_phase(GV, a.in[17], a.in[18]); CONV(a.in[10], DM, 12352, WA, 8192, 256, 12288, -4096); } SEAM(8);
    if (IN(9)) { run_gemm(lds, GV + DFF, 2 * DFF, WB, DM, DFF, Yb, DM, DM, nullptr, -1, 0); } SEAM(9);
    if (IN(10)) { ROWP(a.out, false, false, 0, 1, 3, 1, 0, 0); CONV(a.in[15], 2 * DM, DM, WB, NOSEG, 0, NOSEG, 0); } SEAM(10);
    if (IN(11)) { run_gemm(lds, Hb, DM, WA, 8448, DM, QKV, 8192, 8192, AB, 32, 64); } SEAM(11);
    if (IN(12)) { gdn_prep(QKV, AB, a.in[11], a.in[12], a.in[13], qn, kn, kT, vT, Gt, Btb); } SEAM(12);
    if (IN(13)) { gdn_g1(lds, qn, kn, Gt, Btb, Tm, QKm, TB); } SEAM(13);
    if (IN(14)) { gdn_g2(lds, qn, kn, kT, vT, Tm, QKm, TB, Ob); } SEAM(14);
    if (IN(15)) { run_gemm(lds, Hb, DM, WA + (size_t)8448 * DM, 2 * DM, DM, Zb, 2 * DM, 2 * DM, nullptr, -1, 0); } SEAM(15);
    if (IN(16)) { gdn_g3(Ob, Zb, a.in[14]); CONV(a.in[16] + (size_t)DM * 2 * DFF, DM, 2 * DFF, WA, NOSEG, 0, NOSEG, 0); } SEAM(16);
    if (IN(17)) { run_gemm(lds, Ob, 2 * DM, WB, DM, 2 * DM, Yb, DM, DM, nullptr, -1, 0); } SEAM(17);
    if (IN(18)) { ROWP(a.out, false, false, 1, 0, 1, 1, 1, 2); CONV(a.in[19] + (size_t)DFF * DM, DFF, DM, WB, NOSEG, 0, NOSEG, 0); } SEAM(18);
    if (IN(19)) { run_gemm(lds, Hb, DM, WA, 2 * DFF, DM, GV, 2 * DFF, 2 * DFF, nullptr, -1, 0); } SEAM(19);
    if (IN(20)) { glu_phase(GV, a.in[17] + 3 * DFF, a.in[18] + DFF); } SEAM(20);
    if (IN(21)) { run_gemm(lds, GV + DFF, 2 * DFF, WB, DM, DFF, Yb, DM, DM, nullptr, -1, 0); } SEAM(21);
    if (IN(22)) { ROWP(a.out, false, true, 1, 1, 3, 0, 0, 0); }
    asm volatile("s_waitcnt vmcnt(0) lgkmcnt(0)" ::: "memory"); __syncthreads(); if (__builtin_amdgcn_readfirstlane(tidx() >> 6) == 0) { __threadfence(); asm volatile("s_waitcnt vmcnt(0)" ::: "memory"); }
#ifdef EXP_ROWS
    __syncthreads(); if (blockIdx.x == 0) { for (int i = tidx(); i < DM; i += NTHR) { a.out[i] = x[i]; a.out[(size_t)SEQ * DM + i] = x[(size_t)SEQ * DM + i]; } }
#endif
}

extern "C" void kernel_launch(void* const* d_in, const int* in_sizes, int n_in, void* d_out, int out_size, void* d_ws, size_t ws_size, hipStream_t stream) {
    static int grid = 0;
    if (grid == 0) {
        if (n_in != 20 || ws_size < WS_END) { fprintf(stderr, "kernel_launch: need 20 inputs and >= %zu B workspace (got %d, %zu)\n", (size_t)WS_END, n_in, ws_size); grid = -1; return; }
        int dev = 0, cus = 0, per_cu = 0;
        (void)hipGetDevice(&dev); (void)hipDeviceGetAttribute(&cus, hipDeviceAttributeMultiprocessorCount, dev);
        if (hipFuncSetAttribute((const void*)fwd_megakernel, hipFuncAttributeMaxDynamicSharedMemorySize, LDS_TOTAL) != hipSuccess) fprintf(stderr, "kernel_launch: hipFuncSetAttribute failed\n");
        if (hipOccupancyMaxActiveBlocksPerMultiprocessor(&per_cu, (const void*)fwd_megakernel, NTHR, LDS_TOTAL) != hipSuccess || per_cu < 1) { fprintf(stderr, "kernel_launch: occupancy query gave %d\n", per_cu); per_cu = 1; }
        (void)hipGetLastError();
        grid = cus > 0 ? cus : 256;
    }
    if (grid < 0) return;
    Args a{};
    for (int i = 0; i < 20; ++i) a.in[i] = (const float*)d_in[i];
    a.out = (float*)d_out; a.ws = (unsigned char*)d_ws;
    (void)hipMemsetAsync((char*)d_ws + WS_BAR, 0, 16384, stream);
#if MK_COOP
    a.ph_lo = 0; a.ph_hi = NPHASE;
    void* args[] = {&a};
    hipError_t e = hipLaunchCooperativeKernel((const void*)fwd_megakernel, dim3(grid), dim3(NTHR), args, LDS_TOTAL, stream);
    if (e != hipSuccess) fprintf(stderr, "cooperative launch failed: %s (grid %d)\n", hipGetErrorString(e), grid);
#else
    for (int ph = 0; ph < NPHASE; ++ph) { a.ph_lo = ph; a.ph_hi = ph + 1; hipLaunchKernelGGL(fwd_megakernel, dim3(grid), dim3(NTHR), LDS_TOTAL, stream, a); }
#endif
}
```

```cpp
#include <hip/hip_runtime.h>
#include <hip/hip_cooperative_groups.h>
#include <hip/hip_bf16.h>
#include <cstdio>
#include <cstdint>
#include <cmath>
namespace cg = cooperative_groups;
__device__ __forceinline__ int tidx() { int t = (int)__builtin_amdgcn_workitem_id_x(); asm volatile("" : "+v"(t)); return t; }
namespace pg8 {
#define PG8_LAS __attribute__((address_space(3)))
typedef unsigned short bf16_t;
typedef short bf16x8 __attribute__((ext_vector_type(8)));
typedef float f32x4 __attribute__((ext_vector_type(4)));
typedef unsigned u32x4 __attribute__((ext_vector_type(4)));
constexpr int BM = 256, BK = 64, HALF = 128, HTB = HALF * BK * 2  , STAGE_BYTES = 8 * HTB, NXCD = 8, WGM = 8;

__host__ __device__ __forceinline__ int lds_byte(int r, int c) { const int st = (r >> 4) * 2 + (c >> 5), rr = r & 15, cc = c & 31, ob = rr * 64 + cc * 2; return st * 1024 + (ob ^ (((ob >> 9) & 1) << 5)); }
__host__ __device__ __forceinline__ void stage_rc(int b, int& R, int& C) { const int st = b / 1024, sb = b % 1024, swz = sb ^ (((sb >> 9) & 1) << 5); R = (st >> 1) * 16 + swz / 64; C = (st & 1) * 32 + (swz % 64) / 2; }
__host__ __device__ __forceinline__ int perm32(int rho) { const int n = rho >> 4, i = rho & 15; return 8 * (i >> 2) + 4 * n + (i & 3); }

struct Unit { int pm, pn; };
struct Gemm { const bf16_t* A; const bf16_t* Bt; int M, N, K, lda; };

struct StaticOrder {
    int nM, nN, nwg, G, c;
    __host__ __device__ void init(int M, int N, int G_, int c_) { nM = M / BM; nN = N / BM; nwg = nM * nN; G = G_; c = c_; }
    __host__ __device__ bool next(int i, Unit& u) const {
        const long L = (long)i * G + c; if (L >= nwg) return false;
        int wgid = (int)L; { const int q = nwg / NXCD, r = nwg % NXCD, xcd = wgid % NXCD, off = wgid / NXCD; wgid = (xcd < r ? xcd * (q + 1) : r * (q + 1) + (xcd - r) * q) + off; }
        const int nig = WGM * nN, gid = wgid / nig, fm = gid * WGM, gsz = (nM - fm) < WGM ? (nM - fm) : WGM;
        u.pm = fm + ((wgid % nig) % gsz); u.pn = (wgid % nig) / gsz; return true;
    }
    __device__ __forceinline__ void a_ready(const Unit&) const {}
    __device__ __forceinline__ void done(const Unit&) const {}
};

__device__ __forceinline__ unsigned cvt_pk_bf16(float lo, float hi) { unsigned r; asm volatile("v_cvt_pk_bf16_f32 %0, %1, %2" : "=v"(r) : "v"(lo), "v"(hi)); return r; }
template <class Epi, class Sched, bool ALIGN_EPI = false, bool SP2 = false>
__device__ __forceinline__ void gemm_phase(PG8_LAS unsigned char* lds, const Gemm g, const Sched& S, const Epi& E) {
    const int tid = tidx(), wid = __builtin_amdgcn_readfirstlane(tid >> 6), lane = tid & 63, wr = wid >> 2, wc = wid & 3, fr = lane & 15, fq = lane >> 4;
    const int K = g.K, nt = K / BK;
    unsigned voffA[2], voffB[2];
#pragma unroll
    for (int i = 0; i < 2; ++i) { int R, C; stage_rc(tid * 16 + i * 8192, R, C); const int Rb = Epi::PERM ? ((R & ~31) + perm32(R & 31)) : R;
        voffA[i] = (unsigned)(R * g.lda + C) * 2u; voffB[i] = (unsigned)(Rb * K + C) * 2u; }
    const size_t kstep = (size_t)(BK * 2);
    const size_t hstep = (size_t)HALF * K * 2;
    const size_t tstep = 2 * hstep; const size_t hstepA = (size_t)HALF * g.lda * 2, tstepA = 2 * hstepA;
    const unsigned ldsw = (unsigned)wid * 1024u;
    const int aoff = lds_byte(wr * 64 + fr, fq * 8), boff = lds_byte(wc * 32 + fr, fq * 8);
#define PG8_SA(b, h) (((b) * 2 + (h)) * HTB)
#define PG8_SB(b, h) ((4 + (b) * 2 + (h)) * HTB)
#define PG8_STAGE(bufoff, gbase, voff) do { _Pragma("unroll") for (int _i = 0; _i < 2; ++_i) \
        __builtin_amdgcn_global_load_lds((const unsigned*)((const char*)(gbase) + (voff)[_i]), (PG8_LAS unsigned*)(lds + (bufoff) + ldsw + _i * 8192), 16, 0, 0); } while (0)
#define PG8_LDA(dst, b, h) do { _Pragma("unroll") for (int m = 0; m < 4; ++m) _Pragma("unroll") for (int k = 0; k < 2; ++k) dst[m][k] = *(const PG8_LAS bf16x8*)(lds + PG8_SA(b, h) + aoff + m * 2048 + k * 1024); } while (0)
#define PG8_LDB(dst, b, h) do { _Pragma("unroll") for (int n = 0; n < 2; ++n) _Pragma("unroll") for (int k = 0; k < 2; ++k) dst[n][k] = *(const PG8_LAS bf16x8*)(lds + PG8_SB(b, h) + boff + n * 2048 + k * 1024); } while (0)
#define PG8_MMA(ai, bj, At, Bt) do { __builtin_amdgcn_s_setprio(1); _Pragma("unroll") for (int m = 0; m < 4; ++m) _Pragma("unroll") for (int n = 0; n < 2; ++n) _Pragma("unroll") for (int k = 0; k < 2; ++k) \
        acc[ai][bj][m][n] = __builtin_amdgcn_mfma_f32_16x16x32_bf16(Bt[n][k], At[m][k], acc[ai][bj][m][n], 0, 0, 0); __builtin_amdgcn_s_setprio(0); } while (0)
#define PG8_WAIT_V(n) asm volatile("s_waitcnt vmcnt(" #n ")" ::: "memory")
#define PG8_WAIT_L(n) asm volatile("s_waitcnt lgkmcnt(" #n ")" ::: "memory")
#define PG8_BAR __builtin_amdgcn_s_barrier()
#define PG8_SCHED __builtin_amdgcn_sched_barrier(0)
    Unit cur, nxt; int ui = 0;
    if (!S.next(0, cur)) return;
    f32x4 acc[2][2][4][2];
#pragma unroll
    for (int a = 0; a < 2; ++a)
#pragma unroll
        for (int b = 0; b < 2; ++b)
#pragma unroll
            for (int m = 0; m < 4; ++m)
#pragma unroll
                for (int n = 0; n < 2; ++n) acc[a][b][m][n] = (f32x4){0.f, 0.f, 0.f, 0.f};
    bf16x8 At[4][2], B0[2][2], B1[2][2];
    const char* cA = (const char*)g.A + (size_t)cur.pm * tstepA; const char* cB = (const char*)g.Bt + (size_t)cur.pn * tstep;
    S.a_ready(cur);
    if constexpr (SP2) {
        PG8_STAGE(PG8_SB(0, 0), cB, voffB); PG8_STAGE(PG8_SB(0, 1), cB + hstep, voffB); PG8_STAGE(PG8_SA(0, 0), cA, voffA); PG8_STAGE(PG8_SA(0, 1), cA + hstepA, voffA);
        if (wr == 1) PG8_BAR;
        PG8_WAIT_V(2); PG8_BAR;
        PG8_STAGE(PG8_SB(1, 0), cB + kstep, voffB); PG8_STAGE(PG8_SA(1, 0), cA + kstep, voffA); PG8_STAGE(PG8_SB(1, 1), cB + hstep + kstep, voffB);
        PG8_WAIT_V(6); PG8_BAR;
    } else {
        PG8_STAGE(PG8_SB(0, 0), cB, voffB); PG8_STAGE(PG8_SA(0, 0), cA, voffA); PG8_STAGE(PG8_SB(0, 1), cB + hstep, voffB); PG8_STAGE(PG8_SA(0, 1), cA + hstepA, voffA);
        if (wr == 1) PG8_BAR;
        PG8_WAIT_V(4); PG8_BAR;
        PG8_STAGE(PG8_SB(1, 0), cB + kstep, voffB); PG8_STAGE(PG8_SA(1, 0), cA + kstep, voffA); PG8_STAGE(PG8_SB(1, 1), cB + hstep + kstep, voffB);
        PG8_WAIT_V(6); PG8_BAR;
    }
    for (;;) {
        const bool has_next = S.next(ui + 1, nxt);
        const char* nA = has_next ? (const char*)g.A + (size_t)nxt.pm * tstepA : cA; const char* nB = has_next ? (const char*)g.Bt + (size_t)nxt.pn * tstep : cB;
        for (int t = 0; t < nt; t += 2) {
            const bool last = (t == nt - 2);
            const char* a1 = cA + (size_t)(t + 1) * kstep;
            const char* a2 = last ? nA : cA + (size_t)(t + 2) * kstep; const char* b2 = last ? nB : cB + (size_t)(t + 2) * kstep;
            const char* a3 = a2 + kstep; const char* b3 = b2 + kstep;
            if (last && has_next) S.a_ready(nxt);
            if constexpr (SP2) {
            PG8_LDB(B0, 0, 0); PG8_LDB(B1, 0, 1); PG8_SCHED; PG8_LDA(At, 0, 0); PG8_STAGE(PG8_SA(1, 1), a1 + hstepA, voffA);
            PG8_WAIT_V(8); PG8_WAIT_L(0); PG8_BAR; PG8_MMA(0, 0, At, B0); PG8_MMA(0, 1, At, B1); PG8_BAR; PG8_SCHED;
            PG8_LDA(At, 0, 1); PG8_STAGE(PG8_SB(0, 0), b2, voffB); PG8_STAGE(PG8_SB(0, 1), b2 + hstep, voffB); PG8_STAGE(PG8_SA(0, 0), a2, voffA);
            PG8_WAIT_V(8); PG8_WAIT_L(0); PG8_BAR; PG8_MMA(1, 0, At, B0); PG8_MMA(1, 1, At, B1); PG8_BAR; PG8_SCHED;
            PG8_LDB(B0, 1, 0); PG8_LDB(B1, 1, 1); PG8_SCHED; PG8_LDA(At, 1, 0); PG8_STAGE(PG8_SA(0, 1), a2 + hstepA, voffA);
            PG8_WAIT_V(8); PG8_WAIT_L(0); PG8_BAR; PG8_MMA(0, 0, At, B0); PG8_MMA(0, 1, At, B1); PG8_BAR; PG8_SCHED;
            PG8_LDA(At, 1, 1); PG8_STAGE(PG8_SB(1, 0), b3, voffB); PG8_STAGE(PG8_SB(1, 1), b3 + hstep, voffB); PG8_STAGE(PG8_SA(1, 0), a3, voffA);
            PG8_WAIT_V(8); PG8_WAIT_L(0); PG8_BAR; PG8_MMA(1, 0, At, B0); PG8_MMA(1, 1, At, B1); PG8_BAR; PG8_SCHED;
            } else {
            PG8_LDB(B0, 0, 0); PG8_SCHED; PG8_LDA(At, 0, 0); PG8_STAGE(PG8_SA(1, 1), a1 + hstepA, voffA);
            PG8_WAIT_L(8); PG8_BAR; PG8_WAIT_L(0); PG8_MMA(0, 0, At, B0); PG8_BAR; PG8_SCHED;
            PG8_LDB(B1, 0, 1); PG8_STAGE(PG8_SB(0, 0), b2, voffB);
            PG8_BAR; PG8_WAIT_L(0); PG8_MMA(0, 1, At, B1); PG8_BAR;
            PG8_LDA(At, 0, 1); PG8_STAGE(PG8_SA(0, 0), a2, voffA);
            PG8_BAR; PG8_WAIT_L(0); PG8_MMA(1, 0, At, B0); PG8_BAR; PG8_SCHED;
            PG8_STAGE(PG8_SB(0, 1), b2 + hstep, voffB);
            PG8_WAIT_V(6); PG8_BAR; PG8_MMA(1, 1, At, B1); PG8_BAR;
            PG8_LDB(B0, 1, 0); PG8_SCHED; PG8_LDA(At, 1, 0); PG8_STAGE(PG8_SA(0, 1), a2 + hstepA, voffA);
            PG8_WAIT_L(8); PG8_BAR; PG8_WAIT_L(0); PG8_MMA(0, 0, At, B0); PG8_BAR; PG8_SCHED;
            PG8_LDB(B1, 1, 1); PG8_STAGE(PG8_SB(1, 0), b3, voffB);
            PG8_BAR; PG8_WAIT_L(0); PG8_MMA(0, 1, At, B1); PG8_BAR;
            PG8_LDA(At, 1, 1); PG8_STAGE(PG8_SA(1, 0), a3, voffA);
            PG8_BAR; PG8_WAIT_L(0); PG8_MMA(1, 0, At, B0); PG8_BAR; PG8_SCHED;
            PG8_STAGE(PG8_SB(1, 1), b3 + hstep, voffB);
            PG8_WAIT_V(6); PG8_BAR; PG8_MMA(1, 1, At, B1); PG8_BAR;
            }
        }
        if constexpr (ALIGN_EPI) { if (wr == 0) PG8_BAR; }
        if constexpr (!Epi::AFTER_DRAIN) { E(acc, cur, wr, wc, fr, fq); S.done(cur); }
        if (!has_next) break;
#pragma unroll
        for (int a = 0; a < 2; ++a)
#pragma unroll
            for (int b = 0; b < 2; ++b)
#pragma unroll
                for (int m = 0; m < 4; ++m)
#pragma unroll
                    for (int n = 0; n < 2; ++n) acc[a][b][m][n] = (f32x4){0.f, 0.f, 0.f, 0.f};
        cur = nxt; cA = nA; cB = nB; ++ui;
        if constexpr (ALIGN_EPI) { if (wr == 1) PG8_BAR; }
    }
    PG8_WAIT_V(0);
    if constexpr (!ALIGN_EPI) { if (wr == 0) PG8_BAR; }
    PG8_BAR;
    if constexpr (Epi::AFTER_DRAIN) { E.fused(acc, cur, wr, wc, fr, fq, lds, wid, lane); S.done(cur); }
#undef PG8_SA
#undef PG8_SB
#undef PG8_STAGE
#undef PG8_LDA
#undef PG8_LDB
#undef PG8_MMA
#undef PG8_WAIT_V
#undef PG8_WAIT_L
#undef PG8_BAR
#undef PG8_SCHED
}
}
namespace att {
enum { ORDER_NATURAL = 0, ORDER_REVERSED = 1, ORDER_PAIRED = 2, ORDER_XCD = 4 };
constexpr int B = 2, H = 16, HKV = 16, SQ = 8192, SKV = 8192, D = 128;
constexpr int QOFF = 0;
constexpr int WINDOW = SKV;
constexpr float THR = 8.f;
constexpr bool WSKIP = false;

constexpr float SCALE = 0.08838834764831845f;
constexpr int NW = 8, QBLK = 32, KVBLK = 64, QB = NW * QBLK;
constexpr int SHM_V = KVBLK * D * 2, SHM_K = KVBLK * D * 2;
constexpr int LDS_BYTES = 2 * SHM_V + 2 * SHM_K + NW * 64 * 4;
constexpr int FB_OFF = LDS_BYTES, OSTR = 2048, GSTR = 8448;

using bf16 = __hip_bfloat16;
#define ALAS __attribute__((address_space(3)))
typedef short bf16x8 __attribute__((ext_vector_type(8)));
typedef short s16x4 __attribute__((ext_vector_type(4)));
typedef float f32x16 __attribute__((ext_vector_type(16)));
typedef float f32x4 __attribute__((ext_vector_type(4)));
typedef unsigned u32x4 __attribute__((ext_vector_type(4)));
template <class A, class Bt> struct same_t { static constexpr bool v = false; };
template <class A> struct same_t<A, A> { static constexpr bool v = true; };

#define KSWZ(row, colB) ((row) * 256 + ((colB) ^ (((row) & 7) << 4)))
#define SBAR() __builtin_amdgcn_sched_barrier(0)
__device__ __forceinline__ int v_st(int k, int c) { const int kk = (k & ~0xC) | ((k & 4) << 1) | ((k & 8) >> 1); return ((kk >> 3) * 4 + (c >> 5)) * 512 + ((kk & 7) * 32 + (c & 31)) * 2; }
__device__ __forceinline__ int v_rd_base(int lane) { return ((lane & 3) << 3) | (((lane >> 2) & 3) << 6) | (((lane >> 4) & 1) << 5) | (((lane >> 5) & 1) << 8); }
constexpr int v_rd_off(int d0, int ks, int half) { return d0 * 512 + ks * 4096 + half * 2048; }
__device__ __forceinline__ int crow(int r, int hi) { return (r & 3) + 8 * (r >> 2) + 4 * hi; }
__device__ __forceinline__ unsigned cvtpk(float lo, float hi) {
    unsigned r; asm volatile("v_cvt_pk_bf16_f32 %0, %1, %2" : "=v"(r) : "v"(lo), "v"(hi)); return r;
}
__device__ __forceinline__ bf16x8 pack8(f32x4 a, f32x4 b) {
    u32x4 w = {cvtpk(a[0], a[1]), cvtpk(a[2], a[3]), cvtpk(b[0], b[1]), cvtpk(b[2], b[3])};
    return *reinterpret_cast<bf16x8*>(&w);
}
template <class T> __device__ __forceinline__ bf16x8 load8(const T* p) {
    if constexpr (same_t<T, float>::v) { return pack8(*(const f32x4*)p, *(const f32x4*)(p + 4)); }
    else { return *reinterpret_cast<const bf16x8*>(p); }
}
__device__ __forceinline__ void mask_tile(f32x16& p0, f32x16& p1, int dq, unsigned W) {
    const float NEG = -__builtin_inff();
#pragma unroll
    for (int r = 0; r < 16; ++r) {
        const int c = (r & 3) + 8 * (r >> 2);
        if ((unsigned)(dq - c) >= W) p0[r] = NEG;
        if ((unsigned)(dq - c - 32) >= W) p1[r] = NEG;
    }
}
__device__ __forceinline__ void partialSM(f32x16& p0, f32x16& p1, float& m_reg, float& mn, float& alpha) {
    float pmax = p0[0]; for (int r = 1; r < 16; ++r) pmax = fmaxf(pmax, p0[r]); for (int r = 0; r < 16; ++r) pmax = fmaxf(pmax, p1[r]);
    { auto rr = __builtin_amdgcn_permlane32_swap(__float_as_uint(pmax), __float_as_uint(pmax), false, false);
      pmax = fmaxf(__uint_as_float(rr[0]), __uint_as_float(rr[1])); }
    constexpr float C2 = 1.4426950408889634f * SCALE;
    if (__builtin_expect(__all((pmax - m_reg) * SCALE <= THR), 1)) { mn = m_reg; alpha = 1.f; }
    else { mn = fmaxf(m_reg, pmax); alpha = __builtin_amdgcn_exp2f((m_reg - mn) * C2); m_reg = mn; }
    const float mnL = -mn * C2;
    for (int r = 0; r < 16; ++r) p0[r] = fmaf(p0[r], C2, mnL); for (int r = 0; r < 16; ++r) p1[r] = fmaf(p1[r], C2, mnL);
    for (int r = 0; r < 16; ++r) p0[r] = __builtin_amdgcn_exp2f(p0[r]);
}
__device__ __forceinline__ void finishSM(f32x16& p0, f32x16& p1, float alpha, float& l_reg, bf16x8& pa0, bf16x8& pa1, bf16x8& pa2, bf16x8& pa3) {
    for (int r = 0; r < 16; ++r) p1[r] = __builtin_amdgcn_exp2f(p1[r]);
    float ps = 0; for (int r = 0; r < 16; ++r) ps += p0[r]; for (int r = 0; r < 16; ++r) ps += p1[r];
    { auto rr = __builtin_amdgcn_permlane32_swap(__float_as_uint(ps), __float_as_uint(ps), false, false);
      ps = __uint_as_float(rr[0]) + __uint_as_float(rr[1]); }
    l_reg = l_reg * alpha + ps;
#define PK4(P, B_, OUT) do { unsigned a0 = cvtpk(P[B_+0], P[B_+1]), a1 = cvtpk(P[B_+2], P[B_+3]);                          \
        unsigned b0 = cvtpk(P[B_+4], P[B_+5]), b1 = cvtpk(P[B_+6], P[B_+7]);                                             \
        auto r0 = __builtin_amdgcn_permlane32_swap(a0, b0, false, false); auto r1 = __builtin_amdgcn_permlane32_swap(a1, b1, false, false); \
        u32x4 w = {r0[0], r1[0], r0[1], r1[1]}; OUT = *reinterpret_cast<bf16x8*>(&w); } while (0)
    PK4(p0, 0, pa0); PK4(p0, 8, pa1); PK4(p1, 0, pa2); PK4(p1, 8, pa3);
#undef PK4
}
template <int KB, bool SK>
__device__ __forceinline__ void qkt(f32x16& p0, f32x16& p1, const char* K_lds, int r32, int hi, const bf16x8* qr, bool act, const ALAS float* fbp) {
    if (SK && !act) { const float NEG = -__builtin_inff();
#pragma unroll
        for (int r = 0; r < 16; ++r) { p0[r] = NEG; p1[r] = NEG; } return; }
#pragma unroll
    for (int a = 0; a < 4; ++a) { const f32x4 t0 = *(const ALAS f32x4*)(fbp + 8 * a), t1 = *(const ALAS f32x4*)(fbp + 32 + 8 * a);
        p0[4 * a] = t0[0]; p0[4 * a + 1] = t0[1]; p0[4 * a + 2] = t0[2]; p0[4 * a + 3] = t0[3];
        p1[4 * a] = t1[0]; p1[4 * a + 1] = t1[1]; p1[4 * a + 2] = t1[2]; p1[4 * a + 3] = t1[3]; }
    const char* kb[4];
#pragma unroll
    for (int dd = 0; dd < 4; ++dd) kb[dd] = K_lds + KB * SHM_K + KSWZ(r32, (dd * 16 + hi * 8) * 2);
#pragma unroll
    for (int d0 = 0; d0 < 8; ++d0) { const char* a = kb[d0 & 3] + (d0 >> 2) * 128;
        bf16x8 b0 = *reinterpret_cast<const bf16x8*>(a);
        bf16x8 b1 = *reinterpret_cast<const bf16x8*>(a + 32 * 256);
        p0 = __builtin_amdgcn_mfma_f32_32x32x16_bf16(b0, qr[d0], p0, 0, 0, 0);
        p1 = __builtin_amdgcn_mfma_f32_32x32x16_bf16(b1, qr[d0], p1, 0, 0, 0); }
}
template <int VB, bool SK>
__device__ __forceinline__ void pv_tile(f32x16* o, int vb0, bf16x8 pa0, bf16x8 pa1, bf16x8 pa2, bf16x8 pa3, bool act) {
    if (SK && !act) return;
#define TRRD(dst, off) asm volatile("ds_read_b64_tr_b16 %0, %1 offset:%2" : "=&v"(dst) : "v"(vb0), "i"(off) : "memory")
#define PV_D0(d0) do { s16x4 l0, l1, l2, l3, h0, h1, h2, h3; constexpr int b_ = VB * SHM_V + v_rd_off(d0, 0, 0);     \
        TRRD(l0, b_); TRRD(h0, b_ + 2048); TRRD(l1, b_ + 4096); TRRD(h1, b_ + 6144); TRRD(l2, b_ + 8192); TRRD(h2, b_ + 10240); TRRD(l3, b_ + 12288); TRRD(h3, b_ + 14336); \
        asm volatile("s_waitcnt lgkmcnt(0)" ::: "memory"); SBAR();                 \
        o[d0] = __builtin_amdgcn_mfma_f32_32x32x16_bf16(pa0, (bf16x8){l0[0], l0[1], l0[2], l0[3], h0[0], h0[1], h0[2], h0[3]}, o[d0], 0, 0, 0);   \
        o[d0] = __builtin_amdgcn_mfma_f32_32x32x16_bf16(pa1, (bf16x8){l1[0], l1[1], l1[2], l1[3], h1[0], h1[1], h1[2], h1[3]}, o[d0], 0, 0, 0);   \
        o[d0] = __builtin_amdgcn_mfma_f32_32x32x16_bf16(pa2, (bf16x8){l2[0], l2[1], l2[2], l2[3], h2[0], h2[1], h2[2], h2[3]}, o[d0], 0, 0, 0);   \
        o[d0] = __builtin_amdgcn_mfma_f32_32x32x16_bf16(pa3, (bf16x8){l3[0], l3[1], l3[2], l3[3], h3[0], h3[1], h3[2], h3[3]}, o[d0], 0, 0, 0); } while (0)
    PV_D0(0); PV_D0(1); PV_D0(2); PV_D0(3);
#undef PV_D0
#undef TRRD
}

template <class TIn, class TOut> struct BlockRef { const TIn* Q; const TIn* K; const TIn* V; TOut* O; const TIn* G; int P0; int JLO; };
template <class TIn> struct Seam {
    bf16x8 qr[8];
    bf16x8 st_v0, st_v1, st_k0, st_k1; f32x4 sf0, sf1, sf2, sf3;
    f32x4 tq[16];
};
__device__ __forceinline__ int swa_jlo(int P0, int W) { const int lowk = P0 - W + 1; return lowk > 0 ? lowk / KVBLK : 0; }
#define ROW(p, k0, rr) ((p) + (size_t)((k0) + (rr)) * D + sc)
#define ROWV(p, k0, rr) ((p) + (size_t)((k0) + (rr)) * GSTR + sc)
#define VMW() asm volatile("s_waitcnt vmcnt(0)" ::: "memory")
#define VMWN(n) asm volatile("s_waitcnt vmcnt(%0)" :: "i"(n) : "memory")
#define SLOAD_H(Kp, Vp, k0) do { S.st_v0 = load8<TIn>(ROWV(Vp, k0, sr)); S.st_v1 = load8<TIn>(ROWV(Vp, k0, 32 + sr));              \
                         S.st_k0 = load8<TIn>(ROW(Kp, k0, sr)); S.st_k1 = load8<TIn>(ROW(Kp, k0, 32 + sr)); } while (0)
#define SWRITE_HK(bf) do { *(bf16x8*)(K_lds + (bf) * SHM_K + kws) = S.st_k0; *(bf16x8*)(K_lds + (bf) * SHM_K + kws + 32 * 256) = S.st_k1; } while (0)
#define SWRITE_HV(bf) do { *(bf16x8*)(V_lds + (bf) * SHM_V + vst0) = S.st_v0; *(bf16x8*)(V_lds + (bf) * SHM_V + vst1) = S.st_v1; } while (0)
#define SWRITE_H(bf) do { SWRITE_HV(bf); SWRITE_HK(bf); } while (0)
#define SLOAD_F(p, k0) do { S.sf0 = *(const f32x4*)ROW(p, k0, sr); S.sf1 = *(const f32x4*)(ROW(p, k0, sr) + 4);                \
                            S.sf2 = *(const f32x4*)ROW(p, k0, 32 + sr); S.sf3 = *(const f32x4*)(ROW(p, k0, 32 + sr) + 4); } while (0)
#define SWRITE_KF(bf) do { *(bf16x8*)(K_lds + (bf) * SHM_K + kws) = pack8(S.sf0, S.sf1); *(bf16x8*)(K_lds + (bf) * SHM_K + kws + 32 * 256) = pack8(S.sf2, S.sf3); } while (0)
#define SWRITE_VF(bf) do { *(bf16x8*)(V_lds + (bf) * SHM_V + vst0) = pack8(S.sf0, S.sf1); *(bf16x8*)(V_lds + (bf) * SHM_V + vst1) = pack8(S.sf2, S.sf3); } while (0)
template <class TIn, class TOut>
__device__ __forceinline__ void causal_swa_prime(const BlockRef<TIn, TOut>& cur, int W, char* lds, Seam<TIn>& S) {
    constexpr bool F32 = same_t<TIn, float>::v;
    const int tid = tidx(), wid = __builtin_amdgcn_readfirstlane(tid >> 6), lane = tid & 63, r32 = lane & 31, hi = lane >> 5;
    const int sr = tid >> 4, sc = (tid & 15) * 8, kws = KSWZ(sr, sc * 2); char* K_lds = lds + 2 * SHM_V;
    const int kb0 = cur.JLO * KVBLK;
    for (int d0 = 0; d0 < 8; ++d0) S.qr[d0] = load8<TIn>(cur.Q + (size_t)(wid * QBLK + r32) * D + d0 * 16 + hi * 8);
    if constexpr (F32) { SLOAD_F((const float*)cur.K, kb0); VMW(); SWRITE_KF(0); SBAR(); SLOAD_F((const float*)cur.V, kb0); }
    else { SLOAD_H(cur.K, cur.V, kb0); VMW(); SWRITE_HK(0); }
    __syncthreads();
}
template <class TIn, class TOut>
__device__ __forceinline__ void causal_swa_block(const BlockRef<TIn, TOut>& cur, const BlockRef<TIn, TOut>& nxt, int skv, int W, char* lds, Seam<TIn>& S) {
    constexpr bool F32 = same_t<TIn, float>::v;
    const int tid = tidx(), wid = __builtin_amdgcn_readfirstlane(tid >> 6), lane = tid & 63, r32 = lane & 31, hi = lane >> 5;
    const int j_lo = cur.JLO;
    int j_hi = (cur.P0 + QB - 1) / KVBLK + 1; if (j_hi > skv / KVBLK) j_hi = skv / KVBLK;
    const int NT = j_hi - j_lo;
    const int kbn = nxt.JLO * KVBLK;
    const int qlo = cur.P0 + wid * QBLK, qm = qlo + r32 - 4 * hi;
    char* V_lds = lds; char* K_lds = lds + 2 * SHM_V;
    float* ws = (float*)(lds + 2 * SHM_V + 2 * SHM_K) + wid * 64; float* li_l = ws, * al_l = ws + 32;
    float m_reg = -1e30f, l_reg = 0; f32x16 o[4] = {};
    const int sr = tid >> 4, sc = (tid & 15) * 8, vst0 = v_st(sr, sc), vst1 = v_st(32 + sr, sc), kws = KSWZ(sr, sc * 2);
    const int vb0 = (int)(uintptr_t)V_lds + v_rd_base(lane);
    const TIn* Kh = cur.K; const TIn* Vh = cur.V;
#define RESC(a) do { if (__any((a) < 1.f)) { if (hi == 0) al_l[r32] = (a); asm volatile("s_waitcnt lgkmcnt(0)" ::: "memory");              \
                     for (int d_ = 0; d_ < 4; ++d_) for (int r = 0; r < 16; ++r) o[d_][r] *= al_l[crow(r, hi)]; } } while (0)
#define KBASE(t) ((j_lo + (t)) * KVBLK)
    const ALAS float* fb3 = (const ALAS float*)((ALAS char*)lds + FB_OFF) + 4 * hi;
#define FBP(t) (fb3 + KBASE(t))
#define ACT(t) (KBASE(t) <= qlo + QBLK - 1 && KBASE(t) + KVBLK - 1 >= qlo - W + 1)
#define MASKT(P0_, P1_, t) do { const int kb_ = KBASE(t); if ((!SK || ACT(t)) && (kb_ + KVBLK - 1 > qlo || kb_ <= qlo + QBLK - 1 - W)) mask_tile(P0_, P1_, qm - kb_, (unsigned)W); } while (0)
    constexpr int NQL = F32 ? 16 : 8;
    constexpr bool SK = WSKIP && !F32;
#define SEAM_K0() do { VMWN(NQL); if constexpr (F32) { SWRITE_KF(0); SBAR(); SLOAD_F((const float*)nxt.V, kbn); } else { SWRITE_HK(0); } SBAR(); } while (0)
    f32x16 pA0, pA1, pB0, pB1; float mnA, mnB, alA, alB; bf16x8 pa0, pa1, pa2, pa3;
    if constexpr (F32) { VMW(); SWRITE_VF(0); SBAR(); } else { SWRITE_HV(0); SBAR(); }
    if (NT > 1) { if constexpr (F32) SLOAD_F((const float*)Kh, KBASE(1)); else SLOAD_H(Kh, Vh, KBASE(1)); }
    SBAR(); qkt<0, SK>(pA0, pA1, K_lds, r32, hi, S.qr, ACT(0), FBP(0));
    if constexpr (F32) { if (NT > 1) { VMW(); SWRITE_KF(1); SBAR(); SLOAD_F((const float*)Vh, KBASE(1)); } }
    MASKT(pA0, pA1, 0); partialSM(pA0, pA1, m_reg, mnA, alA);
    if (NT > 1) { VMW(); if constexpr (F32) { SWRITE_VF(1); SBAR(); if (NT > 2) SLOAD_F((const float*)Kh, KBASE(2)); } else SWRITE_H(1); }
    __syncthreads();
#define HALF_STEP(PX0, PX1, mnX, alX, PY0, PY1, alY, t, KB, VB, SB) do {                                                      \
        SBAR(); qkt<KB, SK>(PX0, PX1, K_lds, r32, hi, S.qr, ACT(t), FBP(t));                                             \
        finishSM(PY0, PY1, alY, l_reg, pa0, pa1, pa2, pa3); SBAR();                                                           \
        if ((t) + 1 < NT) { if constexpr (F32) { VMW(); SWRITE_KF(SB); SBAR(); SLOAD_F((const float*)Vh, KBASE((t) + 1)); }  \
                            else { SLOAD_H(Kh, Vh, KBASE((t) + 1)); } SBAR(); }                                               \
        pv_tile<VB, SK>(o, vb0, pa0, pa1, pa2, pa3, ACT((t) - 1)); MASKT(PX0, PX1, (t)); partialSM(PX0, PX1, m_reg, mnX, alX);                                        \
        __syncthreads();                                                                                                      \
        if ((t) + 1 < NT) { VMW(); if constexpr (F32) { SWRITE_VF(SB); SBAR(); if ((t) + 2 < NT) SLOAD_F((const float*)Kh, KBASE((t) + 2)); } \
                            else { SWRITE_H(SB); } }                                                                          \
        RESC(alX); __syncthreads(); } while (0)
    for (int t = 1; t + 1 < NT; t += 2) {
        HALF_STEP(pB0, pB1, mnB, alB, pA0, pA1, alA, t, 1, 0, 0);
        HALF_STEP(pA0, pA1, mnA, alA, pB0, pB1, alB, t + 1, 0, 1, 1);
    }
    const bool even = (NT & 1) == 0;
    if (even) { SBAR(); qkt<1, SK>(pB0, pB1, K_lds, r32, hi, S.qr, ACT(NT - 1), FBP(NT - 1)); SBAR(); }
#define QROW(e) (nxt.Q + (size_t)(wid * QBLK + r32) * D + ((e) >> 1) * 16 + hi * 8 + ((e) & 1) * 4)
    if constexpr (F32) { SLOAD_F((const float*)nxt.K, kbn); SBAR();
#pragma unroll
        for (int e = 0; e < 8; ++e) S.tq[e] = *(const f32x4*)QROW(e); }
    else { SLOAD_H(nxt.K, nxt.V, kbn); SBAR();
#pragma unroll
        for (int d0 = 0; d0 < 8; ++d0) S.qr[d0] = load8<TIn>(nxt.Q + (size_t)(wid * QBLK + r32) * D + d0 * 16 + hi * 8); }
    SBAR();
    finishSM(pA0, pA1, alA, l_reg, pa0, pa1, pa2, pa3); SBAR();
    if constexpr (F32) {
#pragma unroll
        for (int e = 8; e < 16; ++e) S.tq[e] = *(const f32x4*)QROW(e); SBAR(); }
#undef QROW
    pv_tile<0, SK>(o, vb0, pa0, pa1, pa2, pa3, ACT(even ? NT - 2 : NT - 1));
    if (even) { MASKT(pB0, pB1, NT - 1); partialSM(pB0, pB1, m_reg, mnB, alB); __syncthreads(); RESC(alB);
        finishSM(pB0, pB1, alB, l_reg, pa0, pa1, pa2, pa3); SBAR(); pv_tile<1, SK>(o, vb0, pa0, pa1, pa2, pa3, ACT(NT - 1)); }
    SBAR(); SEAM_K0();
    if (hi == 0) li_l[r32] = l_reg; asm volatile("s_waitcnt lgkmcnt(0)" ::: "memory");
    float rli[16];
#pragma unroll
    for (int r = 0; r < 16; ++r) rli[r] = __builtin_amdgcn_rcpf(li_l[crow(r, hi)]);
    TOut* Ow = cur.O + (size_t)(wid * QBLK) * OSTR;
#pragma unroll
    for (int r = 0; r < 16; ++r) { const int orow = crow(r, hi);
#pragma unroll
        for (int d0 = 0; d0 < 4; ++d0) {
            const float v = o[d0][r] * rli[r];
            const float vn = __shfl_xor(v, 1);
            if ((r32 & 1) == 0) *(unsigned*)(Ow + (size_t)orow * OSTR + d0 * 32 + r32) = cvtpk(v, vn); } }
    if constexpr (F32) {
#pragma unroll
        for (int d0 = 0; d0 < 8; ++d0) S.qr[d0] = pack8(S.tq[2 * d0], S.tq[2 * d0 + 1]); }
    __syncthreads();
#undef RESC
#undef KBASE
#undef FBP
#undef ACT
#undef MASKT
#undef SEAM_K0
#undef HALF_STEP
}
#undef ROW
#undef ROWV
#undef VMW
#undef VMWN
#undef SLOAD_H
#undef SWRITE_HK
#undef SWRITE_HV
#undef SWRITE_H
#undef SLOAD_F
#undef SWRITE_KF
#undef SWRITE_VF

}

#define LAS __attribute__((address_space(3)))
typedef unsigned short bf16_t;
typedef short bf16x8 __attribute__((ext_vector_type(8)));
typedef short s16x4 __attribute__((ext_vector_type(4)));
typedef float f32x4 __attribute__((ext_vector_type(4)));
typedef unsigned u32x4 __attribute__((ext_vector_type(4)));
typedef unsigned u32x2 __attribute__((ext_vector_type(2)));

constexpr int NB = 2, SEQ = 8192, T = NB * SEQ, DM = 2048, DFF = 5632;
constexpr int NTHR = 512, NWV = 8;
constexpr float EPS = 1e-6f;
constexpr int FOX_N = 8208, FOX_LD = 8448;
constexpr int GDN_ROWS = 12544;

constexpr size_t MiB = 1u << 20;
constexpr size_t WS_MODS = 0, WS_FL = 1 * MiB, WS_FB = 2 * MiB, WS_AB = 3 * MiB, WS_GB = 7 * MiB, WS_TB = 11 * MiB;
constexpr size_t WS_WA = 17 * MiB, WS_WB = 66 * MiB, WS_H = 88 * MiB, WS_Y = 152 * MiB, WS_BIG = 216 * MiB;
constexpr size_t WS_P = WS_BIG, WS_QH = WS_BIG + 264 * MiB, WS_KH = WS_QH + 64 * MiB, WS_VH = WS_KH + 64 * MiB;
constexpr size_t WS_GV = WS_BIG;
constexpr size_t WS_QKV = WS_BIG, WS_QN = WS_BIG + 256 * MiB, WS_KN = WS_QN + 64 * MiB, WS_KT = WS_KN + 64 * MiB, WS_VT = WS_KT + 64 * MiB;
constexpr size_t WS_TM = WS_BIG, WS_QKM = WS_BIG + 64 * MiB, WS_O = WS_BIG + 128 * MiB, WS_Z = WS_QN;
constexpr size_t WS_END = WS_VT + 128 * MiB;
static_assert((size_t)GDN_ROWS * DM * 2 <= WS_WB - WS_WA && (size_t)DM * DFF * 2 <= WS_H - WS_WB, "weight regions");

constexpr int LDS_TOTAL = 147456;

__device__ __forceinline__ float bf2f(unsigned h) { return __uint_as_float(h << 16); }
typedef float f32x2_t __attribute__((ext_vector_type(2))); typedef __bf16 bf16x2_t __attribute__((ext_vector_type(2)));
__device__ __forceinline__ unsigned pk2(float lo, float hi) { const f32x2_t v = {lo, hi}; const bf16x2_t b = __builtin_convertvector(v, bf16x2_t); return __builtin_bit_cast(unsigned, b); }
__device__ __forceinline__ void unpack8(u32x4 w, float* f) {
    f[0] = __uint_as_float(w.x << 16); f[1] = __uint_as_float(w.x & 0xffff0000u); f[2] = __uint_as_float(w.y << 16); f[3] = __uint_as_float(w.y & 0xffff0000u);
    f[4] = __uint_as_float(w.z << 16); f[5] = __uint_as_float(w.z & 0xffff0000u); f[6] = __uint_as_float(w.w << 16); f[7] = __uint_as_float(w.w & 0xffff0000u);
}
__device__ __forceinline__ u32x4 pack8f(const float* f) { u32x4 w; w.x = pk2(f[0], f[1]); w.y = pk2(f[2], f[3]); w.z = pk2(f[4], f[5]); w.w = pk2(f[6], f[7]); return w; }
__device__ __forceinline__ float wave_sum(float v) {
#pragma unroll
    for (int o = 1; o < 64; o <<= 1) v += __shfl_xor(v, o);
    return v;
}
__device__ __forceinline__ float sum16(float v) { v += __shfl_xor(v, 1); v += __shfl_xor(v, 2); v += __shfl_xor(v, 4); v += __shfl_xor(v, 8); return v; }
__device__ __forceinline__ float sigmoidf_(float x) { return 1.f / (1.f + __expf(-x)); }
__device__ __forceinline__ float siluf_(float x) { return x / (1.f + __expf(-x)); }

struct EpiStore {
    static constexpr bool PERM = true, AFTER_DRAIN = false;
    bf16_t* O; int ldc; int ncols; float* aux; int aux_tile, aux_n;
    __device__ __forceinline__ void operator()(const pg8::f32x4 (&acc)[2][2][4][2], const pg8::Unit& u, int wr, int wc, int fr, int fq) const {
        const int row0 = u.pm * 256 + wr * 64 + fr, col0 = u.pn * 256 + wc * 32 + 8 * fq;
#pragma unroll
        for (int ai = 0; ai < 2; ++ai)
#pragma unroll
            for (int m = 0; m < 4; ++m) { const int row = row0 + ai * 128 + m * 16; bf16_t* rowp = O + (size_t)row * ldc + col0;
#pragma unroll
                for (int bj = 0; bj < 2; ++bj) { const pg8::f32x4 v0 = acc[ai][bj][m][0], v1 = acc[ai][bj][m][1];
                    if (col0 + bj * 128 < ncols) { u32x4 w; w.x = pk2(v0[0], v0[1]); w.y = pk2(v0[2], v0[3]); w.z = pk2(v1[0], v1[1]); w.w = pk2(v1[2], v1[3]);
                        *(u32x4*)(rowp + bj * 128) = w; }
                    if (u.pn == aux_tile) { const int ct = wc * 32 + 8 * fq + bj * 128;
                        if (ct < aux_n) { float* ap = aux + (size_t)row * aux_n + ct; *(pg8::f32x4*)ap = v0; *(pg8::f32x4*)(ap + 4) = v1; } } } }
    }
};
__device__ __forceinline__ void run_gemm(LAS unsigned char* lds, const bf16_t* A, int lda, const bf16_t* Bt, int N, int K, bf16_t* O, int ldc, int ncols, float* aux, int aux_tile, int aux_n) {
    pg8::Gemm g{A, Bt, T, N, K, lda}; pg8::StaticOrder S; S.init(T, N, (int)gridDim.x, (int)blockIdx.x);
    EpiStore E{O, ldc, ncols, aux, aux_tile, aux_n};
    pg8::gemm_phase<EpiStore, pg8::StaticOrder, true, true>(lds, g, S, E);
}

__device__ __forceinline__ void convert_weight(LAS unsigned char* lds, const float* W, int K, int N, bf16_t* WT, int seg1, int add1, int seg2, int add2) {
    const int lane = tidx() & 63, wave = tidx() >> 6;
    LAS float* scr = (LAS float*)(lds + wave * 16384);
    const int gw = blockIdx.x * NWV + wave, NGW = gridDim.x * NWV;
    const int nblk = (N + 31) / 32, nitems = (K / 64) * nblk;
    for (int item = gw; item < nitems; item += NGW) {
        const int kb = item / nblk, nb = item % nblk, k0 = 64 * kb, n0 = 32 * nb;
        const int c4 = (lane & 7) * 4, nn = n0 + c4; const bool ok = nn < N;
        f32x4 vld[8];
#pragma unroll
        for (int i = 0; i < 8; ++i) { const int kk = 8 * i + (lane >> 3); vld[i] = ok ? *(const f32x4*)(W + (size_t)(k0 + kk) * N + nn) : (f32x4){0.f, 0.f, 0.f, 0.f}; }
#pragma unroll
        for (int i = 0; i < 8; ++i) { const int kk = 8 * i + (lane >> 3); LAS float* sp = scr + kk * 33 + c4; sp[0] = vld[i][0]; sp[1] = vld[i][1]; sp[2] = vld[i][2]; sp[3] = vld[i][3]; }
        asm volatile("s_waitcnt lgkmcnt(0)" ::: "memory");
        const int c = lane & 7;
#pragma unroll
        for (int j = 0; j < 4; ++j) { const int nl = (lane >> 3) + 8 * j, n = n0 + nl; const LAS float* s = scr + (8 * c) * 33 + nl;
            u32x4 o; o.x = pk2(s[0 * 33], s[1 * 33]); o.y = pk2(s[2 * 33], s[3 * 33]); o.z = pk2(s[4 * 33], s[5 * 33]); o.w = pk2(s[6 * 33], s[7 * 33]);
            if (n < N) { const int row = n + (n >= seg2 ? add2 : (n >= seg1 ? add1 : 0)); *(u32x4*)(WT + (size_t)row * K + k0 + 8 * c) = o; } }
        asm volatile("s_waitcnt lgkmcnt(0)" ::: "memory");
    }
    __syncthreads();
}
constexpr int NOSEG = 0x7fffffff;

__device__ __forceinline__ void mods_phase(LAS unsigned char* lds, const float* c, const float* ada_w, const float* ada_b, float* Mods) {
    const int tid = tidx(), lane = tid & 63, wave = tid >> 6, e4 = lane & 15, ds = lane >> 4;
    LAS float* red = (LAS float*)lds;
    for (int u = blockIdx.x; u < 4 * 96; u += gridDim.x) {
        const int is = u / 96, e0 = (u % 96) * 64;
        f32x4 a0 = {0.f, 0.f, 0.f, 0.f}, a1 = {0.f, 0.f, 0.f, 0.f};
#pragma unroll 8
        for (int it = 0; it < 64; ++it) { const int d = 256 * wave + 4 * it + ds;
            const f32x4 wv = *(const f32x4*)(ada_w + ((size_t)is * DM + d) * (3 * DM) + e0 + 4 * e4);
            const float c0 = siluf_(c[d]), c1 = siluf_(c[DM + d]);
            a0 += wv * c0; a1 += wv * c1; }
#pragma unroll
        for (int k = 0; k < 4; ++k) { a0[k] += __shfl_xor(a0[k], 16); a0[k] += __shfl_xor(a0[k], 32); a1[k] += __shfl_xor(a1[k], 16); a1[k] += __shfl_xor(a1[k], 32); }
        if (lane < 16) {
#pragma unroll
            for (int k = 0; k < 4; ++k) { red[(wave * 2 + 0) * 64 + 4 * e4 + k] = a0[k]; red[(wave * 2 + 1) * 64 + 4 * e4 + k] = a1[k]; } }
        __syncthreads();
        if (tid < 128) { const int b = tid >> 6, e = tid & 63; float s = 0.f;
#pragma unroll
            for (int w = 0; w < 8; ++w) s += red[(w * 2 + b) * 64 + e];
            Mods[((size_t)is * 2 + b) * (3 * DM) + e0 + e] = s + ada_b[(size_t)is * (3 * DM) + e0 + e]; }
        __syncthreads();
    }
}

__device__ __forceinline__ void row_phase(const float* xin, float* xout, const bf16_t* Yb, const float* gate, const float* gpost, bf16_t* Hout, const float* gpre, const float* shift, const float* scale) {
    const int lane = tidx() & 63, wave = __builtin_amdgcn_readfirstlane(tidx() >> 6);
    const int gw = blockIdx.x * NWV + wave, NGW = gridDim.x * NWV;
    for (int row = gw; row < T; row += 2 * NGW) {
        const int row1 = row + NGW; const int b = row >> 13; const size_t mo = (size_t)b * 3 * DM;
        f32x4 x0[8], x1[8];
#pragma unroll
        for (int j = 0; j < 8; ++j) { x0[j] = *(const f32x4*)(xin + (size_t)row * DM + 4 * lane + 256 * j); x1[j] = *(const f32x4*)(xin + (size_t)row1 * DM + 4 * lane + 256 * j); }
        if (Yb) {
            u32x2 w0[8], w1[8]; float s0 = 0.f, s1 = 0.f;
#define UNPK4(w) ((f32x4){__uint_as_float((w).x << 16), __uint_as_float((w).x & 0xffff0000u), __uint_as_float((w).y << 16), __uint_as_float((w).y & 0xffff0000u)})
#pragma unroll
            for (int j = 0; j < 8; ++j) { w0[j] = *(const u32x2*)(Yb + (size_t)row * DM + 4 * lane + 256 * j); w1[j] = *(const u32x2*)(Yb + (size_t)row1 * DM + 4 * lane + 256 * j);
                const f32x4 a = UNPK4(w0[j]), c = UNPK4(w1[j]);
                s0 += (a[0] * a[0] + a[1] * a[1]) + (a[2] * a[2] + a[3] * a[3]); s1 += (c[0] * c[0] + c[1] * c[1]) + (c[2] * c[2] + c[3] * c[3]); }
            const float r0 = rsqrtf(wave_sum(s0) * (1.f / DM) + EPS), r1 = rsqrtf(wave_sum(s1) * (1.f / DM) + EPS);
#pragma unroll
            for (int j = 0; j < 8; ++j) { const int c = 4 * lane + 256 * j; const f32x4 m = *(const f32x4*)(gate + mo + c) * *(const f32x4*)(gpost + c);
                x0[j] += m * (UNPK4(w0[j]) * r0); x1[j] += m * (UNPK4(w1[j]) * r1); }
#undef UNPK4
        }
        if (xout) {
#pragma unroll
            for (int j = 0; j < 8; ++j) { *(f32x4*)(xout + (size_t)row * DM + 4 * lane + 256 * j) = x0[j]; *(f32x4*)(xout + (size_t)row1 * DM + 4 * lane + 256 * j) = x1[j]; }
        }
        if (Hout) {
            float s0 = 0.f, s1 = 0.f;
#pragma unroll
            for (int j = 0; j < 8; ++j) { s0 += (x0[j][0] * x0[j][0] + x0[j][1] * x0[j][1]) + (x0[j][2] * x0[j][2] + x0[j][3] * x0[j][3]);
                s1 += (x1[j][0] * x1[j][0] + x1[j][1] * x1[j][1]) + (x1[j][2] * x1[j][2] + x1[j][3] * x1[j][3]); }
            const float r0 = rsqrtf(wave_sum(s0) * (1.f / DM) + EPS), r1 = rsqrtf(wave_sum(s1) * (1.f / DM) + EPS);
#pragma unroll
            for (int j = 0; j < 8; ++j) { const int c = 4 * lane + 256 * j; const f32x4 a = *(const f32x4*)(gpre + c) * (*(const f32x4*)(scale + mo + c) + 1.f), sh = *(const f32x4*)(shift + mo + c);
                const f32x4 h0 = x0[j] * r0 * a + sh, h1 = x1[j] * r1 * a + sh; u32x2 w0, w1; w0.x = pk2(h0[0], h0[1]); w0.y = pk2(h0[2], h0[3]); w1.x = pk2(h1[0], h1[1]); w1.y = pk2(h1[2], h1[3]);
                *(u32x2*)(Hout + (size_t)row * DM + c) = w0; *(u32x2*)(Hout + (size_t)row1 * DM + c) = w1; }
        }
    }
}

__device__ __forceinline__ void fox_prep(LAS unsigned char* lds, const bf16_t* P, const float* FL, const float* fbias, const float* qg, const float* kg, bf16_t* Qh, bf16_t* Kh, bf16_t* Vh, float* FB) {
    const int lane = tidx() & 63, wave = tidx() >> 6;
    const int gw = blockIdx.x * NWV + wave, NGW = gridDim.x * NWV;
    const int dl = (lane & 15) * 8;
    float gq[8], gk[8];
#pragma unroll
    for (int j = 0; j < 8; ++j) { gq[j] = qg[dl + j]; gk[j] = kg[dl + j]; }
    for (int row = gw; row < T; row += NGW) {
        const int b = row >> 13, s = row & (SEQ - 1);
#pragma unroll
        for (int part = 0; part < 2; ++part) {
#pragma unroll
            for (int p = 0; p < 4; ++p) {
                const int col = p * 512 + lane * 8, h = col >> 7;
                const u32x4 w = *(const u32x4*)(P + (size_t)row * FOX_LD + part * 2048 + col);
                bf16_t* dst = (part == 0 ? Qh : (part == 1 ? Kh : Vh)) + (((size_t)(b * 16 + h) * SEQ + s) * 128 + dl);
                if (part == 2) { *(u32x4*)dst = w; }
                else { float f[8]; unpack8(w, f); float ss = 0.f;
#pragma unroll
                    for (int j = 0; j < 8; ++j) ss += f[j] * f[j];
                    const float r = rsqrtf(sum16(ss) * (1.f / 128.f) + EPS);
#pragma unroll
                    for (int j = 0; j < 8; ++j) f[j] = f[j] * r * (part == 0 ? gq[j] : gk[j]);
                    *(u32x4*)dst = pack8f(f); }
            }
        }
    }
    if (blockIdx.x < 32) {
        LAS float* wtot = (LAS float*)lds;
        const int bh = blockIdx.x, b = bh >> 4, h = bh & 15; const float fb = fbias[h];
        const float* src = FL + ((size_t)b * SEQ + wave * 2048 + lane * 32) * 16 + h;
        float tot = 0.f, incl = 0.f;
        if (wave < 4) {
#pragma unroll 16
            for (int i = 0; i < 32; ++i) { const float x = src[(size_t)i * 16] + fb; tot += (x >= 0.f) ? -log1pf(expf(-x)) : (x - log1pf(expf(x))); }
            incl = tot;
#pragma unroll
            for (int o = 1; o < 64; o <<= 1) { const float t = __shfl_up(incl, o); if (lane >= o) incl += t; }
            if (lane == 63) wtot[wave] = incl;
        }
        __syncthreads();
        if (wave < 4) {
            float run = incl - tot;
            for (int w = 0; w < wave; ++w) run += wtot[w];
            float* dst = FB + (size_t)bh * SEQ + wave * 2048 + lane * 32;
#pragma unroll 16
            for (int i = 0; i < 32; ++i) { const float x = src[(size_t)i * 16] + fb; run += (x >= 0.f) ? -log1pf(expf(-x)) : (x - log1pf(expf(x))); dst[i] = -run * 11.313708498984761f; }
        }
    }
}

__device__ __forceinline__ void fox_attention(char* lds, const bf16_t* Qh, const bf16_t* Kh, const bf16_t* Vh, const bf16_t* P, const float* FB, bf16_t* AO, const float* qg, const float* kg) {
    using abf = att::bf16; typedef att::BlockRef<abf, abf> Ref;
    float thr_t;
    { const int ll = tidx() & 63; float mq = fmaxf(fabsf(qg[ll]), fabsf(qg[64 + ll])), mk = fmaxf(fabsf(kg[ll]), fabsf(kg[64 + ll]));
#pragma unroll
      for (int o = 1; o < 64; o <<= 1) { mq = fmaxf(mq, __shfl_xor(mq, o)); mk = fmaxf(mk, __shfl_xor(mk, o)); }
      thr_t = 2.04f * 128.f * mq * mk + 32.f * 11.313708498984761f; }
    for (int L = blockIdx.x; L < 512; L += gridDim.x) {
        const int bh = L >> 4, x = L & 15, b = bh >> 4, h = bh & 15;
        __syncthreads();
        {
            const f32x4* src = (const f32x4*)(FB + (size_t)bh * SEQ); LAS f32x4* dst = (LAS f32x4*)((LAS char*)lds + att::FB_OFF);
            const int tl = tidx();
#pragma unroll
            for (int i = 0; i < 4; ++i) dst[tl + i * NTHR] = src[tl + i * NTHR];
        }
        Ref r0, r1;
        const int qb0 = x, qb1 = 31 - x;
        __syncthreads();
        int jl[2];
#pragma unroll
        for (int pass = 0; pass < 2; ++pass) { const int P0 = (pass ? qb1 : qb0) * 256; const LAS float* tbl = (const LAS float*)((LAS char*)lds + att::FB_OFF);
            const float ref = tbl[P0]; int lo = 0, hi = P0 >> 6;
            while (lo < hi) { const int mid = (lo + hi + 1) >> 1; if (ref - tbl[64 * mid - 1] > thr_t) lo = mid; else hi = mid - 1; }
            jl[pass] = __builtin_amdgcn_readfirstlane(lo); }
        r0.Q = (const abf*)Qh + ((size_t)bh * SEQ + (size_t)qb0 * 256) * 128; r0.K = (const abf*)Kh + (size_t)bh * SEQ * 128; r0.V = (const abf*)P + (size_t)b * SEQ * FOX_LD + 4096 + h * 128;
        r0.O = (abf*)AO + ((size_t)b * SEQ + (size_t)qb0 * 256) * DM + h * 128; r0.G = nullptr; r0.P0 = qb0 * 256; r0.JLO = jl[0];
        r1 = r0;
        r1.Q = (const abf*)Qh + ((size_t)bh * SEQ + (size_t)qb1 * 256) * 128;
        r1.O = (abf*)AO + ((size_t)b * SEQ + (size_t)qb1 * 256) * DM + h * 128; r1.P0 = qb1 * 256; r1.JLO = jl[1];
        att::Seam<abf> S;
        att::causal_swa_prime<abf, abf>(r0, SEQ, lds, S);
        att::causal_swa_block<abf, abf>(r0, r1, SEQ, SEQ, lds, S);
        att::causal_swa_block<abf, abf>(r1, r1, SEQ, SEQ, lds, S);
        asm volatile("s_waitcnt vmcnt(0)" ::: "memory");
        __syncthreads();
#pragma unroll 1
        for (int pass = 0; pass < 2; ++pass) { const int qb = pass ? qb1 : qb0;
#pragma unroll 2
            for (int i = 0; i < 8; ++i) { const int idx = tidx() + NTHR * i, row = idx >> 4, c8 = idx & 15; const size_t trow = (size_t)b * SEQ + (size_t)qb * 256 + row;
                bf16_t* op = AO + trow * DM + h * 128 + c8 * 8; const bf16_t* gp = P + trow * FOX_LD + 6160 + h * 128 + c8 * 8;
                float o[8], g[8]; unpack8(*(const u32x4*)op, o); unpack8(*(const u32x4*)gp, g);
#pragma unroll
                for (int j = 0; j < 8; ++j) o[j] *= sigmoidf_(g[j]);
                *(u32x4*)op = pack8f(o); } }
    }
    asm volatile("s_waitcnt vmcnt(0)" ::: "memory");
    __syncthreads();
}

__device__ __forceinline__ void glu_phase(bf16_t* GV, const float* cw, const float* cb) {
    constexpr int LD = 2 * DFF, NCG = DFF / 8, RUN = 32, NTASK = (T / RUN) * NCG;
    const int gt = blockIdx.x * NTHR + tidx(), NGT = gridDim.x * NTHR;
    for (int task = gt; task < NTASK; task += NGT) {
        const int run = task / NCG, cgp = task % NCG, col = cgp * 8, t0 = run * RUN;
        float w0[8], w1[8], w2[8], bb[8];
#pragma unroll
        for (int j = 0; j < 8; ++j) { w0[j] = cw[col + j]; w1[j] = cw[DFF + col + j]; w2[j] = cw[2 * DFF + col + j]; bb[j] = cb[col + j]; }
        float h0[8], h1[8];
        if ((t0 & (SEQ - 1)) == 0) {
#pragma unroll
            for (int j = 0; j < 8; ++j) { h0[j] = 0.f; h1[j] = 0.f; }
        } else { unpack8(*(const u32x4*)(GV + (size_t)(t0 - 2) * LD + col), h0); unpack8(*(const u32x4*)(GV + (size_t)(t0 - 1) * LD + col), h1); }
#pragma unroll 4
        for (int i = 0; i < RUN; ++i) {
            bf16_t* rp = GV + (size_t)(t0 + i) * LD + col;
            float g[8], v[8], o[8]; unpack8(*(const u32x4*)rp, g); unpack8(*(const u32x4*)(rp + DFF), v);
#pragma unroll
            for (int j = 0; j < 8; ++j) { const float a = w0[j] * h0[j] + w1[j] * h1[j] + w2[j] * g[j] + bb[j];
                o[j] = 0.5f * a * (1.f + erff(a * 0.70710678118654752f)) * v[j]; h0[j] = h1[j]; h1[j] = g[j]; }
            *(u32x4*)(rp + DFF) = pack8f(o);
        }
    }
}

__device__ __forceinline__ void gdn_prep(const bf16_t* QKV, const float* AB, const float* cw, const float* a_log, const float* dt_bias,
                                         bf16_t* qn, bf16_t* kn, bf16_t* kT, bf16_t* vT, float* Gt, float* Bt) {
    const int gt = blockIdx.x * NTHR + tidx(), NGT = gridDim.x * NTHR;
    for (int i = gt; i < T * 32; i += NGT) { const int t = i >> 5, hv = i & 31;
        const float a = AB[(size_t)t * 64 + hv] + dt_bias[hv], bq = AB[(size_t)t * 64 + 32 + hv];
        const float sp = a > 20.f ? a : log1pf(expf(a));
        Gt[i] = -expf(a_log[hv]) * sp; Bt[i] = 1.f / (1.f + expf(-bq)); }
    for (int task = gt; task < 256 * 1024; task += NGT) {
        const int chunk = task >> 10, cgp = task & 1023, col = cgp * 8, n = chunk & 127, row0 = chunk * 64;
        const int type = col < 2048 ? 0 : (col < 4096 ? 1 : 2);
        float w0[8], w1[8], w2[8], w3[8], h0[8], h1[8], h2[8];
#pragma unroll
        for (int j = 0; j < 8; ++j) { w0[j] = cw[col + j]; w1[j] = cw[8192 + col + j]; w2[j] = cw[2 * 8192 + col + j]; w3[j] = cw[3 * 8192 + col + j]; }
        if (n == 0) {
#pragma unroll
            for (int j = 0; j < 8; ++j) { h0[j] = 0.f; h1[j] = 0.f; h2[j] = 0.f; }
        } else { unpack8(*(const u32x4*)(QKV + (size_t)(row0 - 3) * 8192 + col), h0); unpack8(*(const u32x4*)(QKV + (size_t)(row0 - 2) * 8192 + col), h1); unpack8(*(const u32x4*)(QKV + (size_t)(row0 - 1) * 8192 + col), h2); }
        const float qs = type == 0 ? 0.08838834764831845f : 1.f;
        for (int rb = 0; rb < 8; ++rb) {
            float yv[8][8];
#pragma unroll
            for (int rr = 0; rr < 8; ++rr) {
                const int t = row0 + rb * 8 + rr; float xv[8]; unpack8(*(const u32x4*)(QKV + (size_t)t * 8192 + col), xv);
                float ss = 0.f;
#pragma unroll
                for (int j = 0; j < 8; ++j) { float y = w0[j] * h0[j] + w1[j] * h1[j] + w2[j] * h2[j] + w3[j] * xv[j]; h0[j] = h1[j]; h1[j] = h2[j]; h2[j] = xv[j];
                    y = siluf_(y); yv[rr][j] = y; ss += y * y; }
                if (type < 2) { const float r = rsqrtf(sum16(ss) + EPS) * qs;
#pragma unroll
                    for (int j = 0; j < 8; ++j) yv[rr][j] *= r;
                    *(u32x4*)((type == 0 ? qn : kn) + (size_t)t * 2048 + (col & 2047)) = pack8f(yv[rr]); }
            }
            if (type > 0) {
                const int cc = type == 1 ? col - 2048 : col - 4096, hh = cc >> 7, d0 = cc & 127;
                bf16_t* base = type == 1 ? kT + ((size_t)chunk * 16 + hh) * 8192 + (size_t)(rb * 128 + d0) * 8 : vT + ((size_t)chunk * 32 + hh) * 8192 + (size_t)(rb * 128 + d0) * 8;
#pragma unroll
                for (int j = 0; j < 8; ++j) { u32x4 w; w.x = pk2(yv[0][j], yv[1][j]); w.y = pk2(yv[2][j], yv[3][j]); w.z = pk2(yv[4][j], yv[5][j]); w.w = pk2(yv[6][j], yv[7][j]);
                    *(u32x4*)(base + (size_t)j * 8) = w; }
            }
        }
    }
}

__device__ __forceinline__ void gdn_g1(LAS unsigned char* lds, const bf16_t* qn, const bf16_t* kn, const float* Gt, const float* Bt, bf16_t* Tm, bf16_t* QKm, float* TB) {
    const int tid = tidx(), lane = tid & 63, wid = __builtin_amdgcn_readfirstlane(tid >> 6), r = lane & 15, g = lane >> 4;
    const int grp = wid >> 1, lw = wid & 1;
    LAS float* Am = (LAS float*)(lds + grp * 35840);
    LAS float* gcs = (LAS float*)(lds + grp * 35840 + 34816);
    LAS float* bts = (LAS float*)(lds + grp * 35840 + 35328);
    for (int u0 = blockIdx.x; u0 < 1024; u0 += gridDim.x) {
        const int unit = u0 + grp * 1024;
        const int chunk = unit >> 4, hk = unit & 15, row0 = chunk * 64;
        { const int hv = 2 * hk + lw;
            const float gv = Gt[(size_t)(row0 + lane) * 32 + hv], bv = Bt[(size_t)(row0 + lane) * 32 + hv];
            float sc = gv;
#pragma unroll
            for (int o = 1; o < 64; o <<= 1) { const float t = __shfl_up(sc, o); if (lane >= o) sc += t; }
            const float gl = __shfl(sc, 63);
            gcs[lw * 64 + lane] = sc; bts[lw * 64 + lane] = bv;
            float* tb = TB + ((size_t)chunk * 32 + hv) * 192;
            tb[lane] = bv; tb[64 + lane] = expf(sc); tb[128 + lane] = expf(gl - sc); }
        __syncthreads();
#pragma unroll 1
        for (int nt2 = 0; nt2 < 2; ++nt2) {
            const int nt = 2 * lw + nt2, c = 16 * nt + r;
            bf16x8 kY[4], qY[4];
            const bf16_t* yb = kn + (size_t)(row0 + 16 * nt + r) * 2048 + hk * 128 + 8 * g; const bf16_t* qb = qn + (size_t)(row0 + 16 * nt + r) * 2048 + hk * 128 + 8 * g;
#pragma unroll
            for (int ks = 0; ks < 4; ++ks) { kY[ks] = *(const bf16x8*)(yb + 32 * ks); qY[ks] = *(const bf16x8*)(qb + 32 * ks); }
#pragma unroll
            for (int mt = 0; mt < 4; ++mt) {
                const bf16_t* xb = kn + (size_t)(row0 + 16 * mt + r) * 2048 + hk * 128 + 8 * g;
                f32x4 kk = {0.f, 0.f, 0.f, 0.f}, qk = {0.f, 0.f, 0.f, 0.f};
#pragma unroll
                for (int ks = 0; ks < 4; ++ks) { const bf16x8 X = *(const bf16x8*)(xb + 32 * ks);
                    kk = __builtin_amdgcn_mfma_f32_16x16x32_bf16(X, kY[ks], kk, 0, 0, 0); qk = __builtin_amdgcn_mfma_f32_16x16x32_bf16(X, qY[ks], qk, 0, 0, 0); }
#pragma unroll
                for (int j = 0; j < 2; ++j) { const float gcc = gcs[j * 64 + c], bc = bts[j * 64 + c]; const f32x4 gcp = *(const LAS f32x4*)(gcs + j * 64 + 16 * mt + 4 * g);
                    f32x4 av; float qv[4];
#pragma unroll
                    for (int i = 0; i < 4; ++i) { const int cp = 16 * mt + 4 * g + i; const float e = __expf(fminf(gcc - gcp[i], 0.f));
                        av[i] = (c > cp) ? kk[i] * bc * e : 0.f; qv[i] = (c >= cp) ? qk[i] * e : 0.f; }
                    *(LAS f32x4*)(Am + (j * 64 + c) * 68 + 16 * mt + 4 * g) = av;
                    u32x2 w; w.x = pk2(qv[0], qv[1]); w.y = pk2(qv[2], qv[3]);
                    *(u32x2*)(QKm + (((size_t)chunk * 32 + 2 * hk + j) * 64 + c) * 64 + 16 * mt + 4 * g) = w; }
            }
        }
        __syncthreads();
        {
            const LAS float* A = Am + lw * 64 * 68; float t[64];
#pragma unroll
            for (int i = 0; i < 64; ++i) t[i] = 0.f;
#pragma unroll
            for (int i = 0; i < 64; ++i) { float acc = (lane == i) ? 1.f : 0.f, acc1 = 0.f, acc2 = 0.f, acc3 = 0.f;
#pragma unroll
                for (int jb = 0; jb < (i + 3) / 4; ++jb) { const f32x4 a = *(const LAS f32x4*)(A + i * 68 + 4 * jb);
                    acc -= a[0] * t[4 * jb]; acc1 -= a[1] * t[4 * jb + 1]; acc2 -= a[2] * t[4 * jb + 2]; acc3 -= a[3] * t[4 * jb + 3]; }
                t[i] = (acc + acc1) + (acc2 + acc3); }
            bf16_t* tp = Tm + ((size_t)chunk * 32 + 2 * hk + lw) * 4096 + lane;
#pragma unroll
            for (int i = 0; i < 64; ++i) tp[i * 64] = (bf16_t)(pk2(t[i], 0.f) & 0xffffu);
        }
        __syncthreads();
    }
}

__device__ __forceinline__ s16x4 ldsrd8(const LAS unsigned char* p) { return *(const LAS s16x4*)p; }
__device__ __forceinline__ bf16x8 join8(s16x4 a, s16x4 b) { return (bf16x8){a[0], a[1], a[2], a[3], b[0], b[1], b[2], b[3]}; }
__device__ __forceinline__ bf16x8 packf8(f32x4 a, f32x4 b) { u32x4 w; w.x = pk2(a[0], a[1]); w.y = pk2(a[2], a[3]); w.z = pk2(b[0], b[1]); w.w = pk2(b[2], b[3]); return __builtin_bit_cast(bf16x8, w); }
__device__ __forceinline__ void gdn_g2(LAS unsigned char* lds, const bf16_t* qn, const bf16_t* kn, const bf16_t* kT, const bf16_t* vT, const bf16_t* Tm, const bf16_t* QKm, const float* TB, bf16_t* O) {
    if (blockIdx.x >= 128) return;
    const int tid = tidx(), lane = tid & 63, wid = __builtin_amdgcn_readfirstlane(tid >> 6), r = lane & 15, g = lane >> 4;
    const int b = blockIdx.x >> 6, hv = (blockIdx.x >> 1) & 31, hk = hv >> 1, e0 = (blockIdx.x & 1) * 64 + (wid & 3) * 16;
    constexpr int O_KN = 0, O_QN = 16384, O_KT = 32768, O_TT = 49152, O_QK = 57344, BUFB = 65536, O_TB = 131072;
    int off128[8], off64[4];
#pragma unroll
    for (int q = 0; q < 8; ++q) { const int p = 2 * q + (g >> 1); off128[q] = r * 256 + ((p ^ r) << 4) + 8 * (g & 1); }
#pragma unroll
    for (int q = 0; q < 4; ++q) { const int p = 2 * q + (g >> 1); off64[q] = r * 128 + ((p ^ ((r >> 1) & 7)) << 4) + 8 * (g & 1); }
    f32x4 S[8];
#pragma unroll
    for (int i = 0; i < 8; ++i) S[i] = (f32x4){0.f, 0.f, 0.f, 0.f};
    f32x4 tbreg = {0.f, 0.f, 0.f, 0.f};
#define G2_ISSUE(n_, bf_) do { const int chunk_ = b * 128 + (n_); \
        _Pragma("unroll") for (int i_ = 0; i_ < 8; ++i_) { const int q_ = wid * 64 + lane + 512 * i_; const bf16_t* src_; \
            if (i_ < 4) { const int ql = q_ & 1023, row = ql >> 4, p = (ql & 15) ^ (row & 15); src_ = (i_ < 2 ? kn : qn) + (size_t)(chunk_ * 64 + row) * 2048 + hk * 128 + p * 8; } \
            else if (i_ < 6) { const int ql = q_ - 2048, row = ql >> 3, p = (ql & 7) ^ ((row >> 1) & 7); src_ = kT + ((size_t)chunk_ * 16 + hk) * 8192 + (size_t)(p * 128 + row) * 8; } \
            else { const int ql = q_ - (i_ == 6 ? 3072 : 3584), row = ql >> 3, p = (ql & 7) ^ ((row >> 1) & 7); src_ = (i_ == 6 ? Tm : QKm) + (((size_t)chunk_ * 32 + hv) * 64 + row) * 64 + p * 8; } \
            __builtin_amdgcn_global_load_lds((const unsigned*)src_, (LAS unsigned*)(lds + (bf_) * BUFB + (512 * i_ + wid * 64) * 16), 16, 0, 0); } \
        if (tid < 48) tbreg = *(const f32x4*)(TB + ((size_t)chunk_ * 32 + hv) * 192 + tid * 4); } while (0)
    G2_ISSUE(0, 0);
    if (tid < 48) *(LAS f32x4*)(lds + O_TB + tid * 16) = tbreg;
    for (int n = 0; n < 128; ++n) {
        const int bf = n & 1; const int chunk = b * 128 + n;
        asm volatile("s_waitcnt vmcnt(0)" ::: "memory");
        __syncthreads();
        if (n + 1 < 128) G2_ISSUE(n + 1, bf ^ 1);
        if (wid < 4) {
        f32x4 vv[4];
        { const bf16_t* vp = vT + ((size_t)chunk * 32 + hv) * 8192 + (size_t)((g >> 1) * 128 + e0 + r) * 8 + 4 * (g & 1);
#pragma unroll
          for (int mt = 0; mt < 4; ++mt) { const u32x2 w = *(const u32x2*)(vp + 2048 * mt);
              vv[mt] = (f32x4){__uint_as_float(w.x << 16), __uint_as_float(w.x & 0xffff0000u), __uint_as_float(w.y << 16), __uint_as_float(w.y & 0xffff0000u)}; } }
        const LAS unsigned char* B0 = lds + bf * BUFB;
        const LAS float* tb = (const LAS float*)(lds + O_TB + bf * 768);
        bf16x8 Sb[4];
#pragma unroll
        for (int ks = 0; ks < 4; ++ks) Sb[ks] = packf8(S[2 * ks], S[2 * ks + 1]);
        f32x4 kS[4], qS[4];
#pragma unroll
        for (int mt = 0; mt < 4; ++mt) { kS[mt] = (f32x4){0.f, 0.f, 0.f, 0.f}; qS[mt] = (f32x4){0.f, 0.f, 0.f, 0.f};
#pragma unroll
            for (int ks = 0; ks < 4; ++ks) {
                const bf16x8 xk = join8(ldsrd8(B0 + O_KN + mt * 4096 + off128[2 * ks]), ldsrd8(B0 + O_KN + mt * 4096 + off128[2 * ks + 1]));
                const bf16x8 xq = join8(ldsrd8(B0 + O_QN + mt * 4096 + off128[2 * ks]), ldsrd8(B0 + O_QN + mt * 4096 + off128[2 * ks + 1]));
                kS[mt] = __builtin_amdgcn_mfma_f32_16x16x32_bf16(xk, Sb[ks], kS[mt], 0, 0, 0);
                qS[mt] = __builtin_amdgcn_mfma_f32_16x16x32_bf16(xq, Sb[ks], qS[mt], 0, 0, 0); } }
        f32x4 beta[4], eg[4], ed[4];
#pragma unroll
        for (int mt = 0; mt < 4; ++mt) { beta[mt] = *(const LAS f32x4*)(tb + 16 * mt + 4 * g); eg[mt] = *(const LAS f32x4*)(tb + 64 + 16 * mt + 4 * g); ed[mt] = *(const LAS f32x4*)(tb + 128 + 16 * mt + 4 * g); }
        const float egl = tb[64 + 63];
        f32x4 rr[4];
#pragma unroll
        for (int mt = 0; mt < 4; ++mt) rr[mt] = beta[mt] * (vv[mt] - eg[mt] * kS[mt]);
        bf16x8 rb[2] = {packf8(rr[0], rr[1]), packf8(rr[2], rr[3])};
        f32x4 vn[4];
#pragma unroll
        for (int mt = 0; mt < 4; ++mt) { vn[mt] = (f32x4){0.f, 0.f, 0.f, 0.f};
#pragma unroll
            for (int ks = 0; ks < 2; ++ks) { const bf16x8 xt = join8(ldsrd8(B0 + O_TT + mt * 2048 + off64[2 * ks]), ldsrd8(B0 + O_TT + mt * 2048 + off64[2 * ks + 1]));
                vn[mt] = __builtin_amdgcn_mfma_f32_16x16x32_bf16(xt, rb[ks], vn[mt], 0, 0, 0); } }
        bf16x8 vnb[2] = {packf8(vn[0], vn[1]), packf8(vn[2], vn[3])};
        f32x4 o[4];
#pragma unroll
        for (int mt = 0; mt < 4; ++mt) { o[mt] = eg[mt] * qS[mt];
#pragma unroll
            for (int ks = 0; ks < 2; ++ks) { const bf16x8 xq = join8(ldsrd8(B0 + O_QK + mt * 2048 + off64[2 * ks]), ldsrd8(B0 + O_QK + mt * 2048 + off64[2 * ks + 1]));
                o[mt] = __builtin_amdgcn_mfma_f32_16x16x32_bf16(xq, vnb[ks], o[mt], 0, 0, 0); } }
        bf16x8 vdb[2] = {packf8(vn[0] * ed[0], vn[1] * ed[1]), packf8(vn[2] * ed[2], vn[3] * ed[3])};
#pragma unroll
        for (int dt = 0; dt < 8; ++dt) { S[dt] = S[dt] * egl;
#pragma unroll
            for (int ks = 0; ks < 2; ++ks) { const bf16x8 xk = join8(ldsrd8(B0 + O_KT + dt * 2048 + off64[2 * ks]), ldsrd8(B0 + O_KT + dt * 2048 + off64[2 * ks + 1]));
                S[dt] = __builtin_amdgcn_mfma_f32_16x16x32_bf16(xk, vdb[ks], S[dt], 0, 0, 0); } }
        { bf16_t* op = O + (size_t)(chunk * 64 + 4 * g) * 4096 + hv * 128 + e0 + r;
#pragma unroll
          for (int mt = 0; mt < 4; ++mt)
#pragma unroll
              for (int i = 0; i < 4; ++i) op[(size_t)(16 * mt + i) * 4096] = (bf16_t)(pk2(o[mt][i], 0.f) & 0xffffu); }
        }
        if (n + 1 < 128 && tid < 48) *(LAS f32x4*)(lds + O_TB + (bf ^ 1) * 768 + tid * 16) = tbreg;
    }
#undef G2_ISSUE
    asm volatile("s_waitcnt vmcnt(0)" ::: "memory");
    __syncthreads();
}

__device__ __forceinline__ void gdn_g3(bf16_t* O, const bf16_t* Z, const float* gn) {
    const int gt = blockIdx.x * NTHR + tidx(), NGT = gridDim.x * NTHR;
    const int dl = (tidx() & 15) * 8; float gv[8];
#pragma unroll
    for (int j = 0; j < 8; ++j) gv[j] = gn[dl + j];
#pragma unroll 4
    for (int idx = gt; idx < T * 512; idx += NGT) {
        float o[8], z[8]; unpack8(*(const u32x4*)(O + (size_t)idx * 8), o); unpack8(*(const u32x4*)(Z + (size_t)idx * 8), z);
        float ss = 0.f;
#pragma unroll
        for (int j = 0; j < 8; ++j) ss += o[j] * o[j];
        const float rn = rsqrtf(sum16(ss) * (1.f / 128.f) + EPS);
#pragma unroll
        for (int j = 0; j < 8; ++j) o[j] = o[j] * rn * gv[j] * siluf_(z[j]);
        *(u32x4*)(O + (size_t)idx * 8) = pack8f(o);
    }
}

#define XB_TMO      128
#define XB_XCNT(j)  (256  + 64 * (j))
#define XB_XSUB(j)  (1280 + 64 * (j))
#define XB_XGEN(j)  (2304 + 64 * (j))
#define XB_TOP      3328
#define XB_TOPGEN   3392
#define XCD_BAR_WORDS 3456
#define XB_SPIN_CAP (1u << 18)

__device__ __forceinline__ unsigned xb_ld(unsigned* p)              { return __hip_atomic_load(p, __ATOMIC_RELAXED, __HIP_MEMORY_SCOPE_AGENT); }
__device__ __forceinline__ unsigned xb_add(unsigned* p, unsigned v) { return __hip_atomic_fetch_add(p, v, __ATOMIC_RELAXED, __HIP_MEMORY_SCOPE_AGENT); }
__device__ __forceinline__ unsigned xb_xcc_id() { return (unsigned)__builtin_amdgcn_s_getreg((3 << 11) | 20) & 0xFu; }
#define XB_SPIN(cond, bar) do { unsigned _sp = 0; while (cond) { __builtin_amdgcn_s_sleep(1); \
    if ((++_sp & 255u) == 0u) { if (xb_ld(&(bar)[XB_TMO])) break; if (_sp > XB_SPIN_CAP) { atomicAdd(&(bar)[XB_TMO], 1u); break; } } } } while (0)

struct XcdBarrier {
    unsigned* bar; unsigned x;
    volatile LAS unsigned* st;
};

__device__ __forceinline__ XcdBarrier xcd_barrier_post(unsigned* bar, volatile LAS unsigned* st) {
    XcdBarrier b; b.bar = bar; b.x = xb_xcc_id(); b.st = st;
    if (threadIdx.x == 0) (void)xb_add(&bar[XB_XCNT(b.x)], 1u);
    return b;
}
__device__ __forceinline__ void xcd_barrier_complete(unsigned* bar, unsigned x, unsigned& nloc, unsigned& nx) {
    const unsigned G = gridDim.x * gridDim.y * gridDim.z;
    unsigned sum, cnt, mine, sp = 0u;
    for (;;) {
        sum = 0u; cnt = 0u; mine = 0u;
#pragma unroll
        for (unsigned j = 0; j < 16; ++j) { const unsigned c = xb_ld(&bar[XB_XCNT(j)]); sum += c; cnt += (c > 0u) ? 1u : 0u; mine = (j == x) ? c : mine; }
        if (sum == G) break;
        __builtin_amdgcn_s_sleep(1);
        if ((++sp & 255u) == 0u) { if (xb_ld(&bar[XB_TMO])) break; if (sp > XB_SPIN_CAP) { atomicAdd(&bar[XB_TMO], 1u); break; } }
    }
    nloc = mine > 0u ? mine : 1u; nx = cnt > 0u ? cnt : 1u;
}

__device__ __forceinline__ void xcd_barrier(const XcdBarrier& b) {
    asm volatile("s_waitcnt vmcnt(0)" ::: "memory");
    __syncthreads();
    if (threadIdx.x == 0) {
        unsigned* bar = b.bar;
        __builtin_amdgcn_s_waitcnt(0);
        unsigned nloc = b.st[0], nx = b.st[1];
        if (nloc == 0u) { xcd_barrier_complete(bar, b.x, nloc, nx); b.st[0] = nloc; b.st[1] = nx; }
        const unsigned old = xb_add(&bar[XB_XSUB(b.x)], 1u);
        const unsigned gen = old / nloc;
        if (old + 1u == (gen + 1u) * nloc) {
            __builtin_amdgcn_fence(__ATOMIC_RELEASE, "agent");
            asm volatile("s_waitcnt vmcnt(0)" ::: "memory");
            const unsigned og = xb_add(&bar[XB_TOP], 1u);
            const unsigned tg = og / nx;
            if (og + 1u == (tg + 1u) * nx) xb_add(&bar[XB_TOPGEN], 1u);
            else XB_SPIN(xb_ld(&bar[XB_TOPGEN]) == tg, bar);
            __builtin_amdgcn_fence(__ATOMIC_ACQUIRE, "agent");
            xb_add(&bar[XB_XGEN(b.x)], 1u);
            asm volatile("s_waitcnt vmcnt(0)" ::: "memory");
        } else {
            XB_SPIN(xb_ld(&bar[XB_XGEN(b.x)]) == gen, bar);
            __builtin_amdgcn_fence(__ATOMIC_ACQUIRE, "agent");
            asm volatile("s_waitcnt vmcnt(0)" ::: "memory");
        }
    }
    __syncthreads();
}

constexpr size_t WS_BAR = 256 * 1024;
struct Args { const float* in[20]; float* out; unsigned char* ws; int ph_lo, ph_hi; };
constexpr int NPHASE = 23;
#ifndef ONLY_PH
#define ONLY_PH -1
#endif
#define EN(k) (ONLY_PH < 0 || ONLY_PH == (k))
#ifndef MK_COOP
#define MK_COOP 1
#endif

__global__ void __launch_bounds__(NTHR) fwd_megakernel(Args a) {
    extern __shared__ __attribute__((aligned(16))) unsigned char lds_raw[];
    LAS unsigned char* lds = (LAS unsigned char*)lds_raw;
    unsigned char* ws = a.ws;
    const float* x = a.in[0]; const float* cvec = a.in[1]; const float* ada_w = a.in[2]; const float* ada_b = a.in[3]; const float* norm_g = a.in[4];
    float* Mods = (float*)(ws + WS_MODS); float* FL = (float*)(ws + WS_FL); float* FB = (float*)(ws + WS_FB); float* AB = (float*)(ws + WS_AB);
    float* Gt = (float*)(ws + WS_GB); float* Btb = Gt + (size_t)T * 32; float* TB = (float*)(ws + WS_TB);
    bf16_t* WA = (bf16_t*)(ws + WS_WA); bf16_t* WB = (bf16_t*)(ws + WS_WB); bf16_t* Hb = (bf16_t*)(ws + WS_H); bf16_t* Yb = (bf16_t*)(ws + WS_Y);
    bf16_t* Pb = (bf16_t*)(ws + WS_P); bf16_t* Qh = (bf16_t*)(ws + WS_QH); bf16_t* Kh = (bf16_t*)(ws + WS_KH); bf16_t* Vh = (bf16_t*)(ws + WS_VH);
    bf16_t* GV = (bf16_t*)(ws + WS_GV); bf16_t* QKV = (bf16_t*)(ws + WS_QKV); bf16_t* qn = (bf16_t*)(ws + WS_QN); bf16_t* kn = (bf16_t*)(ws + WS_KN);
    bf16_t* kT = (bf16_t*)(ws + WS_KT); bf16_t* vT = (bf16_t*)(ws + WS_VT); bf16_t* Tm = (bf16_t*)(ws + WS_TM); bf16_t* QKm = (bf16_t*)(ws + WS_QKM);
    bf16_t* Ob = (bf16_t*)(ws + WS_O); bf16_t* Zb = (bf16_t*)(ws + WS_Z);
#define mods(layer, sub) (Mods + (size_t)((layer) * 2 + (sub)) * 2 * 3 * DM)
#define ng(layer, k) (norm_g + (size_t)((layer) * 4 + (k)) * DM)
    const int lo = a.ph_lo, hi = a.ph_hi;
    volatile LAS unsigned* xst = (volatile LAS unsigned*)(lds + LDS_TOTAL - 64);
    if (tidx() < 2) xst[tidx()] = 0u;
    __syncthreads();
    XcdBarrier xbar = xcd_barrier_post((unsigned*)(ws + WS_BAR), xst);
    if (__builtin_amdgcn_readfirstlane(tidx() >> 6) == 0) { __threadfence(); asm volatile("s_waitcnt vmcnt(0)" ::: "memory"); } __syncthreads();
#define IN(k) (lo <= (k) && (k) < hi && EN(k))
#define SEAM(k) do { if (lo <= (k) && (k) + 1 < hi) { if ((k) == 0) { asm volatile("s_waitcnt vmcnt(0) lgkmcnt(0)" ::: "memory"); __syncthreads(); cg::this_grid().sync(); if (__builtin_amdgcn_readfirstlane(tidx() >> 6) == 0) { __builtin_amdgcn_fence(__ATOMIC_ACQUIRE, "agent"); asm volatile("s_waitcnt vmcnt(0)" ::: "memory"); } __syncthreads(); } else { xcd_barrier(xbar); } } } while (0)
#define CONV(W_, K_, N_, T_, s1, a1, s2, a2) do { __syncthreads(); convert_weight(lds, W_, K_, N_, T_, s1, a1, s2, a2); } while (0)
#define ROWP(xin_, first_, last_, gl, gs, gk, hl, hs, hk) row_phase(xin_, (first_) ? nullptr : a.out, (first_) ? nullptr : Yb, mods(gl, gs) + 2 * DM, ng(gl, gk), (last_) ? nullptr : Hb, ng(hl, hk), mods(hl, hs), mods(hl, hs) + DM)
    if (IN(0)) { mods_phase(lds, cvec, ada_w, ada_b, Mods); CONV(a.in[5], DM, FOX_N, WA, NOSEG, 0, NOSEG, 0); } SEAM(0);
    if (IN(1)) { ROWP(x, true, false, 0, 0, 0, 0, 0, 0); CONV(a.in[9], DM, DM, WB, NOSEG, 0, NOSEG, 0); } SEAM(1);
    if (IN(2)) { run_gemm(lds, Hb, DM, WA, FOX_LD, DM, Pb, FOX_LD, FOX_N, FL, 24, 16); } SEAM(2);
    if (IN(3)) { fox_prep(lds, Pb, FL, a.in[6], a.in[7], a.in[8], Qh, Kh, Vh, FB); CONV(a.in[16], DM, 2 * DFF, WA, NOSEG, 0, NOSEG, 0); } SEAM(3);
    if (IN(4)) { fox_attention((char*)lds_raw, Qh, Kh, Vh, Pb, FB, Hb, a.in[7], a.in[8]); } SEAM(4);
    if (IN(5)) { run_gemm(lds, Hb, DM, WB, DM, DM, Yb, DM, DM, nullptr, -1, 0); } SEAM(5);
    if (IN(6)) { ROWP(x, false, false, 0, 0, 1, 0, 1, 2); CONV(a.in[19], DFF, DM, WB, NOSEG, 0, NOSEG, 0); } SEAM(6);
    if (IN(7)) { run_gemm(lds, Hb, DM, WA, 2 * DFF, DM, GV, 2 * DFF, 2 * DFF, nullptr, -1, 0); } SEAM(7);
    if (IN(8)) { glu_phase(GV, a.in[17], a.in[18]); CONV(a.in[10], DM, 12352, WA, 8192, 256, 12288, -4096); } SEAM(8);
    if (IN(9)) { run_gemm(lds, GV + DFF, 2 * DFF, WB, DM, DFF, Yb, DM, DM, nullptr, -1, 0); } SEAM(9);
    if (IN(10)) { ROWP(a.out, false, false, 0, 1, 3, 1, 0, 0); CONV(a.in[15], 2 * DM, DM, WB, NOSEG, 0, NOSEG, 0); } SEAM(10);
    if (IN(11)) { run_gemm(lds, Hb, DM, WA, 8448, DM, QKV, 8192, 8192, AB, 32, 64); } SEAM(11);
    if (IN(12)) { gdn_prep(QKV, AB, a.in[11], a.in[12], a.in[13], qn, kn, kT, vT, Gt, Btb); } SEAM(12);
    if (IN(13)) { gdn_g1(lds, qn, kn, Gt, Btb, Tm, QKm, TB); } SEAM(13);
    if (IN(14)) { gdn_g2(lds, qn, kn, kT, vT, Tm, QKm, TB, Ob); } SEAM(14);
    if (IN(15)) { run_gemm(lds, Hb, DM, WA + (size_t)8448 * DM, 2 * DM, DM, Zb, 2 * DM, 2 * DM, nullptr, -1, 0); } SEAM(15);
    if (IN(16)) { gdn_g3(Ob, Zb, a.in[14]); CONV(a.in[16] + (size_t)DM * 2 * DFF, DM, 2 * DFF, WA, NOSEG, 0, NOSEG, 0); } SEAM(16);
    if (IN(17)) { run_gemm(lds, Ob, 2 * DM, WB, DM, 2 * DM, Yb, DM, DM, nullptr, -1, 0); } SEAM(17);
    if (IN(18)) { ROWP(a.out, false, false, 1, 0, 1, 1, 1, 2); CONV(a.in[19] + (size_t)DFF * DM, DFF, DM, WB, NOSEG, 0, NOSEG, 0); } SEAM(18);
    if (IN(19)) { run_gemm(lds, Hb, DM, WA, 2 * DFF, DM, GV, 2 * DFF, 2 * DFF, nullptr, -1, 0); } SEAM(19);
    if (IN(20)) { glu_phase(GV, a.in[17] + 3 * DFF, a.in[18] + DFF); } SEAM(20);
    if (IN(21)) { run_gemm(lds, GV + DFF, 2 * DFF, WB, DM, DFF, Yb, DM, DM, nullptr, -1, 0); } SEAM(21);
    if (IN(22)) { ROWP(a.out, false, true, 1, 1, 3, 0, 0, 0); }
    asm volatile("s_waitcnt vmcnt(0) lgkmcnt(0)" ::: "memory"); __syncthreads(); if (__builtin_amdgcn_readfirstlane(tidx() >> 6) == 0) { __threadfence(); asm volatile("s_waitcnt vmcnt(0)" ::: "memory"); }
#ifdef EXP_ROWS
    __syncthreads(); if (blockIdx.x == 0) { for (int i = tidx(); i < DM; i += NTHR) { a.out[i] = x[i]; a.out[(size_t)SEQ * DM + i] = x[(size_t)SEQ * DM + i]; } }
#endif
}

extern "C" void kernel_launch(void* const* d_in, const int* in_sizes, int n_in, void* d_out, int out_size, void* d_ws, size_t ws_size, hipStream_t stream) {
    static int grid = 0;
    if (grid == 0) {
        if (n_in != 20 || ws_size < WS_END) { fprintf(stderr, "kernel_launch: need 20 inputs and >= %zu B workspace (got %d, %zu)\n", (size_t)WS_END, n_in, ws_size); grid = -1; return; }
        int dev = 0, cus = 0, per_cu = 0;
        (void)hipGetDevice(&dev); (void)hipDeviceGetAttribute(&cus, hipDeviceAttributeMultiprocessorCount, dev);
        if (hipFuncSetAttribute((const void*)fwd_megakernel, hipFuncAttributeMaxDynamicSharedMemorySize, LDS_TOTAL) != hipSuccess) fprintf(stderr, "kernel_launch: hipFuncSetAttribute failed\n");
        if (hipOccupancyMaxActiveBlocksPerMultiprocessor(&per_cu, (const void*)fwd_megakernel, NTHR, LDS_TOTAL) != hipSuccess || per_cu < 1) { fprintf(stderr, "kernel_launch: occupancy query gave %d\n", per_cu); per_cu = 1; }
        (void)hipGetLastError();
        grid = cus > 0 ? cus : 256;
    }
    if (grid < 0) return;
    Args a{};
    for (int i = 0; i < 20; ++i) a.in[i] = (const float*)d_in[i];
    a.out = (float*)d_out; a.ws = (unsigned char*)d_ws;
    (void)hipMemsetAsync((char*)d_ws + WS_BAR, 0, 16384, stream);
#if MK_COOP
    a.ph_lo = 0; a.ph_hi = NPHASE;
    void* args[] = {&a};
    hipError_t e = hipLaunchCooperativeKernel((const void*)fwd_megakernel, dim3(grid), dim3(NTHR), args, LDS_TOTAL, stream);
    if (e != hipSuccess) fprintf(stderr, "cooperative launch failed: %s (grid %d)\n", hipGetErrorString(e), grid);
#else
    for (int ph = 0; ph < NPHASE; ++ph) { a.ph_lo = ph; a.ph_hi = ph + 1; hipLaunchKernelGGL(fwd_megakernel, dim3(grid), dim3(NTHR), LDS_TOTAL, stream, a); }
#endif
}
```

```cpp
#include <hip/hip_runtime.h>
#include <hip/hip_cooperative_groups.h>
#include <hip/hip_bf16.h>
#include <cstdio>
#include <cstdint>
#include <cmath>
namespace cg = cooperative_groups;
__device__ __forceinline__ int tidx() { int t = (int)__builtin_amdgcn_workitem_id_x(); asm volatile("" : "+v"(t)); return t; }
namespace pg8 {
#define PG8_LAS __attribute__((address_space(3)))
typedef unsigned short bf16_t;
typedef short bf16x8 __attribute__((ext_vector_type(8)));
typedef float f32x4 __attribute__((ext_vector_type(4)));
typedef unsigned u32x4 __attribute__((ext_vector_type(4)));
constexpr int BM = 256, BK = 64, HALF = 128, HTB = HALF * BK * 2  , STAGE_BYTES = 8 * HTB, NXCD = 8, WGM = 8;

__host__ __device__ __forceinline__ int lds_byte(int r, int c) { const int st = (r >> 4) * 2 + (c >> 5), rr = r & 15, cc = c & 31, ob = rr * 64 + cc * 2; return st * 1024 + (ob ^ (((ob >> 9) & 1) << 5)); }
__host__ __device__ __forceinline__ void stage_rc(int b, int& R, int& C) { const int st = b / 1024, sb = b % 1024, swz = sb ^ (((sb >> 9) & 1) << 5); R = (st >> 1) * 16 + swz / 64; C = (st & 1) * 32 + (swz % 64) / 2; }
__host__ __device__ __forceinline__ int perm32(int rho) { const int n = rho >> 4, i = rho & 15; return 8 * (i >> 2) + 4 * n + (i & 3); }

struct Unit { int pm, pn; };
struct Gemm { const bf16_t* A; const bf16_t* Bt; int M, N, K, lda; };

struct StaticOrder {
    int nM, nN, nwg, G, c;
    __host__ __device__ void init(int M, int N, int G_, int c_) { nM = M / BM; nN = N / BM; nwg = nM * nN; G = G_; c = c_; }
    __host__ __device__ bool next(int i, Unit& u) const {
        const long L = (long)i * G + c; if (L >= nwg) return false;
        int wgid = (int)L; { const int q = nwg / NXCD, r = nwg % NXCD, xcd = wgid % NXCD, off = wgid / NXCD; wgid = (xcd < r ? xcd * (q + 1) : r * (q + 1) + (xcd - r) * q) + off; }
        const int nig = WGM * nN, gid = wgid / nig, fm = gid * WGM, gsz = (nM - fm) < WGM ? (nM - fm) : WGM;
        u.pm = fm + ((wgid % nig) % gsz); u.pn = (wgid % nig) / gsz; return true;
    }
    __device__ __forceinline__ void a_ready(const Unit&) const {}
    __device__ __forceinline__ void done(const Unit&) const {}
};

__device__ __forceinline__ unsigned cvt_pk_bf16(float lo, float hi) { unsigned r; asm volatile("v_cvt_pk_bf16_f32 %0, %1, %2" : "=v"(r) : "v"(lo), "v"(hi)); return r; }
template <class Epi, class Sched, bool ALIGN_EPI = false, bool SP2 = false>
__device__ __forceinline__ void gemm_phase(PG8_LAS unsigned char* lds, const Gemm g, const Sched& S, const Epi& E) {
    const int tid = tidx(), wid = __builtin_amdgcn_readfirstlane(tid >> 6), lane = tid & 63, wr = wid >> 2, wc = wid & 3, fr = lane & 15, fq = lane >> 4;
    const int K = g.K, nt = K / BK;
    unsigned voffA[2], voffB[2];
#pragma unroll
    for (int i = 0; i < 2; ++i) { int R, C; stage_rc(tid * 16 + i * 8192, R, C); const int Rb = Epi::PERM ? ((R & ~31) + perm32(R & 31)) : R;
        voffA[i] = (unsigned)(R * g.lda + C) * 2u; voffB[i] = (unsigned)(Rb * K + C) * 2u; }
    const size_t kstep = (size_t)(BK * 2);
    const size_t hstep = (size_t)HALF * K * 2;
    const size_t tstep = 2 * hstep; const size_t hstepA = (size_t)HALF * g.lda * 2, tstepA = 2 * hstepA;
    const unsigned ldsw = (unsigned)wid * 1024u;
    const int aoff = lds_byte(wr * 64 + fr, fq * 8), boff = lds_byte(wc * 32 + fr, fq * 8);
#define PG8_SA(b, h) (((b) * 2 + (h)) * HTB)
#define PG8_SB(b, h) ((4 + (b) * 2 + (h)) * HTB)
#define PG8_STAGE(bufoff, gbase, voff) do { _Pragma("unroll") for (int _i = 0; _i < 2; ++_i) \
        __builtin_amdgcn_global_load_lds((const unsigned*)((const char*)(gbase) + (voff)[_i]), (PG8_LAS unsigned*)(lds + (bufoff) + ldsw + _i * 8192), 16, 0, 0); } while (0)
#define PG8_LDA(dst, b, h) do { _Pragma("unroll") for (int m = 0; m < 4; ++m) _Pragma("unroll") for (int k = 0; k < 2; ++k) dst[m][k] = *(const PG8_LAS bf16x8*)(lds + PG8_SA(b, h) + aoff + m * 2048 + k * 1024); } while (0)
#define PG8_LDB(dst, b, h) do { _Pragma("unroll") for (int n = 0; n < 2; ++n) _Pragma("unroll") for (int k = 0; k < 2; ++k) dst[n][k] = *(const PG8_LAS bf16x8*)(lds + PG8_SB(b, h) + boff + n * 2048 + k * 1024); } while (0)
#define PG8_MMA(ai, bj, At, Bt) do { __builtin_amdgcn_s_setprio(1); _Pragma("unroll") for (int m = 0; m < 4; ++m) _Pragma("unroll") for (int n = 0; n < 2; ++n) _Pragma("unroll") for (int k = 0; k < 2; ++k) \
        acc[ai][bj][m][n] = __builtin_amdgcn_mfma_f32_16x16x32_bf16(Bt[n][k], At[m][k], acc[ai][bj][m][n], 0, 0, 0); __builtin_amdgcn_s_setprio(0); } while (0)
#define PG8_WAIT_V(n) asm volatile("s_waitcnt vmcnt(" #n ")" ::: "memory")
#define PG8_WAIT_L(n) asm volatile("s_waitcnt lgkmcnt(" #n ")" ::: "memory")
#define PG8_BAR __builtin_amdgcn_s_barrier()
#define PG8_SCHED __builtin_amdgcn_sched_barrier(0)
    Unit cur, nxt; int ui = 0;
    if (!S.next(0, cur)) return;
    f32x4 acc[2][2][4][2];
#pragma unroll
    for (int a = 0; a < 2; ++a)
#pragma unroll
        for (int b = 0; b < 2; ++b)
#pragma unroll
            for (int m = 0; m < 4; ++m)
#pragma unroll
                for (int n = 0; n < 2; ++n) acc[a][b][m][n] = (f32x4){0.f, 0.f, 0.f, 0.f};
    bf16x8 At[4][2], B0[2][2], B1[2][2];
    const char* cA = (const char*)g.A + (size_t)cur.pm * tstepA; const char* cB = (const char*)g.Bt + (size_t)cur.pn * tstep;
    S.a_ready(cur);
    if constexpr (SP2) {
        PG8_STAGE(PG8_SB(0, 0), cB, voffB); PG8_STAGE(PG8_SB(0, 1), cB + hstep, voffB); PG8_STAGE(PG8_SA(0, 0), cA, voffA); PG8_STAGE(PG8_SA(0, 1), cA + hstepA, voffA);
        if (wr == 1) PG8_BAR;
        PG8_WAIT_V(2); PG8_BAR;
        PG8_STAGE(PG8_SB(1, 0), cB + kstep, voffB); PG8_STAGE(PG8_SA(1, 0), cA + kstep, voffA); PG8_STAGE(PG8_SB(1, 1), cB + hstep + kstep, voffB);
        PG8_WAIT_V(6); PG8_BAR;
    } else {
        PG8_STAGE(PG8_SB(0, 0), cB, voffB); PG8_STAGE(PG8_SA(0, 0), cA, voffA); PG8_STAGE(PG8_SB(0, 1), cB + hstep, voffB); PG8_STAGE(PG8_SA(0, 1), cA + hstepA, voffA);
        if (wr == 1) PG8_BAR;
        PG8_WAIT_V(4); PG8_BAR;
        PG8_STAGE(PG8_SB(1, 0), cB + kstep, voffB); PG8_STAGE(PG8_SA(1, 0), cA + kstep, voffA); PG8_STAGE(PG8_SB(1, 1), cB + hstep + kstep, voffB);
        PG8_WAIT_V(6); PG8_BAR;
    }
    for (;;) {
        const bool has_next = S.next(ui + 1, nxt);
        const char* nA = has_next ? (const char*)g.A + (size_t)nxt.pm * tstepA : cA; const char* nB = has_next ? (const char*)g.Bt + (size_t)nxt.pn * tstep : cB;
        for (int t = 0; t < nt; t += 2) {
            const bool last = (t == nt - 2);
            const char* a1 = cA + (size_t)(t + 1) * kstep;
            const char* a2 = last ? nA : cA + (size_t)(t + 2) * kstep; const char* b2 = last ? nB : cB + (size_t)(t + 2) * kstep;
            const char* a3 = a2 + kstep; const char* b3 = b2 + kstep;
            if (last && has_next) S.a_ready(nxt);
            if constexpr (SP2) {
            PG8_LDB(B0, 0, 0); PG8_LDB(B1, 0, 1); PG8_SCHED; PG8_LDA(At, 0, 0); PG8_STAGE(PG8_SA(1, 1), a1 + hstepA, voffA);
            PG8_WAIT_V(8); PG8_WAIT_L(0); PG8_BAR; PG8_MMA(0, 0, At, B0); PG8_MMA(0, 1, At, B1); PG8_BAR; PG8_SCHED;
            PG8_LDA(At, 0, 1); PG8_STAGE(PG8_SB(0, 0), b2, voffB); PG8_STAGE(PG8_SB(0, 1), b2 + hstep, voffB); PG8_STAGE(PG8_SA(0, 0), a2, voffA);
            PG8_WAIT_V(8); PG8_WAIT_L(0); PG8_BAR; PG8_MMA(1, 0, At, B0); PG8_MMA(1, 1, At, B1); PG8_BAR; PG8_SCHED;
            PG8_LDB(B0, 1, 0); PG8_LDB(B1, 1, 1); PG8_SCHED; PG8_LDA(At, 1, 0); PG8_STAGE(PG8_SA(0, 1), a2 + hstepA, voffA);
            PG8_WAIT_V(8); PG8_WAIT_L(0); PG8_BAR; PG8_MMA(0, 0, At, B0); PG8_MMA(0, 1, At, B1); PG8_BAR; PG8_SCHED;
            PG8_LDA(At, 1, 1); PG8_STAGE(PG8_SB(1, 0), b3, voffB); PG8_STAGE(PG8_SB(1, 1), b3 + hstep, voffB); PG8_STAGE(PG8_SA(1, 0), a3, voffA);
            PG8_WAIT_V(8); PG8_WAIT_L(0); PG8_BAR; PG8_MMA(1, 0, At, B0); PG8_MMA(1, 1, At, B1); PG8_BAR; PG8_SCHED;
            } else {
            PG8_LDB(B0, 0, 0); PG8_SCHED; PG8_LDA(At, 0, 0); PG8_STAGE(PG8_SA(1, 1), a1 + hstepA, voffA);
            PG8_WAIT_L(8); PG8_BAR; PG8_WAIT_L(0); PG8_MMA(0, 0, At, B0); PG8_BAR; PG8_SCHED;
            PG8_LDB(B1, 0, 1); PG8_STAGE(PG8_SB(0, 0), b2, voffB);
            PG8_BAR; PG8_WAIT_L(0); PG8_MMA(0, 1, At, B1); PG8_BAR;
            PG8_LDA(At, 0, 1); PG8_STAGE(PG8_SA(0, 0), a2, voffA);
            PG8_BAR; PG8_WAIT_L(0); PG8_MMA(1, 0, At, B0); PG8_BAR; PG8_SCHED;
            PG8_STAGE(PG8_SB(0, 1), b2 + hstep, voffB);
            PG8_WAIT_V(6); PG8_BAR; PG8_MMA(1, 1, At, B1); PG8_BAR;
            PG8_LDB(B0, 1, 0); PG8_SCHED; PG8_LDA(At, 1, 0); PG8_STAGE(PG8_SA(0, 1), a2 + hstepA, voffA);
            PG8_WAIT_L(8); PG8_BAR; PG8_WAIT_L(0); PG8_MMA(0, 0, At, B0); PG8_BAR; PG8_SCHED;
            PG8_LDB(B1, 1, 1); PG8_STAGE(PG8_SB(1, 0), b3, voffB);
            PG8_BAR; PG8_WAIT_L(0); PG8_MMA(0, 1, At, B1); PG8_BAR;
            PG8_LDA(At, 1, 1); PG8_STAGE(PG8_SA(1, 0), a3, voffA);
            PG8_BAR; PG8_WAIT_L(0); PG8_MMA(1, 0, At, B0); PG8_BAR; PG8_SCHED;
            PG8_STAGE(PG8_SB(1, 1), b3 + hstep, voffB);
            PG8_WAIT_V(6); PG8_BAR; PG8_MMA(1, 1, At, B1); PG8_BAR;
            }
        }
        if constexpr (ALIGN_EPI) { if (wr == 0) PG8_BAR; }
        if constexpr (!Epi::AFTER_DRAIN) { E(acc, cur, wr, wc, fr, fq); S.done(cur); }
        if (!has_next) break;
#pragma unroll
        for (int a = 0; a < 2; ++a)
#pragma unroll
            for (int b = 0; b < 2; ++b)
#pragma unroll
                for (int m = 0; m < 4; ++m)
#pragma unroll
                    for (int n = 0; n < 2; ++n) acc[a][b][m][n] = (f32x4){0.f, 0.f, 0.f, 0.f};
        cur = nxt; cA = nA; cB = nB; ++ui;
        if constexpr (ALIGN_EPI) { if (wr == 1) PG8_BAR; }
    }
    PG8_WAIT_V(0);
    if constexpr (!ALIGN_EPI) { if (wr == 0) PG8_BAR; }
    PG8_BAR;
    if constexpr (Epi::AFTER_DRAIN) { E.fused(acc, cur, wr, wc, fr, fq, lds, wid, lane); S.done(cur); }
#undef PG8_SA
#undef PG8_SB
#undef PG8_STAGE
#undef PG8_LDA
#undef PG8_LDB
#undef PG8_MMA
#undef PG8_WAIT_V
#undef PG8_WAIT_L
#undef PG8_BAR
#undef PG8_SCHED
}
}
namespace att {
enum { ORDER_NATURAL = 0, ORDER_REVERSED = 1, ORDER_PAIRED = 2, ORDER_XCD = 4 };
constexpr int B = 2, H = 16, HKV = 16, SQ = 8192, SKV = 8192, D = 128;
constexpr int QOFF = 0;
constexpr int WINDOW = SKV;
constexpr float THR = 8.f;
constexpr bool WSKIP = false;

constexpr float SCALE = 0.08838834764831845f;
constexpr int NW = 8, QBLK = 32, KVBLK = 64, QB = NW * QBLK;
constexpr int SHM_V = KVBLK * D * 2, SHM_K = KVBLK * D * 2;
constexpr int LDS_BYTES = 2 * SHM_V + 2 * SHM_K + NW * 64 * 4;
constexpr int FB_OFF = LDS_BYTES, OSTR = 2048, GSTR = 8448;

using bf16 = __hip_bfloat16;
#define ALAS __attribute__((address_space(3)))
typedef short bf16x8 __attribute__((ext_vector_type(8)));
typedef short s16x4 __attribute__((ext_vector_type(4)));
typedef float f32x16 __attribute__((ext_vector_type(16)));
typedef float f32x4 __attribute__((ext_vector_type(4)));
typedef unsigned u32x4 __attribute__((ext_vector_type(4)));
template <class A, class Bt> struct same_t { static constexpr bool v = false; };
template <class A> struct same_t<A, A> { static constexpr bool v = true; };

#define KSWZ(row, colB) ((row) * 256 + ((colB) ^ (((row) & 7) << 4)))
#define SBAR() __builtin_amdgcn_sched_barrier(0)
__device__ __forceinline__ int v_st(int k, int c) { const int kk = (k & ~0xC) | ((k & 4) << 1) | ((k & 8) >> 1); return ((kk >> 3) * 4 + (c >> 5)) * 512 + ((kk & 7) * 32 + (c & 31)) * 2; }
__device__ __forceinline__ int v_rd_base(int lane) { return ((lane & 3) << 3) | (((lane >> 2) & 3) << 6) | (((lane >> 4) & 1) << 5) | (((lane >> 5) & 1) << 8); }
constexpr int v_rd_off(int d0, int ks, int half) { return d0 * 512 + ks * 4096 + half * 2048; }
__device__ __forceinline__ int crow(int r, int hi) { return (r & 3) + 8 * (r >> 2) + 4 * hi; }
__device__ __forceinline__ unsigned cvtpk(float lo, float hi) {
    unsigned r; asm volatile("v_cvt_pk_bf16_f32 %0, %1, %2" : "=v"(r) : "v"(lo), "v"(hi)); return r;
}
__device__ __forceinline__ bf16x8 pack8(f32x4 a, f32x4 b) {
    u32x4 w = {cvtpk(a[0], a[1]), cvtpk(a[2], a[3]), cvtpk(b[0], b[1]), cvtpk(b[2], b[3])};
    return *reinterpret_cast<bf16x8*>(&w);
}
template <class T> __device__ __forceinline__ bf16x8 load8(const T* p) {
    if constexpr (same_t<T, float>::v) { return pack8(*(const f32x4*)p, *(const f32x4*)(p + 4)); }
    else { return *reinterpret_cast<const bf16x8*>(p); }
}
__device__ __forceinline__ void mask_tile(f32x16& p0, f32x16& p1, int dq, unsigned W) {
    const float NEG = -__builtin_inff();
#pragma unroll
    for (int r = 0; r < 16; ++r) {
        const int c = (r & 3) + 8 * (r >> 2);
        if ((unsigned)(dq - c) >= W) p0[r] = NEG;
        if ((unsigned)(dq - c - 32) >= W) p1[r] = NEG;
    }
}
__device__ __forceinline__ void partialSM(f32x16& p0, f32x16& p1, float& m_reg, float& mn, float& alpha) {
    float pmax = p0[0]; for (int r = 1; r < 16; ++r) pmax = fmaxf(pmax, p0[r]); for (int r = 0; r < 16; ++r) pmax = fmaxf(pmax, p1[r]);
    { auto rr = __builtin_amdgcn_permlane32_swap(__float_as_uint(pmax), __float_as_uint(pmax), false, false);
      pmax = fmaxf(__uint_as_float(rr[0]), __uint_as_float(rr[1])); }
    constexpr float C2 = 1.4426950408889634f * SCALE;
    if (__builtin_expect(__all((pmax - m_reg) * SCALE <= THR), 1)) { mn = m_reg; alpha = 1.f; }
    else { mn = fmaxf(m_reg, pmax); alpha = __builtin_amdgcn_exp2f((m_reg - mn) * C2); m_reg = mn; }
    const float mnL = -mn * C2;
    for (int r = 0; r < 16; ++r) p0[r] = fmaf(p0[r], C2, mnL); for (int r = 0; r < 16; ++r) p1[r] = fmaf(p1[r], C2, mnL);
    for (int r = 0; r < 16; ++r) p0[r] = __builtin_amdgcn_exp2f(p0[r]);
}
__device__ __forceinline__ void finishSM(f32x16& p0, f32x16& p1, float alpha, float& l_reg, bf16x8& pa0, bf16x8& pa1, bf16x8& pa2, bf16x8& pa3) {
    for (int r = 0; r < 16; ++r) p1[r] = __builtin_amdgcn_exp2f(p1[r]);
    float ps = 0; for (int r = 0; r < 16; ++r) ps += p0[r]; for (int r = 0; r < 16; ++r) ps += p1[r];
    { auto rr = __builtin_amdgcn_permlane32_swap(__float_as_uint(ps), __float_as_uint(ps), false, false);
      ps = __uint_as_float(rr[0]) + __uint_as_float(rr[1]); }
    l_reg = l_reg * alpha + ps;
#define PK4(P, B_, OUT) do { unsigned a0 = cvtpk(P[B_+0], P[B_+1]), a1 = cvtpk(P[B_+2], P[B_+3]);                          \
        unsigned b0 = cvtpk(P[B_+4], P[B_+5]), b1 = cvtpk(P[B_+6], P[B_+7]);                                             \
        auto r0 = __builtin_amdgcn_permlane32_swap(a0, b0, false, false); auto r1 = __builtin_amdgcn_permlane32_swap(a1, b1, false, false); \
        u32x4 w = {r0[0], r1[0], r0[1], r1[1]}; OUT = *reinterpret_cast<bf16x8*>(&w); } while (0)
    PK4(p0, 0, pa0); PK4(p0, 8, pa1); PK4(p1, 0, pa2); PK4(p1, 8, pa3);
#undef PK4
}
template <int KB, bool SK>
__device__ __forceinline__ void qkt(f32x16& p0, f32x16& p1, const char* K_lds, int r32, int hi, const bf16x8* qr, bool act, const ALAS float* fbp) {
    if (SK && !act) { const float NEG = -__builtin_inff();
#pragma unroll
        for (int r = 0; r < 16; ++r) { p0[r] = NEG; p1[r] = NEG; } return; }
#pragma unroll
    for (int a = 0; a < 4; ++a) { const f32x4 t0 = *(const ALAS f32x4*)(fbp + 8 * a), t1 = *(const ALAS f32x4*)(fbp + 32 + 8 * a);
        p0[4 * a] = t0[0]; p0[4 * a + 1] = t0[1]; p0[4 * a + 2] = t0[2]; p0[4 * a + 3] = t0[3];
        p1[4 * a] = t1[0]; p1[4 * a + 1] = t1[1]; p1[4 * a + 2] = t1[2]; p1[4 * a + 3] = t1[3]; }
    const char* kb[4];
#pragma unroll
    for (int dd = 0; dd < 4; ++dd) kb[dd] = K_lds + KB * SHM_K + KSWZ(r32, (dd * 16 + hi * 8) * 2);
#pragma unroll
    for (int d0 = 0; d0 < 8; ++d0) { const char* a = kb[d0 & 3] + (d0 >> 2) * 128;
        bf16x8 b0 = *reinterpret_cast<const bf16x8*>(a);
        bf16x8 b1 = *reinterpret_cast<const bf16x8*>(a + 32 * 256);
        p0 = __builtin_amdgcn_mfma_f32_32x32x16_bf16(b0, qr[d0], p0, 0, 0, 0);
        p1 = __builtin_amdgcn_mfma_f32_32x32x16_bf16(b1, qr[d0], p1, 0, 0, 0); }
}
template <int VB, bool SK>
__device__ __forceinline__ void pv_tile(f32x16* o, int vb0, bf16x8 pa0, bf16x8 pa1, bf16x8 pa2, bf16x8 pa3, bool act) {
    if (SK && !act) return;
#define TRRD(dst, off) asm volatile("ds_read_b64_tr_b16 %0, %1 offset:%2" : "=&v"(dst) : "v"(vb0), "i"(off) : "memory")
#define PV_D0(d0) do { s16x4 l0, l1, l2, l3, h0, h1, h2, h3; constexpr int b_ = VB * SHM_V + v_rd_off(d0, 0, 0);     \
        TRRD(l0, b_); TRRD(h0, b_ + 2048); TRRD(l1, b_ + 4096); TRRD(h1, b_ + 6144); TRRD(l2, b_ + 8192); TRRD(h2, b_ + 10240); TRRD(l3, b_ + 12288); TRRD(h3, b_ + 14336); \
        asm volatile("s_waitcnt lgkmcnt(0)" ::: "memory"); SBAR();                 \
        o[d0] = __builtin_amdgcn_mfma_f32_32x32x16_bf16(pa0, (bf16x8){l0[0], l0[1], l0[2], l0[3], h0[0], h0[1], h0[2], h0[3]}, o[d0], 0, 0, 0);   \
        o[d0] = __builtin_amdgcn_mfma_f32_32x32x16_bf16(pa1, (bf16x8){l1[0], l1[1], l1[2], l1[3], h1[0], h1[1], h1[2], h1[3]}, o[d0], 0, 0, 0);   \
        o[d0] = __builtin_amdgcn_mfma_f32_32x32x16_bf16(pa2, (bf16x8){l2[0], l2[1], l2[2], l2[3], h2[0], h2[1], h2[2], h2[3]}, o[d0], 0, 0, 0);   \
        o[d0] = __builtin_amdgcn_mfma_f32_32x32x16_bf16(pa3, (bf16x8){l3[0], l3[1], l3[2], l3[3], h3[0], h3[1], h3[2], h3[3]}, o[d0], 0, 0, 0); } while (0)
    PV_D0(0); PV_D0(1); PV_D0(2); PV_D0(3);
#undef PV_D0
#undef TRRD
}

template <class TIn, class TOut> struct BlockRef { const TIn* Q; const TIn* K; const TIn* V; TOut* O; const TIn* G; int P0; int JLO; };
template <class TIn> struct Seam {
    bf16x8 qr[8];
    bf16x8 st_v0, st_v1, st_k0, st_k1; f32x4 sf0, sf1, sf2, sf3;
    f32x4 tq[16];
};
__device__ __forceinline__ int swa_jlo(int P0, int W) { const int lowk = P0 - W + 1; return lowk > 0 ? lowk / KVBLK : 0; }
#define ROW(p, k0, rr) ((p) + (size_t)((k0) + (rr)) * D + sc)
#define ROWV(p, k0, rr) ((p) + (size_t)((k0) + (rr)) * GSTR + sc)
#define VMW() asm volatile("s_waitcnt vmcnt(0)" ::: "memory")
#define VMWN(n) asm volatile("s_waitcnt vmcnt(%0)" :: "i"(n) : "memory")
#define SLOAD_H(Kp, Vp, k0) do { S.st_v0 = load8<TIn>(ROWV(Vp, k0, sr)); S.st_v1 = load8<TIn>(ROWV(Vp, k0, 32 + sr));              \
                         S.st_k0 = load8<TIn>(ROW(Kp, k0, sr)); S.st_k1 = load8<TIn>(ROW(Kp, k0, 32 + sr)); } while (0)
#define SWRITE_HK(bf) do { *(bf16x8*)(K_lds + (bf) * SHM_K + kws) = S.st_k0; *(bf16x8*)(K_lds + (bf) * SHM_K + kws + 32 * 256) = S.st_k1; } while (0)
#define SWRITE_HV(bf) do { *(bf16x8*)(V_lds + (bf) * SHM_V + vst0) = S.st_v0; *(bf16x8*)(V_lds + (bf) * SHM_V + vst1) = S.st_v1; } while (0)
#define SWRITE_H(bf) do { SWRITE_HV(bf); SWRITE_HK(bf); } while (0)
#define SLOAD_F(p, k0) do { S.sf0 = *(const f32x4*)ROW(p, k0, sr); S.sf1 = *(const f32x4*)(ROW(p, k0, sr) + 4);                \
                            S.sf2 = *(const f32x4*)ROW(p, k0, 32 + sr); S.sf3 = *(const f32x4*)(ROW(p, k0, 32 + sr) + 4); } while (0)
#define SWRITE_KF(bf) do { *(bf16x8*)(K_lds + (bf) * SHM_K + kws) = pack8(S.sf0, S.sf1); *(bf16x8*)(K_lds + (bf) * SHM_K + kws + 32 * 256) = pack8(S.sf2, S.sf3); } while (0)
#define SWRITE_VF(bf) do { *(bf16x8*)(V_lds + (bf) * SHM_V + vst0) = pack8(S.sf0, S.sf1); *(bf16x8*)(V_lds + (bf) * SHM_V + vst1) = pack8(S.sf2, S.sf3); } while (0)
template <class TIn, class TOut>
__device__ __forceinline__ void causal_swa_prime(const BlockRef<TIn, TOut>& cur, int W, char* lds, Seam<TIn>& S) {
    constexpr bool F32 = same_t<TIn, float>::v;
    const int tid = tidx(), wid = __builtin_amdgcn_readfirstlane(tid >> 6), lane = tid & 63, r32 = lane & 31, hi = lane >> 5;
    const int sr = tid >> 4, sc = (tid & 15) * 8, kws = KSWZ(sr, sc * 2); char* K_lds = lds + 2 * SHM_V;
    const int kb0 = cur.JLO * KVBLK;
    for (int d0 = 0; d0 < 8; ++d0) S.qr[d0] = load8<TIn>(cur.Q + (size_t)(wid * QBLK + r32) * D + d0 * 16 + hi * 8);
    if constexpr (F32) { SLOAD_F((const float*)cur.K, kb0); VMW(); SWRITE_KF(0); SBAR(); SLOAD_F((const float*)cur.V, kb0); }
    else { SLOAD_H(cur.K, cur.V, kb0); VMW(); SWRITE_HK(0); }
    __syncthreads();
}
template <class TIn, class TOut>
__device__ __forceinline__ void causal_swa_block(const BlockRef<TIn, TOut>& cur, const BlockRef<TIn, TOut>& nxt, int skv, int W, char* lds, Seam<TIn>& S) {
    constexpr bool F32 = same_t<TIn, float>::v;
    const int tid = tidx(), wid = __builtin_amdgcn_readfirstlane(tid >> 6), lane = tid & 63, r32 = lane & 31, hi = lane >> 5;
    const int j_lo = cur.JLO;
    int j_hi = (cur.P0 + QB - 1) / KVBLK + 1; if (j_hi > skv / KVBLK) j_hi = skv / KVBLK;
    const int NT = j_hi - j_lo;
    const int kbn = nxt.JLO * KVBLK;
    const int qlo = cur.P0 + wid * QBLK, qm = qlo + r32 - 4 * hi;
    char* V_lds = lds; char* K_lds = lds + 2 * SHM_V;
    float* ws = (float*)(lds + 2 * SHM_V + 2 * SHM_K) + wid * 64; float* li_l = ws, * al_l = ws + 32;
    float m_reg = -1e30f, l_reg = 0; f32x16 o[4] = {};
    const int sr = tid >> 4, sc = (tid & 15) * 8, vst0 = v_st(sr, sc), vst1 = v_st(32 + sr, sc), kws = KSWZ(sr, sc * 2);
    const int vb0 = (int)(uintptr_t)V_lds + v_rd_base(lane);
    const TIn* Kh = cur.K; const TIn* Vh = cur.V;
#define RESC(a) do { if (__any((a) < 1.f)) { if (hi == 0) al_l[r32] = (a); asm volatile("s_waitcnt lgkmcnt(0)" ::: "memory");              \
                     for (int d_ = 0; d_ < 4; ++d_) for (int r = 0; r < 16; ++r) o[d_][r] *= al_l[crow(r, hi)]; } } while (0)
#define KBASE(t) ((j_lo + (t)) * KVBLK)
    const ALAS float* fb3 = (const ALAS float*)((ALAS char*)lds + FB_OFF) + 4 * hi;
#define FBP(t) (fb3 + KBASE(t))
#define ACT(t) (KBASE(t) <= qlo + QBLK - 1 && KBASE(t) + KVBLK - 1 >= qlo - W + 1)
#define MASKT(P0_, P1_, t) do { const int kb_ = KBASE(t); if ((!SK || ACT(t)) && (kb_ + KVBLK - 1 > qlo || kb_ <= qlo + QBLK - 1 - W)) mask_tile(P0_, P1_, qm - kb_, (unsigned)W); } while (0)
    constexpr int NQL = F32 ? 16 : 8;
    constexpr bool SK = WSKIP && !F32;
#define SEAM_K0() do { VMWN(NQL); if constexpr (F32) { SWRITE_KF(0); SBAR(); SLOAD_F((const float*)nxt.V, kbn); } else { SWRITE_HK(0); } SBAR(); } while (0)
    f32x16 pA0, pA1, pB0, pB1; float mnA, mnB, alA, alB; bf16x8 pa0, pa1, pa2, pa3;
    if constexpr (F32) { VMW(); SWRITE_VF(0); SBAR(); } else { SWRITE_HV(0); SBAR(); }
    if (NT > 1) { if constexpr (F32) SLOAD_F((const float*)Kh, KBASE(1)); else SLOAD_H(Kh, Vh, KBASE(1)); }
    SBAR(); qkt<0, SK>(pA0, pA1, K_lds, r32, hi, S.qr, ACT(0), FBP(0));
    if constexpr (F32) { if (NT > 1) { VMW(); SWRITE_KF(1); SBAR(); SLOAD_F((const float*)Vh, KBASE(1)); } }
    MASKT(pA0, pA1, 0); partialSM(pA0, pA1, m_reg, mnA, alA);
    if (NT > 1) { VMW(); if constexpr (F32) { SWRITE_VF(1); SBAR(); if (NT > 2) SLOAD_F((const float*)Kh, KBASE(2)); } else SWRITE_H(1); }
    __syncthreads();
#define HALF_STEP(PX0, PX1, mnX, alX, PY0, PY1, alY, t, KB, VB, SB) do {                                                      \
        SBAR(); qkt<KB, SK>(PX0, PX1, K_lds, r32, hi, S.qr, ACT(t), FBP(t));                                             \
        finishSM(PY0, PY1, alY, l_reg, pa0, pa1, pa2, pa3); SBAR();                                                           \
        if ((t) + 1 < NT) { if constexpr (F32) { VMW(); SWRITE_KF(SB); SBAR(); SLOAD_F((const float*)Vh, KBASE((t) + 1)); }  \
                            else { SLOAD_H(Kh, Vh, KBASE((t) + 1)); } SBAR(); }                                               \
        pv_tile<VB, SK>(o, vb0, pa0, pa1, pa2, pa3, ACT((t) - 1)); MASKT(PX0, PX1, (t)); partialSM(PX0, PX1, m_reg, mnX, alX);                                        \
        __syncthreads();                                                                                                      \
        if ((t) + 1 < NT) { VMW(); if constexpr (F32) { SWRITE_VF(SB); SBAR(); if ((t) + 2 < NT) SLOAD_F((const float*)Kh, KBASE((t) + 2)); } \
                            else { SWRITE_H(SB); } }                                                                          \
        RESC(alX); __syncthreads(); } while (0)
    for (int t = 1; t + 1 < NT; t += 2) {
        HALF_STEP(pB0, pB1, mnB, alB, pA0, pA1, alA, t, 1, 0, 0);
        HALF_STEP(pA0, pA1, mnA, alA, pB0, pB1, alB, t + 1, 0, 1, 1);
    }
    const bool even = (NT & 1) == 0;
    if (even) { SBAR(); qkt<1, SK>(pB0, pB1, K_lds, r32, hi, S.qr, ACT(NT - 1), FBP(NT - 1)); SBAR(); }
#define QROW(e) (nxt.Q + (size_t)(wid * QBLK + r32) * D + ((e) >> 1) * 16 + hi * 8 + ((e) & 1) * 4)
    if constexpr (F32) { SLOAD_F((const float*)nxt.K, kbn); SBAR();
#pragma unroll
        for (int e = 0; e < 8; ++e) S.tq[e] = *(const f32x4*)QROW(e); }
    else { SLOAD_H(nxt.K, nxt.V, kbn); SBAR();
#pragma unroll
        for (int d0 = 0; d0 < 8; ++d0) S.qr[d0] = load8<TIn>(nxt.Q + (size_t)(wid * QBLK + r32) * D + d0 * 16 + hi * 8); }
    SBAR();
    finishSM(pA0, pA1, alA, l_reg, pa0, pa1, pa2, pa3); SBAR();
    if constexpr (F32) {
#pragma unroll
        for (int e = 8; e < 16; ++e) S.tq[e] = *(const f32x4*)QROW(e); SBAR(); }
#undef QROW
    pv_tile<0, SK>(o, vb0, pa0, pa1, pa2, pa3, ACT(even ? NT - 2 : NT - 1));
    if (even) { MASKT(pB0, pB1, NT - 1); partialSM(pB0, pB1, m_reg, mnB, alB); __syncthreads(); RESC(alB);
        finishSM(pB0, pB1, alB, l_reg, pa0, pa1, pa2, pa3); SBAR(); pv_tile<1, SK>(o, vb0, pa0, pa1, pa2, pa3, ACT(NT - 1)); }
    SBAR(); SEAM_K0();
    if (hi == 0) li_l[r32] = l_reg; asm volatile("s_waitcnt lgkmcnt(0)" ::: "memory");
    float rli[16];
#pragma unroll
    for (int r = 0; r < 16; ++r) rli[r] = __builtin_amdgcn_rcpf(li_l[crow(r, hi)]);
    TOut* Ow = cur.O + (size_t)(wid * QBLK) * OSTR;
#pragma unroll
    for (int r = 0; r < 16; ++r) { const int orow = crow(r, hi);
#pragma unroll
        for (int d0 = 0; d0 < 4; ++d0) {
            const float v = o[d0][r] * rli[r];
            const float vn = __shfl_xor(v, 1);
            if ((r32 & 1) == 0) *(unsigned*)(Ow + (size_t)orow * OSTR + d0 * 32 + r32) = cvtpk(v, vn); } }
    if constexpr (F32) {
#pragma unroll
        for (int d0 = 0; d0 < 8; ++d0) S.qr[d0] = pack8(S.tq[2 * d0], S.tq[2 * d0 + 1]); }
    __syncthreads();
#undef RESC
#undef KBASE
#undef FBP
#undef ACT
#undef MASKT
#undef SEAM_K0
#undef HALF_STEP
}
#undef ROW
#undef ROWV
#undef VMW
#undef VMWN
#undef SLOAD_H
#undef SWRITE_HK
#undef SWRITE_HV
#undef SWRITE_H
#undef SLOAD_F
#undef SWRITE_KF
#undef SWRITE_VF

}

#define LAS __attribute__((address_space(3)))
typedef unsigned short bf16_t;
typedef short bf16x8 __attribute__((ext_vector_type(8)));
typedef short s16x4 __attribute__((ext_vector_type(4)));
typedef float f32x4 __attribute__((ext_vector_type(4)));
typedef unsigned u32x4 __attribute__((ext_vector_type(4)));
typedef unsigned u32x2 __attribute__((ext_vector_type(2)));

constexpr int NB = 2, SEQ = 8192, T = NB * SEQ, DM = 2048, DFF = 5632;
constexpr int NTHR = 512, NWV = 8;
constexpr float EPS = 1e-6f;
constexpr int FOX_N = 8208, FOX_LD = 8448;
constexpr int GDN_ROWS = 12544;

constexpr size_t MiB = 1u << 20;
constexpr size_t WS_MODS = 0, WS_FL = 1 * MiB, WS_FB = 2 * MiB, WS_AB = 3 * MiB, WS_GB = 7 * MiB, WS_TB = 11 * MiB;
constexpr size_t WS_WA = 17 * MiB, WS_WB = 66 * MiB, WS_H = 88 * MiB, WS_Y = 152 * MiB, WS_BIG = 216 * MiB;
constexpr size_t WS_P = WS_BIG, WS_QH = WS_BIG + 264 * MiB, WS_KH = WS_QH + 64 * MiB, WS_VH = WS_KH + 64 * MiB;
constexpr size_t WS_GV = WS_BIG;
constexpr size_t WS_QKV = WS_BIG, WS_QN = WS_BIG + 256 * MiB, WS_KN = WS_QN + 64 * MiB, WS_KT = WS_KN + 64 * MiB, WS_VT = WS_KT + 64 * MiB;
constexpr size_t WS_TM = WS_BIG, WS_QKM = WS_BIG + 64 * MiB, WS_O = WS_BIG + 128 * MiB, WS_Z = WS_QN;
constexpr size_t WS_END = WS_VT + 128 * MiB;
static_assert((size_t)GDN_ROWS * DM * 2 <= WS_WB - WS_WA && (size_t)DM * DFF * 2 <= WS_H - WS_WB, "weight regions");

constexpr int LDS_TOTAL = 147456;

__device__ __forceinline__ float bf2f(unsigned h) { return __uint_as_float(h << 16); }
typedef float f32x2_t __attribute__((ext_vector_type(2))); typedef __bf16 bf16x2_t __attribute__((ext_vector_type(2)));
__device__ __forceinline__ unsigned pk2(float lo, float hi) { const f32x2_t v = {lo, hi}; const bf16x2_t b = __builtin_convertvector(v, bf16x2_t); return __builtin_bit_cast(unsigned, b); }
__device__ __forceinline__ void unpack8(u32x4 w, float* f) {
    f[0] = __uint_as_float(w.x << 16); f[1] = __uint_as_float(w.x & 0xffff0000u); f[2] = __uint_as_float(w.y << 16); f[3] = __uint_as_float(w.y & 0xffff0000u);
    f[4] = __uint_as_float(w.z << 16); f[5] = __uint_as_float(w.z & 0xffff0000u); f[6] = __uint_as_float(w.w << 16); f[7] = __uint_as_float(w.w & 0xffff0000u);
}
__device__ __forceinline__ u32x4 pack8f(const float* f) { u32x4 w; w.x = pk2(f[0], f[1]); w.y = pk2(f[2], f[3]); w.z = pk2(f[4], f[5]); w.w = pk2(f[6], f[7]); return w; }
__device__ __forceinline__ float wave_sum(float v) {
#pragma unroll
    for (int o = 1; o < 64; o <<= 1) v += __shfl_xor(v, o);
    return v;
}
__device__ __forceinline__ float sum16(float v) { v += __shfl_xor(v, 1); v += __shfl_xor(v, 2); v += __shfl_xor(v, 4); v += __shfl_xor(v, 8); return v; }
__device__ __forceinline__ float sigmoidf_(float x) { return 1.f / (1.f + __expf(-x)); }
__device__ __forceinline__ float siluf_(float x) { return x / (1.f + __expf(-x)); }

struct EpiStore {
    static constexpr bool PERM = true, AFTER_DRAIN = false;
    bf16_t* O; int ldc; int ncols; float* aux; int aux_tile, aux_n;
    __device__ __forceinline__ void operator()(const pg8::f32x4 (&acc)[2][2][4][2], const pg8::Unit& u, int wr, int wc, int fr, int fq) const {
        const int row0 = u.pm * 256 + wr * 64 + fr, col0 = u.pn * 256 + wc * 32 + 8 * fq;
#pragma unroll
        for (int ai = 0; ai < 2; ++ai)
#pragma unroll
            for (int m = 0; m < 4; ++m) { const int row = row0 + ai * 128 + m * 16; bf16_t* rowp = O + (size_t)row * ldc + col0;
#pragma unroll
                for (int bj = 0; bj < 2; ++bj) { const pg8::f32x4 v0 = acc[ai][bj][m][0], v1 = acc[ai][bj][m][1];
                    if (col0 + bj * 128 < ncols) { u32x4 w; w.x = pk2(v0[0], v0[1]); w.y = pk2(v0[2], v0[3]); w.z = pk2(v1[0], v1[1]); w.w = pk2(v1[2], v1[3]);
                        *(u32x4*)(rowp + bj * 128) = w; }
                    if (u.pn == aux_tile) { const int ct = wc * 32 + 8 * fq + bj * 128;
                        if (ct < aux_n) { float* ap = aux + (size_t)row * aux_n + ct; *(pg8::f32x4*)ap = v0; *(pg8::f32x4*)(ap + 4) = v1; } } } }
    }
};
__device__ __forceinline__ void run_gemm(LAS unsigned char* lds, const bf16_t* A, int lda, const bf16_t* Bt, int N, int K, bf16_t* O, int ldc, int ncols, float* aux, int aux_tile, int aux_n) {
    pg8::Gemm g{A, Bt, T, N, K, lda}; pg8::StaticOrder S; S.init(T, N, (int)gridDim.x, (int)blockIdx.x);
    EpiStore E{O, ldc, ncols, aux, aux_tile, aux_n};
    pg8::gemm_phase<EpiStore, pg8::StaticOrder, true, true>(lds, g, S, E);
}

__device__ __forceinline__ void convert_weight(LAS unsigned char* lds, const float* W, int K, int N, bf16_t* WT, int seg1, int add1, int seg2, int add2) {
    const int lane = tidx() & 63, wave = tidx() >> 6;
    LAS float* scr = (LAS float*)(lds + wave * 16384);
    const int gw = blockIdx.x * NWV + wave, NGW = gridDim.x * NWV;
    const int nblk = (N + 31) / 32, nitems = (K / 64) * nblk;
    for (int item = gw; item < nitems; item += NGW) {
        const int kb = item / nblk, nb = item % nblk, k0 = 64 * kb, n0 = 32 * nb;
        const int c4 = (lane & 7) * 4, nn = n0 + c4; const bool ok = nn < N;
        f32x4 vld[8];
#pragma unroll
        for (int i = 0; i < 8; ++i) { const int kk = 8 * i + (lane >> 3); vld[i] = ok ? *(const f32x4*)(W + (size_t)(k0 + kk) * N + nn) : (f32x4){0.f, 0.f, 0.f, 0.f}; }
#pragma unroll
        for (int i = 0; i < 8; ++i) { const int kk = 8 * i + (lane >> 3); LAS float* sp = scr + kk * 33 + c4; sp[0] = vld[i][0]; sp[1] = vld[i][1]; sp[2] = vld[i][2]; sp[3] = vld[i][3]; }
        asm volatile("s_waitcnt lgkmcnt(0)" ::: "memory");
        const int c = lane & 7;
#pragma unroll
        for (int j = 0; j < 4; ++j) { const int nl = (lane >> 3) + 8 * j, n = n0 + nl; const LAS float* s = scr + (8 * c) * 33 + nl;
            u32x4 o; o.x = pk2(s[0 * 33], s[1 * 33]); o.y = pk2(s[2 * 33], s[3 * 33]); o.z = pk2(s[4 * 33], s[5 * 33]); o.w = pk2(s[6 * 33], s[7 * 33]);
            if (n < N) { const int row = n + (n >= seg2 ? add2 : (n >= seg1 ? add1 : 0)); *(u32x4*)(WT + (size_t)row * K + k0 + 8 * c) = o; } }
        asm volatile("s_waitcnt lgkmcnt(0)" ::: "memory");
    }
    __syncthreads();
}
constexpr int NOSEG = 0x7fffffff;

__device__ __forceinline__ void mods_phase(LAS unsigned char* lds, const float* c, const float* ada_w, const float* ada_b, float* Mods) {
    const int tid = tidx(), lane = tid & 63, wave = tid >> 6, e4 = lane & 7, ds = lane >> 3;
    LAS float* red = (LAS float*)lds;
    for (int u = blockIdx.x; u < 4 * 192; u += gridDim.x) {
        const int is = u / 192, e0 = (u % 192) * 32;
        f32x4 a0 = {0.f, 0.f, 0.f, 0.f}, a1 = {0.f, 0.f, 0.f, 0.f};
#pragma unroll 8
        for (int it = 0; it < 32; ++it) { const int d = 256 * wave + 8 * it + ds;
            const f32x4 wv = *(const f32x4*)(ada_w + ((size_t)is * DM + d) * (3 * DM) + e0 + 4 * e4);
            const float c0 = siluf_(c[d]), c1 = siluf_(c[DM + d]);
            a0 += wv * c0; a1 += wv * c1; }
#pragma unroll
        for (int kk = 0; kk < 4; ++kk) {
#pragma unroll
            for (int o = 8; o < 64; o <<= 1) { a0[kk] += __shfl_xor(a0[kk], o); a1[kk] += __shfl_xor(a1[kk], o); } }
        if (lane < 8) {
#pragma unroll
            for (int kk = 0; kk < 4; ++kk) { red[(wave * 2 + 0) * 32 + 4 * e4 + kk] = a0[kk]; red[(wave * 2 + 1) * 32 + 4 * e4 + kk] = a1[kk]; } }
        __syncthreads();
        if (tid < 64) { const int b = tid >> 5, e = tid & 31; float s = 0.f;
#pragma unroll
            for (int w = 0; w < 8; ++w) s += red[(w * 2 + b) * 32 + e];
            Mods[((size_t)is * 2 + b) * (3 * DM) + e0 + e] = s + ada_b[(size_t)is * (3 * DM) + e0 + e]; }
        __syncthreads();
    }
}

__device__ __forceinline__ void row_phase(const float* xin, float* xout, const bf16_t* Yb, const float* gate, const float* gpost, bf16_t* Hout, const float* gpre, const float* shift, const float* scale) {
    const int lane = tidx() & 63, wave = __builtin_amdgcn_readfirstlane(tidx() >> 6);
    const int gw = blockIdx.x * NWV + wave, NGW = gridDim.x * NWV;
    for (int row = gw; row < T; row += 2 * NGW) {
        const int row1 = row + NGW; const int b = row >> 13; const size_t mo = (size_t)b * 3 * DM;
        f32x4 x0[8], x1[8];
#pragma unroll
        for (int j = 0; j < 8; ++j) { x0[j] = *(const f32x4*)(xin + (size_t)row * DM + 4 * lane + 256 * j); x1[j] = *(const f32x4*)(xin + (size_t)row1 * DM + 4 * lane + 256 * j); }
        if (Yb) {
            u32x2 w0[8], w1[8]; float s0 = 0.f, s1 = 0.f;
#define UNPK4(w) ((f32x4){__uint_as_float((w).x << 16), __uint_as_float((w).x & 0xffff0000u), __uint_as_float((w).y << 16), __uint_as_float((w).y & 0xffff0000u)})
#pragma unroll
            for (int j = 0; j < 8; ++j) { w0[j] = *(const u32x2*)(Yb + (size_t)row * DM + 4 * lane + 256 * j); w1[j] = *(const u32x2*)(Yb + (size_t)row1 * DM + 4 * lane + 256 * j);
                const f32x4 a = UNPK4(w0[j]), c = UNPK4(w1[j]);
                s0 += (a[0] * a[0] + a[1] * a[1]) + (a[2] * a[2] + a[3] * a[3]); s1 += (c[0] * c[0] + c[1] * c[1]) + (c[2] * c[2] + c[3] * c[3]); }
            const float r0 = rsqrtf(wave_sum(s0) * (1.f / DM) + EPS), r1 = rsqrtf(wave_sum(s1) * (1.f / DM) + EPS);
#pragma unroll
            for (int j = 0; j < 8; ++j) { const int c = 4 * lane + 256 * j; const f32x4 m = *(const f32x4*)(gate + mo + c) * *(const f32x4*)(gpost + c);
                x0[j] += m * (UNPK4(w0[j]) * r0); x1[j] += m * (UNPK4(w1[j]) * r1); }
#undef UNPK4
        }
        if (xout) {
#pragma unroll
            for (int j = 0; j < 8; ++j) { *(f32x4*)(xout + (size_t)row * DM + 4 * lane + 256 * j) = x0[j]; *(f32x4*)(xout + (size_t)row1 * DM + 4 * lane + 256 * j) = x1[j]; }
        }
        if (Hout) {
            float s0 = 0.f, s1 = 0.f;
#pragma unroll
            for (int j = 0; j < 8; ++j) { s0 += (x0[j][0] * x0[j][0] + x0[j][1] * x0[j][1]) + (x0[j][2] * x0[j][2] + x0[j][3] * x0[j][3]);
                s1 += (x1[j][0] * x1[j][0] + x1[j][1] * x1[j][1]) + (x1[j][2] * x1[j][2] + x1[j][3] * x1[j][3]); }
            const float r0 = rsqrtf(wave_sum(s0) * (1.f / DM) + EPS), r1 = rsqrtf(wave_sum(s1) * (1.f / DM) + EPS);
#pragma unroll
            for (int j = 0; j < 8; ++j) { const int c = 4 * lane + 256 * j; const f32x4 a = *(const f32x4*)(gpre + c) * (*(const f32x4*)(scale + mo + c) + 1.f), sh = *(const f32x4*)(shift + mo + c);
                const f32x4 h0 = x0[j] * r0 * a + sh, h1 = x1[j] * r1 * a + sh; u32x2 w0, w1; w0.x = pk2(h0[0], h0[1]); w0.y = pk2(h0[2], h0[3]); w1.x = pk2(h1[0], h1[1]); w1.y = pk2(h1[2], h1[3]);
                *(u32x2*)(Hout + (size_t)row * DM + c) = w0; *(u32x2*)(Hout + (size_t)row1 * DM + c) = w1; }
        }
    }
}

__device__ __forceinline__ void fox_prep(LAS unsigned char* lds, const bf16_t* P, const float* FL, const float* fbias, const float* qg, const float* kg, bf16_t* Qh, bf16_t* Kh, bf16_t* Vh, float* FB) {
    const int lane = tidx() & 63, wave = tidx() >> 6;
    const int gw = blockIdx.x * NWV + wave, NGW = gridDim.x * NWV;
    const int dl = (lane & 15) * 8;
    float gq[8], gk[8];
#pragma unroll
    for (int j = 0; j < 8; ++j) { gq[j] = qg[dl + j]; gk[j] = kg[dl + j]; }
    for (int row = gw; row < T; row += NGW) {
        const int b = row >> 13, s = row & (SEQ - 1);
#pragma unroll
        for (int part = 0; part < 2; ++part) {
#pragma unroll
            for (int p = 0; p < 4; ++p) {
                const int col = p * 512 + lane * 8, h = col >> 7;
                const u32x4 w = *(const u32x4*)(P + (size_t)row * FOX_LD + part * 2048 + col);
                bf16_t* dst = (part == 0 ? Qh : (part == 1 ? Kh : Vh)) + (((size_t)(b * 16 + h) * SEQ + s) * 128 + dl);
                if (part == 2) { *(u32x4*)dst = w; }
                else { float f[8]; unpack8(w, f); float ss = 0.f;
#pragma unroll
                    for (int j = 0; j < 8; ++j) ss += f[j] * f[j];
                    const float r = rsqrtf(sum16(ss) * (1.f / 128.f) + EPS);
#pragma unroll
                    for (int j = 0; j < 8; ++j) f[j] = f[j] * r * (part == 0 ? gq[j] : gk[j]);
                    *(u32x4*)dst = pack8f(f); }
            }
        }
    }
    if (blockIdx.x < 32) {
        LAS float* wtot = (LAS float*)lds;
        const int bh = blockIdx.x, b = bh >> 4, h = bh & 15; const float fb = fbias[h];
        const float* src = FL + ((size_t)b * SEQ + wave * 2048 + lane * 32) * 16 + h;
        float tot = 0.f, incl = 0.f;
        if (wave < 4) {
#pragma unroll 16
            for (int i = 0; i < 32; ++i) { const float x = src[(size_t)i * 16] + fb; tot += (x >= 0.f) ? -log1pf(expf(-x)) : (x - log1pf(expf(x))); }
            incl = tot;
#pragma unroll
            for (int o = 1; o < 64; o <<= 1) { const float t = __shfl_up(incl, o); if (lane >= o) incl += t; }
            if (lane == 63) wtot[wave] = incl;
        }
        __syncthreads();
        if (wave < 4) {
            float run = incl - tot;
            for (int w = 0; w < wave; ++w) run += wtot[w];
            float* dst = FB + (size_t)bh * SEQ + wave * 2048 + lane * 32;
#pragma unroll 16
            for (int i = 0; i < 32; ++i) { const float x = src[(size_t)i * 16] + fb; run += (x >= 0.f) ? -log1pf(expf(-x)) : (x - log1pf(expf(x))); dst[i] = -run * 11.313708498984761f; }
        }
    }
}

__device__ __forceinline__ void fox_attention(char* lds, const bf16_t* Qh, const bf16_t* Kh, const bf16_t* Vh, const bf16_t* P, const float* FB, bf16_t* AO, const float* qg, const float* kg) {
    using abf = att::bf16; typedef att::BlockRef<abf, abf> Ref;
    float thr_t;
    { const int ll = tidx() & 63; float mq = fmaxf(fabsf(qg[ll]), fabsf(qg[64 + ll])), mk = fmaxf(fabsf(kg[ll]), fabsf(kg[64 + ll]));
#pragma unroll
      for (int o = 1; o < 64; o <<= 1) { mq = fmaxf(mq, __shfl_xor(mq, o)); mk = fmaxf(mk, __shfl_xor(mk, o)); }
      thr_t = 2.04f * 128.f * mq * mk + 32.f * 11.313708498984761f; }
    for (int L = blockIdx.x; L < 512; L += gridDim.x) {
        const int bh = L >> 4, x = L & 15, b = bh >> 4, h = bh & 15;
        __syncthreads();
        {
            const f32x4* src = (const f32x4*)(FB + (size_t)bh * SEQ); LAS f32x4* dst = (LAS f32x4*)((LAS char*)lds + att::FB_OFF);
            const int tl = tidx();
#pragma unroll
            for (int i = 0; i < 4; ++i) dst[tl + i * NTHR] = src[tl + i * NTHR];
        }
        Ref r0, r1;
        const int qb0 = x, qb1 = 31 - x;
        __syncthreads();
        int jl[2];
#pragma unroll
        for (int pass = 0; pass < 2; ++pass) { const int P0 = (pass ? qb1 : qb0) * 256; const LAS float* tbl = (const LAS float*)((LAS char*)lds + att::FB_OFF);
            const float ref = tbl[P0]; int lo = 0, hi = P0 >> 6;
            while (lo < hi) { const int mid = (lo + hi + 1) >> 1; if (ref - tbl[64 * mid - 1] > thr_t) lo = mid; else hi = mid - 1; }
            jl[pass] = __builtin_amdgcn_readfirstlane(lo); }
        r0.Q = (const abf*)Qh + ((size_t)bh * SEQ + (size_t)qb0 * 256) * 128; r0.K = (const abf*)Kh + (size_t)bh * SEQ * 128; r0.V = (const abf*)P + (size_t)b * SEQ * FOX_LD + 4096 + h * 128;
        r0.O = (abf*)AO + ((size_t)b * SEQ + (size_t)qb0 * 256) * DM + h * 128; r0.G = nullptr; r0.P0 = qb0 * 256; r0.JLO = jl[0];
        r1 = r0;
        r1.Q = (const abf*)Qh + ((size_t)bh * SEQ + (size_t)qb1 * 256) * 128;
        r1.O = (abf*)AO + ((size_t)b * SEQ + (size_t)qb1 * 256) * DM + h * 128; r1.P0 = qb1 * 256; r1.JLO = jl[1];
        att::Seam<abf> S;
        att::causal_swa_prime<abf, abf>(r0, SEQ, lds, S);
        att::causal_swa_block<abf, abf>(r0, r1, SEQ, SEQ, lds, S);
        att::causal_swa_block<abf, abf>(r1, r1, SEQ, SEQ, lds, S);
        asm volatile("s_waitcnt vmcnt(0)" ::: "memory");
        __syncthreads();
#pragma unroll 1
        for (int pass = 0; pass < 2; ++pass) { const int qb = pass ? qb1 : qb0;
#pragma unroll 2
            for (int i = 0; i < 8; ++i) { const int idx = tidx() + NTHR * i, row = idx >> 4, c8 = idx & 15; const size_t trow = (size_t)b * SEQ + (size_t)qb * 256 + row;
                bf16_t* op = AO + trow * DM + h * 128 + c8 * 8; const bf16_t* gp = P + trow * FOX_LD + 6160 + h * 128 + c8 * 8;
                float o[8], g[8]; unpack8(*(const u32x4*)op, o); unpack8(*(const u32x4*)gp, g);
#pragma unroll
                for (int j = 0; j < 8; ++j) o[j] *= sigmoidf_(g[j]);
                *(u32x4*)op = pack8f(o); } }
    }
    asm volatile("s_waitcnt vmcnt(0)" ::: "memory");
    __syncthreads();
}

__device__ __forceinline__ void glu_phase(bf16_t* GV, const float* cw, const float* cb) {
    constexpr int LD = 2 * DFF, NCG = DFF / 8, RUN = 32, NTASK = (T / RUN) * NCG;
    const int gt = blockIdx.x * NTHR + tidx(), NGT = gridDim.x * NTHR;
    for (int task = gt; task < NTASK; task += NGT) {
        const int run = task / NCG, cgp = task % NCG, col = cgp * 8, t0 = run * RUN;
        float w0[8], w1[8], w2[8], bb[8];
#pragma unroll
        for (int j = 0; j < 8; ++j) { w0[j] = cw[col + j]; w1[j] = cw[DFF + col + j]; w2[j] = cw[2 * DFF + col + j]; bb[j] = cb[col + j]; }
        float h0[8], h1[8];
        if ((t0 & (SEQ - 1)) == 0) {
#pragma unroll
            for (int j = 0; j < 8; ++j) { h0[j] = 0.f; h1[j] = 0.f; }
        } else { unpack8(*(const u32x4*)(GV + (size_t)(t0 - 2) * LD + col), h0); unpack8(*(const u32x4*)(GV + (size_t)(t0 - 1) * LD + col), h1); }
#pragma unroll 4
        for (int i = 0; i < RUN; ++i) {
            bf16_t* rp = GV + (size_t)(t0 + i) * LD + col;
            float g[8], v[8], o[8]; unpack8(*(const u32x4*)rp, g); unpack8(*(const u32x4*)(rp + DFF), v);
#pragma unroll
            for (int j = 0; j < 8; ++j) { const float a = w0[j] * h0[j] + w1[j] * h1[j] + w2[j] * g[j] + bb[j];
                o[j] = 0.5f * a * (1.f + erff(a * 0.70710678118654752f)) * v[j]; h0[j] = h1[j]; h1[j] = g[j]; }
            *(u32x4*)(rp + DFF) = pack8f(o);
        }
    }
}

__device__ __forceinline__ void gdn_prep(const bf16_t* QKV, const float* AB, const float* cw, const float* a_log, const float* dt_bias,
                                         bf16_t* qn, bf16_t* kn, bf16_t* kT, bf16_t* vT, float* Gt, float* Bt) {
    const int gt = blockIdx.x * NTHR + tidx(), NGT = gridDim.x * NTHR;
    for (int i = gt; i < T * 32; i += NGT) { const int t = i >> 5, hv = i & 31;
        const float a = AB[(size_t)t * 64 + hv] + dt_bias[hv], bq = AB[(size_t)t * 64 + 32 + hv];
        const float sp = a > 20.f ? a : log1pf(expf(a));
        Gt[i] = -expf(a_log[hv]) * sp; Bt[i] = 1.f / (1.f + expf(-bq)); }
    for (int task = gt; task < 256 * 1024; task += NGT) {
        const int chunk = task >> 10, cgp = task & 1023, col = cgp * 8, n = chunk & 127, row0 = chunk * 64;
        const int type = col < 2048 ? 0 : (col < 4096 ? 1 : 2);
        float w0[8], w1[8], w2[8], w3[8], h0[8], h1[8], h2[8];
#pragma unroll
        for (int j = 0; j < 8; ++j) { w0[j] = cw[col + j]; w1[j] = cw[8192 + col + j]; w2[j] = cw[2 * 8192 + col + j]; w3[j] = cw[3 * 8192 + col + j]; }
        if (n == 0) {
#pragma unroll
            for (int j = 0; j < 8; ++j) { h0[j] = 0.f; h1[j] = 0.f; h2[j] = 0.f; }
        } else { unpack8(*(const u32x4*)(QKV + (size_t)(row0 - 3) * 8192 + col), h0); unpack8(*(const u32x4*)(QKV + (size_t)(row0 - 2) * 8192 + col), h1); unpack8(*(const u32x4*)(QKV + (size_t)(row0 - 1) * 8192 + col), h2); }
        const float qs = type == 0 ? 0.08838834764831845f : 1.f;
        for (int rb = 0; rb < 8; ++rb) {
            float yv[8][8];
#pragma unroll
            for (int rr = 0; rr < 8; ++rr) {
                const int t = row0 + rb * 8 + rr; float xv[8]; unpack8(*(const u32x4*)(QKV + (size_t)t * 8192 + col), xv);
                float ss = 0.f;
#pragma unroll
                for (int j = 0; j < 8; ++j) { float y = w0[j] * h0[j] + w1[j] * h1[j] + w2[j] * h2[j] + w3[j] * xv[j]; h0[j] = h1[j]; h1[j] = h2[j]; h2[j] = xv[j];
                    y = siluf_(y); yv[rr][j] = y; ss += y * y; }
                if (type < 2) { const float r = rsqrtf(sum16(ss) + EPS) * qs;
#pragma unroll
                    for (int j = 0; j < 8; ++j) yv[rr][j] *= r;
                    *(u32x4*)((type == 0 ? qn : kn) + (size_t)t * 2048 + (col & 2047)) = pack8f(yv[rr]); }
            }
            if (type > 0) {
                const int cc = type == 1 ? col - 2048 : col - 4096, hh = cc >> 7, d0 = cc & 127;
                bf16_t* base = type == 1 ? kT + ((size_t)chunk * 16 + hh) * 8192 + (size_t)(rb * 128 + d0) * 8 : vT + ((size_t)chunk * 32 + hh) * 8192 + (size_t)(rb * 128 + d0) * 8;
#pragma unroll
                for (int j = 0; j < 8; ++j) { u32x4 w; w.x = pk2(yv[0][j], yv[1][j]); w.y = pk2(yv[2][j], yv[3][j]); w.z = pk2(yv[4][j], yv[5][j]); w.w = pk2(yv[6][j], yv[7][j]);
                    *(u32x4*)(base + (size_t)j * 8) = w; }
            }
        }
    }
}

__device__ __forceinline__ void gdn_g1(LAS unsigned char* lds, const bf16_t* qn, const bf16_t* kn, const float* Gt, const float* Bt, bf16_t* Tm, bf16_t* QKm, float* TB) {
    const int tid = tidx(), lane = tid & 63, wid = __builtin_amdgcn_readfirstlane(tid >> 6), r = lane & 15, g = lane >> 4;
    const int grp = wid >> 1, lw = wid & 1;
    LAS float* Am = (LAS float*)(lds + grp * 35840);
    LAS float* gcs = (LAS float*)(lds + grp * 35840 + 34816);
    LAS float* bts = (LAS float*)(lds + grp * 35840 + 35328);
    for (int u0 = blockIdx.x; u0 < 1024; u0 += gridDim.x) {
        const int unit = u0 + grp * 1024;
        const int chunk = unit >> 4, hk = unit & 15, row0 = chunk * 64;
        { const int hv = 2 * hk + lw;
            const float gv = Gt[(size_t)(row0 + lane) * 32 + hv], bv = Bt[(size_t)(row0 + lane) * 32 + hv];
            float sc = gv;
#pragma unroll
            for (int o = 1; o < 64; o <<= 1) { const float t = __shfl_up(sc, o); if (lane >= o) sc += t; }
            const float gl = __shfl(sc, 63);
            gcs[lw * 64 + lane] = sc; bts[lw * 64 + lane] = bv;
            float* tb = TB + ((size_t)chunk * 32 + hv) * 192;
            tb[lane] = bv; tb[64 + lane] = expf(sc); tb[128 + lane] = expf(gl - sc); }
        __syncthreads();
#pragma unroll 1
        for (int nt2 = 0; nt2 < 2; ++nt2) {
            const int nt = 2 * lw + nt2, c = 16 * nt + r;
            bf16x8 kY[4], qY[4];
            const bf16_t* yb = kn + (size_t)(row0 + 16 * nt + r) * 2048 + hk * 128 + 8 * g; const bf16_t* qb = qn + (size_t)(row0 + 16 * nt + r) * 2048 + hk * 128 + 8 * g;
#pragma unroll
            for (int ks = 0; ks < 4; ++ks) { kY[ks] = *(const bf16x8*)(yb + 32 * ks); qY[ks] = *(const bf16x8*)(qb + 32 * ks); }
#pragma unroll
            for (int mt = 0; mt < 4; ++mt) {
                const bf16_t* xb = kn + (size_t)(row0 + 16 * mt + r) * 2048 + hk * 128 + 8 * g;
                f32x4 kk = {0.f, 0.f, 0.f, 0.f}, qk = {0.f, 0.f, 0.f, 0.f};
#pragma unroll
                for (int ks = 0; ks < 4; ++ks) { const bf16x8 X = *(const bf16x8*)(xb + 32 * ks);
                    kk = __builtin_amdgcn_mfma_f32_16x16x32_bf16(X, kY[ks], kk, 0, 0, 0); qk = __builtin_amdgcn_mfma_f32_16x16x32_bf16(X, qY[ks], qk, 0, 0, 0); }
#pragma unroll
                for (int j = 0; j < 2; ++j) { const float gcc = gcs[j * 64 + c], bc = bts[j * 64 + c]; const f32x4 gcp = *(const LAS f32x4*)(gcs + j * 64 + 16 * mt + 4 * g);
                    f32x4 av; float qv[4];
#pragma unroll
                    for (int i = 0; i < 4; ++i) { const int cp = 16 * mt + 4 * g + i; const float e = __expf(fminf(gcc - gcp[i], 0.f));
                        av[i] = (c > cp) ? kk[i] * bc * e : 0.f; qv[i] = (c >= cp) ? qk[i] * e : 0.f; }
                    *(LAS f32x4*)(Am + (j * 64 + c) * 68 + 16 * mt + 4 * g) = av;
                    u32x2 w; w.x = pk2(qv[0], qv[1]); w.y = pk2(qv[2], qv[3]);
                    *(u32x2*)(QKm + (((size_t)chunk * 32 + 2 * hk + j) * 64 + c) * 64 + 16 * mt + 4 * g) = w; }
            }
        }
        __syncthreads();
        {
            const LAS float* A = Am + lw * 64 * 68; float t[64];
#pragma unroll
            for (int i = 0; i < 64; ++i) t[i] = 0.f;
#pragma unroll
            for (int i = 0; i < 64; ++i) { float acc = (lane == i) ? 1.f : 0.f, acc1 = 0.f, acc2 = 0.f, acc3 = 0.f;
#pragma unroll
                for (int jb = 0; jb < (i + 3) / 4; ++jb) { const f32x4 a = *(const LAS f32x4*)(A + i * 68 + 4 * jb);
                    acc -= a[0] * t[4 * jb]; acc1 -= a[1] * t[4 * jb + 1]; acc2 -= a[2] * t[4 * jb + 2]; acc3 -= a[3] * t[4 * jb + 3]; }
                t[i] = (acc + acc1) + (acc2 + acc3); }
            bf16_t* tp = Tm + ((size_t)chunk * 32 + 2 * hk + lw) * 4096 + lane;
#pragma unroll
            for (int i = 0; i < 64; ++i) tp[i * 64] = (bf16_t)(pk2(t[i], 0.f) & 0xffffu);
        }
        __syncthreads();
    }
}

__device__ __forceinline__ s16x4 ldsrd8(const LAS unsigned char* p) { return *(const LAS s16x4*)p; }
__device__ __forceinline__ bf16x8 join8(s16x4 a, s16x4 b) { return (bf16x8){a[0], a[1], a[2], a[3], b[0], b[1], b[2], b[3]}; }
__device__ __forceinline__ bf16x8 packf8(f32x4 a, f32x4 b) { u32x4 w; w.x = pk2(a[0], a[1]); w.y = pk2(a[2], a[3]); w.z = pk2(b[0], b[1]); w.w = pk2(b[2], b[3]); return __builtin_bit_cast(bf16x8, w); }
__device__ __forceinline__ void gdn_g2(LAS unsigned char* lds, const bf16_t* qn, const bf16_t* kn, const bf16_t* kT, const bf16_t* vT, const bf16_t* Tm, const bf16_t* QKm, const float* TB, bf16_t* O) {
    if (blockIdx.x >= 128) return;
    const int tid = tidx(), lane = tid & 63, wid = __builtin_amdgcn_readfirstlane(tid >> 6), r = lane & 15, g = lane >> 4;
    const int b = blockIdx.x >> 6, hv = (blockIdx.x >> 1) & 31, hk = hv >> 1, e0 = (blockIdx.x & 1) * 64 + (wid & 3) * 16;
    constexpr int O_KN = 0, O_QN = 16384, O_KT = 32768, O_TT = 49152, O_QK = 57344, BUFB = 65536, O_TB = 131072;
    int off128[8], off64[4];
#pragma unroll
    for (int q = 0; q < 8; ++q) { const int p = 2 * q + (g >> 1); off128[q] = r * 256 + ((p ^ r) << 4) + 8 * (g & 1); }
#pragma unroll
    for (int q = 0; q < 4; ++q) { const int p = 2 * q + (g >> 1); off64[q] = r * 128 + ((p ^ ((r >> 1) & 7)) << 4) + 8 * (g & 1); }
    f32x4 S[8];
#pragma unroll
    for (int i = 0; i < 8; ++i) S[i] = (f32x4){0.f, 0.f, 0.f, 0.f};
    f32x4 tbreg = {0.f, 0.f, 0.f, 0.f};
#define G2_ISSUE(n_, bf_) do { const int chunk_ = b * 128 + (n_); \
        _Pragma("unroll") for (int i_ = 0; i_ < 8; ++i_) { const int q_ = wid * 64 + lane + 512 * i_; const bf16_t* src_; \
            if (i_ < 4) { const int ql = q_ & 1023, row = ql >> 4, p = (ql & 15) ^ (row & 15); src_ = (i_ < 2 ? kn : qn) + (size_t)(chunk_ * 64 + row) * 2048 + hk * 128 + p * 8; } \
            else if (i_ < 6) { const int ql = q_ - 2048, row = ql >> 3, p = (ql & 7) ^ ((row >> 1) & 7); src_ = kT + ((size_t)chunk_ * 16 + hk) * 8192 + (size_t)(p * 128 + row) * 8; } \
            else { const int ql = q_ - (i_ == 6 ? 3072 : 3584), row = ql >> 3, p = (ql & 7) ^ ((row >> 1) & 7); src_ = (i_ == 6 ? Tm : QKm) + (((size_t)chunk_ * 32 + hv) * 64 + row) * 64 + p * 8; } \
            __builtin_amdgcn_global_load_lds((const unsigned*)src_, (LAS unsigned*)(lds + (bf_) * BUFB + (512 * i_ + wid * 64) * 16), 16, 0, 0); } \
        if (tid < 48) tbreg = *(const f32x4*)(TB + ((size_t)chunk_ * 32 + hv) * 192 + tid * 4); } while (0)
    G2_ISSUE(0, 0);
    if (tid < 48) *(LAS f32x4*)(lds + O_TB + tid * 16) = tbreg;
    for (int n = 0; n < 128; ++n) {
        const int bf = n & 1; const int chunk = b * 128 + n;
        asm volatile("s_waitcnt vmcnt(0)" ::: "memory");
        __syncthreads();
        if (n + 1 < 128) G2_ISSUE(n + 1, bf ^ 1);
        if (wid < 4) {
        f32x4 vv[4];
        { const bf16_t* vp = vT + ((size_t)chunk * 32 + hv) * 8192 + (size_t)((g >> 1) * 128 + e0 + r) * 8 + 4 * (g & 1);
#pragma unroll
          for (int mt = 0; mt < 4; ++mt) { const u32x2 w = *(const u32x2*)(vp + 2048 * mt);
              vv[mt] = (f32x4){__uint_as_float(w.x << 16), __uint_as_float(w.x & 0xffff0000u), __uint_as_float(w.y << 16), __uint_as_float(w.y & 0xffff0000u)}; } }
        const LAS unsigned char* B0 = lds + bf * BUFB;
        const LAS float* tb = (const LAS float*)(lds + O_TB + bf * 768);
        bf16x8 Sb[4];
#pragma unroll
        for (int ks = 0; ks < 4; ++ks) Sb[ks] = packf8(S[2 * ks], S[2 * ks + 1]);
        f32x4 kS[4], qS[4];
#pragma unroll
        for (int mt = 0; mt < 4; ++mt) { kS[mt] = (f32x4){0.f, 0.f, 0.f, 0.f}; qS[mt] = (f32x4){0.f, 0.f, 0.f, 0.f};
#pragma unroll
            for (int ks = 0; ks < 4; ++ks) {
                const bf16x8 xk = join8(ldsrd8(B0 + O_KN + mt * 4096 + off128[2 * ks]), ldsrd8(B0 + O_KN + mt * 4096 + off128[2 * ks + 1]));
                const bf16x8 xq = join8(ldsrd8(B0 + O_QN + mt * 4096 + off128[2 * ks]), ldsrd8(B0 + O_QN + mt * 4096 + off128[2 * ks + 1]));
                kS[mt] = __builtin_amdgcn_mfma_f32_16x16x32_bf16(xk, Sb[ks], kS[mt], 0, 0, 0);
                qS[mt] = __builtin_amdgcn_mfma_f32_16x16x32_bf16(xq, Sb[ks], qS[mt], 0, 0, 0); } }
        f32x4 beta[4], eg[4], ed[4];
#pragma unroll
        for (int mt = 0; mt < 4; ++mt) { beta[mt] = *(const LAS f32x4*)(tb + 16 * mt + 4 * g); eg[mt] = *(const LAS f32x4*)(tb + 64 + 16 * mt + 4 * g); ed[mt] = *(const LAS f32x4*)(tb + 128 + 16 * mt + 4 * g); }
        const float egl = tb[64 + 63];
        f32x4 rr[4];
#pragma unroll
        for (int mt = 0; mt < 4; ++mt) rr[mt] = beta[mt] * (vv[mt] - eg[mt] * kS[mt]);
        bf16x8 rb[2] = {packf8(rr[0], rr[1]), packf8(rr[2], rr[3])};
        f32x4 vn[4];
#pragma unroll
        for (int mt = 0; mt < 4; ++mt) { vn[mt] = (f32x4){0.f, 0.f, 0.f, 0.f};
#pragma unroll
            for (int ks = 0; ks < 2; ++ks) { const bf16x8 xt = join8(ldsrd8(B0 + O_TT + mt * 2048 + off64[2 * ks]), ldsrd8(B0 + O_TT + mt * 2048 + off64[2 * ks + 1]));
                vn[mt] = __builtin_amdgcn_mfma_f32_16x16x32_bf16(xt, rb[ks], vn[mt], 0, 0, 0); } }
        bf16x8 vnb[2] = {packf8(vn[0], vn[1]), packf8(vn[2], vn[3])};
        f32x4 o[4];
#pragma unroll
        for (int mt = 0; mt < 4; ++mt) { o[mt] = eg[mt] * qS[mt];
#pragma unroll
            for (int ks = 0; ks < 2; ++ks) { const bf16x8 xq = join8(ldsrd8(B0 + O_QK + mt * 2048 + off64[2 * ks]), ldsrd8(B0 + O_QK + mt * 2048 + off64[2 * ks + 1]));
                o[mt] = __builtin_amdgcn_mfma_f32_16x16x32_bf16(xq, vnb[ks], o[mt], 0, 0, 0); } }
        bf16x8 vdb[2] = {packf8(vn[0] * ed[0], vn[1] * ed[1]), packf8(vn[2] * ed[2], vn[3] * ed[3])};
#pragma unroll
        for (int dt = 0; dt < 8; ++dt) { S[dt] = S[dt] * egl;
#pragma unroll
            for (int ks = 0; ks < 2; ++ks) { const bf16x8 xk = join8(ldsrd8(B0 + O_KT + dt * 2048 + off64[2 * ks]), ldsrd8(B0 + O_KT + dt * 2048 + off64[2 * ks + 1]));
                S[dt] = __builtin_amdgcn_mfma_f32_16x16x32_bf16(xk, vdb[ks], S[dt], 0, 0, 0); } }
        { bf16_t* op = O + (size_t)(chunk * 64 + 4 * g) * 4096 + hv * 128 + e0 + r;
#pragma unroll
          for (int mt = 0; mt < 4; ++mt)
#pragma unroll
              for (int i = 0; i < 4; ++i) op[(size_t)(16 * mt + i) * 4096] = (bf16_t)(pk2(o[mt][i], 0.f) & 0xffffu); }
        }
        if (n + 1 < 128 && tid < 48) *(LAS f32x4*)(lds + O_TB + (bf ^ 1) * 768 + tid * 16) = tbreg;
    }
#undef G2_ISSUE
    asm volatile("s_waitcnt vmcnt(0)" ::: "memory");
    __syncthreads();
}

__device__ __forceinline__ void gdn_g3(bf16_t* O, const bf16_t* Z, const float* gn) {
    const int gt = blockIdx.x * NTHR + tidx(), NGT = gridDim.x * NTHR;
    const int dl = (tidx() & 15) * 8; float gv[8];
#pragma unroll
    for (int j = 0; j < 8; ++j) gv[j] = gn[dl + j];
#pragma unroll 4
    for (int idx = gt; idx < T * 512; idx += NGT) {
        float o[8], z[8]; unpack8(*(const u32x4*)(O + (size_t)idx * 8), o); unpack8(*(const u32x4*)(Z + (size_t)idx * 8), z);
        float ss = 0.f;
#pragma unroll
        for (int j = 0; j < 8; ++j) ss += o[j] * o[j];
        const float rn = rsqrtf(sum16(ss) * (1.f / 128.f) + EPS);
#pragma unroll
        for (int j = 0; j < 8; ++j) o[j] = o[j] * rn * gv[j] * siluf_(z[j]);
        *(u32x4*)(O + (size_t)idx * 8) = pack8f(o);
    }
}

#define XB_TMO      128
#define XB_XCNT(j)  (256  + 64 * (j))
#define XB_XSUB(j)  (1280 + 64 * (j))
#define XB_XGEN(j)  (2304 + 64 * (j))
#define XB_TOP      3328
#define XB_TOPGEN   3392
#define XCD_BAR_WORDS 3456
#define XB_SPIN_CAP (1u << 18)

__device__ __forceinline__ unsigned xb_ld(unsigned* p)              { return __hip_atomic_load(p, __ATOMIC_RELAXED, __HIP_MEMORY_SCOPE_AGENT); }
__device__ __forceinline__ unsigned xb_add(unsigned* p, unsigned v) { return __hip_atomic_fetch_add(p, v, __ATOMIC_RELAXED, __HIP_MEMORY_SCOPE_AGENT); }
__device__ __forceinline__ unsigned xb_xcc_id() { return (unsigned)__builtin_amdgcn_s_getreg((3 << 11) | 20) & 0xFu; }
#define XB_SPIN(cond, bar) do { unsigned _sp = 0; while (cond) { __builtin_amdgcn_s_sleep(1); \
    if ((++_sp & 255u) == 0u) { if (xb_ld(&(bar)[XB_TMO])) break; if (_sp > XB_SPIN_CAP) { atomicAdd(&(bar)[XB_TMO], 1u); break; } } } } while (0)

struct XcdBarrier {
    unsigned* bar; unsigned x;
    volatile LAS unsigned* st;
};

__device__ __forceinline__ XcdBarrier xcd_barrier_post(unsigned* bar, volatile LAS unsigned* st) {
    XcdBarrier b; b.bar = bar; b.x = xb_xcc_id(); b.st = st;
    if (threadIdx.x == 0) (void)xb_add(&bar[XB_XCNT(b.x)], 1u);
    return b;
}
__device__ __forceinline__ void xcd_barrier_complete(unsigned* bar, unsigned x, unsigned& nloc, unsigned& nx) {
    const unsigned G = gridDim.x * gridDim.y * gridDim.z;
    unsigned sum, cnt, mine, sp = 0u;
    for (;;) {
        sum = 0u; cnt = 0u; mine = 0u;
#pragma unroll
        for (unsigned j = 0; j < 16; ++j) { const unsigned c = xb_ld(&bar[XB_XCNT(j)]); sum += c; cnt += (c > 0u) ? 1u : 0u; mine = (j == x) ? c : mine; }
        if (sum == G) break;
        __builtin_amdgcn_s_sleep(1);
        if ((++sp & 255u) == 0u) { if (xb_ld(&bar[XB_TMO])) break; if (sp > XB_SPIN_CAP) { atomicAdd(&bar[XB_TMO], 1u); break; } }
    }
    nloc = mine > 0u ? mine : 1u; nx = cnt > 0u ? cnt : 1u;
}

__device__ __forceinline__ void xcd_barrier(const XcdBarrier& b) {
    asm volatile("s_waitcnt vmcnt(0)" ::: "memory");
    __syncthreads();
    if (threadIdx.x == 0) {
        unsigned* bar = b.bar;
        __builtin_amdgcn_s_waitcnt(0);
        unsigned nloc = b.st[0], nx = b.st[1];
        if (nloc == 0u) { xcd_barrier_complete(bar, b.x, nloc, nx); b.st[0] = nloc; b.st[1] = nx; }
        const unsigned old = xb_add(&bar[XB_XSUB(b.x)], 1u);
        const unsigned gen = old / nloc;
        if (old + 1u == (gen + 1u) * nloc) {
            __builtin_amdgcn_fence(__ATOMIC_RELEASE, "agent");
            asm volatile("s_waitcnt vmcnt(0)" ::: "memory");
            const unsigned og = xb_add(&bar[XB_TOP], 1u);
            const unsigned tg = og / nx;
            if (og + 1u == (tg + 1u) * nx) xb_add(&bar[XB_TOPGEN], 1u);
            else XB_SPIN(xb_ld(&bar[XB_TOPGEN]) == tg, bar);
            __builtin_amdgcn_fence(__ATOMIC_ACQUIRE, "agent");
            xb_add(&bar[XB_XGEN(b.x)], 1u);
            asm volatile("s_waitcnt vmcnt(0)" ::: "memory");
        } else {
            XB_SPIN(xb_ld(&bar[XB_XGEN(b.x)]) == gen, bar);
            __builtin_amdgcn_fence(__ATOMIC_ACQUIRE, "agent");
            asm volatile("s_waitcnt vmcnt(0)" ::: "memory");
        }
    }
    __syncthreads();
}

constexpr size_t WS_BAR = 256 * 1024;
struct Args { const float* in[20]; float* out; unsigned char* ws; int ph_lo, ph_hi; };
constexpr int NPHASE = 23;
#ifndef ONLY_PH
#define ONLY_PH -1
#endif
#define EN(k) (ONLY_PH < 0 || ONLY_PH == (k))
#ifndef MK_COOP
#define MK_COOP 1
#endif

__global__ void __launch_bounds__(NTHR) fwd_megakernel(Args a) {
    extern __shared__ __attribute__((aligned(16))) unsigned char lds_raw[];
    LAS unsigned char* lds = (LAS unsigned char*)lds_raw;
    unsigned char* ws = a.ws;
    const float* x = a.in[0]; const float* cvec = a.in[1]; const float* ada_w = a.in[2]; const float* ada_b = a.in[3]; const float* norm_g = a.in[4];
    float* Mods = (float*)(ws + WS_MODS); float* FL = (float*)(ws + WS_FL); float* FB = (float*)(ws + WS_FB); float* AB = (float*)(ws + WS_AB);
    float* Gt = (float*)(ws + WS_GB); float* Btb = Gt + (size_t)T * 32; float* TB = (float*)(ws + WS_TB);
    bf16_t* WA = (bf16_t*)(ws + WS_WA); bf16_t* WB = (bf16_t*)(ws + WS_WB); bf16_t* Hb = (bf16_t*)(ws + WS_H); bf16_t* Yb = (bf16_t*)(ws + WS_Y);
    bf16_t* Pb = (bf16_t*)(ws + WS_P); bf16_t* Qh = (bf16_t*)(ws + WS_QH); bf16_t* Kh = (bf16_t*)(ws + WS_KH); bf16_t* Vh = (bf16_t*)(ws + WS_VH);
    bf16_t* GV = (bf16_t*)(ws + WS_GV); bf16_t* QKV = (bf16_t*)(ws + WS_QKV); bf16_t* qn = (bf16_t*)(ws + WS_QN); bf16_t* kn = (bf16_t*)(ws + WS_KN);
    bf16_t* kT = (bf16_t*)(ws + WS_KT); bf16_t* vT = (bf16_t*)(ws + WS_VT); bf16_t* Tm = (bf16_t*)(ws + WS_TM); bf16_t* QKm = (bf16_t*)(ws + WS_QKM);
    bf16_t* Ob = (bf16_t*)(ws + WS_O); bf16_t* Zb = (bf16_t*)(ws + WS_Z);
#define mods(layer, sub) (Mods + (size_t)((layer) * 2 + (sub)) * 2 * 3 * DM)
#define ng(layer, k) (norm_g + (size_t)((layer) * 4 + (k)) * DM)
    const int lo = a.ph_lo, hi = a.ph_hi;
    volatile LAS unsigned* xst = (volatile LAS unsigned*)(lds + LDS_TOTAL - 64);
    if (tidx() < 2) xst[tidx()] = 0u;
    __syncthreads();
    XcdBarrier xbar = xcd_barrier_post((unsigned*)(ws + WS_BAR), xst);
    if (__builtin_amdgcn_readfirstlane(tidx() >> 6) == 0) { __threadfence(); asm volatile("s_waitcnt vmcnt(0)" ::: "memory"); } __syncthreads();
#define IN(k) (lo <= (k) && (k) < hi && EN(k))
#define SEAM(k) do { if (lo <= (k) && (k) + 1 < hi) { if ((k) == 0) { asm volatile("s_waitcnt vmcnt(0) lgkmcnt(0)" ::: "memory"); __syncthreads(); cg::this_grid().sync(); if (__builtin_amdgcn_readfirstlane(tidx() >> 6) == 0) { __builtin_amdgcn_fence(__ATOMIC_ACQUIRE, "agent"); asm volatile("s_waitcnt vmcnt(0)" ::: "memory"); } __syncthreads(); } else { xcd_barrier(xbar); } } } while (0)
#define CONV(W_, K_, N_, T_, s1, a1, s2, a2) do { __syncthreads(); convert_weight(lds, W_, K_, N_, T_, s1, a1, s2, a2); } while (0)
#define ROWP(xin_, first_, last_, gl, gs, gk, hl, hs, hk) row_phase(xin_, (first_) ? nullptr : a.out, (first_) ? nullptr : Yb, mods(gl, gs) + 2 * DM, ng(gl, gk), (last_) ? nullptr : Hb, ng(hl, hk), mods(hl, hs), mods(hl, hs) + DM)
    if (IN(0)) { mods_phase(lds, cvec, ada_w, ada_b, Mods); CONV(a.in[5], DM, FOX_N, WA, NOSEG, 0, NOSEG, 0); } SEAM(0);
    if (IN(1)) { ROWP(x, true, false, 0, 0, 0, 0, 0, 0); CONV(a.in[9], DM, DM, WB, NOSEG, 0, NOSEG, 0); } SEAM(1);
    if (IN(2)) { run_gemm(lds, Hb, DM, WA, FOX_LD, DM, Pb, FOX_LD, FOX_N, FL, 24, 16); } SEAM(2);
    if (IN(3)) { fox_prep(lds, Pb, FL, a.in[6], a.in[7], a.in[8], Qh, Kh, Vh, FB); CONV(a.in[16], DM, 2 * DFF, WA, NOSEG, 0, NOSEG, 0); } SEAM(3);
    if (IN(4)) { fox_attention((char*)lds_raw, Qh, Kh, Vh, Pb, FB, Hb, a.in[7], a.in[8]); } SEAM(4);
    if (IN(5)) { run_gemm(lds, Hb, DM, WB, DM, DM, Yb, DM, DM, nullptr, -1, 0); } SEAM(5);
    if (IN(6)) { ROWP(x, false, false, 0, 0, 1, 0, 1, 2); CONV(a.in[19], DFF, DM, WB, NOSEG, 0, NOSEG, 0); } SEAM(6);
    if (IN(7)) { run_gemm(lds, Hb, DM, WA, 2 * DFF, DM, GV, 2 * DFF, 2 * DFF, nullptr, -1, 0); } SEAM(7);
    if (IN(8)) { glu_phase(GV, a.in[17], a.in[18]); CONV(a.in[10], DM, 12352, WA, 8192, 256, 12288, -4096); } SEAM(8);
    if (IN(9)) { run_gemm(lds, GV + DFF, 2 * DFF, WB, DM, DFF, Yb, DM, DM, nullptr, -1, 0); } SEAM(9);
    if (IN(10)) { ROWP(a.out, false, false, 0, 1, 3, 1, 0, 0); CONV(a.in[15], 2 * DM, DM, WB, NOSEG, 0, NOSEG, 0); } SEAM(10);
    if (IN(11)) { run_gemm(lds, Hb, DM, WA, 8448, DM, QKV, 8192, 8192, AB, 32, 64); } SEAM(11);
    if (IN(12)) { gdn_prep(QKV, AB, a.in[11], a.in[12], a.in[13], qn, kn, kT, vT, Gt, Btb); } SEAM(12);
    if (IN(13)) { gdn_g1(lds, qn, kn, Gt, Btb, Tm, QKm, TB); } SEAM(13);
    if (IN(14)) { gdn_g2(lds, qn, kn, kT, vT, Tm, QKm, TB, Ob); } SEAM(14);
    if (IN(15)) { run_gemm(lds, Hb, DM, WA + (size_t)8448 * DM, 2 * DM, DM, Zb, 2 * DM, 2 * DM, nullptr, -1, 0); } SEAM(15);
    if (IN(16)) { gdn_g3(Ob, Zb, a.in[14]); CONV(a.in[16] + (size_t)DM * 2 * DFF, DM, 2 * DFF, WA, NOSEG, 0, NOSEG, 0); } SEAM(16);
    if (IN(17)) { run_gemm(lds, Ob, 2 * DM, WB, DM, 2 * DM, Yb, DM, DM, nullptr, -1, 0); } SEAM(17);
    if (IN(18)) { ROWP(a.out, false, false, 1, 0, 1, 1, 1, 2); CONV(a.in[19] + (size_t)DFF * DM, DFF, DM, WB, NOSEG, 0, NOSEG, 0); } SEAM(18);
    if (IN(19)) { run_gemm(lds, Hb, DM, WA, 2 * DFF, DM, GV, 2 * DFF, 2 * DFF, nullptr, -1, 0); } SEAM(19);
    if (IN(20)) { glu_phase(GV, a.in[17] + 3 * DFF, a.in[18] + DFF); } SEAM(20);
    if (IN(21)) { run_gemm(lds, GV + DFF, 2 * DFF, WB, DM, DFF, Yb, DM, DM, nullptr, -1, 0); } SEAM(21);
    if (IN(22)) { ROWP(a.out, false, true, 1, 1, 3, 0, 0, 0); }
    asm volatile("s_waitcnt vmcnt(0) lgkmcnt(0)" ::: "memory"); __syncthreads(); if (__builtin_amdgcn_readfirstlane(tidx() >> 6) == 0) { __threadfence(); asm volatile("s_waitcnt vmcnt(0)" ::: "memory"); }
#ifdef EXP_ROWS
    __syncthreads(); if (blockIdx.x == 0) { for (int i = tidx(); i < DM; i += NTHR) { a.out[i] = x[i]; a.out[(size_t)SEQ * DM + i] = x[(size_t)SEQ * DM + i]; } }
#endif
}

extern "C" void kernel_launch(void* const* d_in, const int* in_sizes, int n_in, void* d_out, int out_size, void* d_ws, size_t ws_size, hipStream_t stream) {
    static int grid = 0;
    if (grid == 0) {
        if (n_in != 20 || ws_size < WS_END) { fprintf(stderr, "kernel_launch: need 20 inputs and >= %zu B workspace (got %d, %zu)\n", (size_t)WS_END, n_in, ws_size); grid = -1; return; }
        int dev = 0, cus = 0, per_cu = 0;
        (void)hipGetDevice(&dev); (void)hipDeviceGetAttribute(&cus, hipDeviceAttributeMultiprocessorCount, dev);
        if (hipFuncSetAttribute((const void*)fwd_megakernel, hipFuncAttributeMaxDynamicSharedMemorySize, LDS_TOTAL) != hipSuccess) fprintf(stderr, "kernel_launch: hipFuncSetAttribute failed\n");
        if (hipOccupancyMaxActiveBlocksPerMultiprocessor(&per_cu, (const void*)fwd_megakernel, NTHR, LDS_TOTAL) != hipSuccess || per_cu < 1) { fprintf(stderr, "kernel_launch: occupancy query gave %d\n", per_cu); per_cu = 1; }
        (void)hipGetLastError();
        grid = cus > 0 ? cus : 256;
    }
    if (grid < 0) return;
    Args a{};
    for (int i = 0; i < 20; ++i) a.in[i] = (const float*)d_in[i];
    a.out = (float*)d_out; a.ws = (unsigned char*)d_ws;
    (void)hipMemsetAsync((char*)d_ws + WS_BAR, 0, 16384, stream);
#if MK_COOP
    a.ph_lo = 0; a.ph_hi = NPHASE;
    void* args[] = {&a};
    hipError_t e = hipLaunchCooperativeKernel((const void*)fwd_megakernel, dim3(grid), dim3(NTHR), args, LDS_TOTAL, stream);
    if (e != hipSuccess) fprintf(stderr, "cooperative launch failed: %s (grid %d)\n", hipGetErrorString(e), grid);
#else
    for (int ph = 0; ph < NPHASE; ++ph) { a.ph_lo = ph; a.ph_hi = ph + 1; hipLaunchKernelGGL(fwd_megakernel, dim3(grid), dim3(NTHR), LDS_TOTAL, stream, a); }
#endif
}
```
